# Optimizing an MI355X kernel written in HIP

```python
import jax, jax.numpy as jnp
from jax import lax
import numpy as np

D_MODEL = 4096
BATCH = 1
SEQ = 8192
DEPTH = 1

N_META = 16
GLA_HEADS = 8
GLA_DK = 128
GLA_DV = 256
GLA_GATE_RANK = 16
GLA_GATE_NORM = 16.0
GLA_CHUNK = 64
MLA_HEADS = 16
MLA_Q_RANK = 1024
MLA_KV_RANK = 512
MLA_NOPE = 128
MLA_ROPE = 64
MLA_V = 128
ROPE_THETA = 10000.0
Q_BLOCK = 128
D_FF = 4 * D_MODEL
EPS = 1e-6

GLA_QK_W = GLA_HEADS * GLA_DK
GLA_V_W = GLA_HEADS * GLA_DV
MLA_QK_HEAD = MLA_NOPE + MLA_ROPE
MLA_V_W = MLA_HEADS * MLA_V
IN_SPLITS = (GLA_QK_W, GLA_QK_W, GLA_V_W, GLA_V_W, GLA_GATE_RANK, GLA_GATE_RANK,
             MLA_Q_RANK, MLA_KV_RANK, MLA_ROPE, D_MODEL, D_MODEL)
IN_WIDTH = sum(IN_SPLITS)

kernel_name = "bidir_gla_mla_gated_hybrid"


def rmsnorm(x, g):
    xf = x.astype(jnp.float32)
    y = xf * lax.rsqrt(jnp.mean(xf * xf, axis=-1, keepdims=True) + EPS)
    return (y * g.astype(jnp.float32)).astype(x.dtype)


def apply_rope(x, cos, sin):
    xf = x.astype(jnp.float32)
    x1, x2 = jnp.split(xf, 2, axis=-1)
    c = cos[:, None, :]
    s = sin[:, None, :]
    return jnp.concatenate([x1 * c - x2 * s, x1 * s + x2 * c], axis=-1).astype(x.dtype)


def gla_direction(q, k, v, logg):
    B, H, T, dk = q.shape
    dv = v.shape[-1]
    C = GLA_CHUNK
    n = T // C

    def chunks(a):
        return jnp.moveaxis(a.reshape(B, H, n, C, a.shape[-1]), 2, 0)

    qc, kc, vc = chunks(q), chunks(k), chunks(v)
    bc = jnp.cumsum(chunks(logg), axis=-2)
    mask = jnp.tril(jnp.ones((C, C), dtype=bool))[:, :, None]

    def step(S, inp):
        qi, ki, vi, bi = inp
        inter = jnp.einsum('bhtd,bhde->bhte', qi * jnp.exp(bi), S)
        diff = bi[:, :, :, None, :] - bi[:, :, None, :, :]
        decay = jnp.exp(jnp.where(mask, diff, -jnp.inf))
        att = jnp.einsum('bhtsd,bhsd->bhts', qi[:, :, :, None, :] * decay, ki)
        intra = jnp.einsum('bhts,bhse->bhte', att, vi)
        last = bi[:, :, -1:, :]
        S_new = jnp.exp(last[:, :, 0, :])[..., None] * S + jnp.einsum(
            'bhsd,bhse->bhde', ki * jnp.exp(last - bi), vi)
        return S_new, inter + intra

    S0 = jnp.zeros((B, H, dk, dv), jnp.float32)
    _, out = lax.scan(step, S0, (qc, kc, vc, bc))
    return jnp.moveaxis(out, 0, 2).reshape(B, H, T, dv)


def block_attention(q, k, v):
    B, L, H, Dq = q.shape
    nb = -(-L // Q_BLOCK)
    Lq = nb * Q_BLOCK
    scale = Dq ** -0.5
    qb = jnp.pad(q, ((0, 0), (0, Lq - L), (0, 0), (0, 0)))
    qb = qb.reshape(B, nb, Q_BLOCK, H, Dq).transpose(1, 0, 3, 2, 4)
    kt = k.transpose(0, 2, 1, 3)
    vt = v.transpose(0, 2, 1, 3)

    def one(qi):
        s = jnp.einsum('bhqd,bhkd->bhqk', qi, kt, preferred_element_type=jnp.float32) * scale
        p = jax.nn.softmax(s, axis=-1)
        return jnp.einsum('bhqk,bhkd->bhqd', p.astype(vt.dtype), vt)

    o = lax.map(one, qb)
    return o.transpose(1, 0, 3, 2, 4).reshape(B, Lq, H, -1)[:, :L]


def hybrid_layer(h, cos, sin, ln1, w_in, gla_wf, gla_bf, gla_wb, gla_bb, gla_norm,
                 q_norm, w_uq, kv_norm, w_ukv, w_gla_out, w_mla_out, w_o,
                 ln2, w_ff1, w_ff2):
    B, L, _ = h.shape
    f32 = jnp.float32
    xn = rmsnorm(h, ln1)
    proj = xn @ w_in
    split_idx = [int(i) for i in np.cumsum(IN_SPLITS)[:-1]]
    (gq, gk, gv, gog, glrf, glrb, cq, ckv, krope, gate_a, gate_b) = jnp.split(proj, split_idx, axis=-1)

    pad = GLA_CHUNK - N_META

    def heads(a, d):
        a = a.reshape(B, L, -1, d).transpose(0, 2, 1, 3).astype(f32)
        return jnp.pad(a, ((0, 0), (0, 0), (pad, 0), (0, 0)))

    q = heads(gq, GLA_DK) * (GLA_DK ** -0.5)
    k = heads(gk, GLA_DK)
    v = heads(gv, GLA_DV)
    lg_f = heads(jax.nn.log_sigmoid((glrf @ gla_wf + gla_bf).astype(f32)) / GLA_GATE_NORM, GLA_DK)
    lg_b = heads(jax.nn.log_sigmoid((glrb @ gla_wb + gla_bb).astype(f32)) / GLA_GATE_NORM, GLA_DK)
    flip = lambda a: jnp.flip(a, axis=2)
    o_f = gla_direction(q, k, v, lg_f)
    o_b = flip(gla_direction(flip(q), flip(k), flip(v), flip(lg_b)))
    o = (o_f + o_b)[:, :, pad:, :].transpose(0, 2, 1, 3)
    o = rmsnorm(o, gla_norm).reshape(B, L, GLA_V_W).astype(h.dtype)
    y_gla = (o * jax.nn.silu(gog)) @ w_gla_out

    qf = (rmsnorm(cq, q_norm) @ w_uq).reshape(B, L, MLA_HEADS, MLA_QK_HEAD)
    q_nope, q_pe = qf[..., :MLA_NOPE], qf[..., MLA_NOPE:]
    q_pe = apply_rope(q_pe, cos, sin)
    kv = (rmsnorm(ckv, kv_norm) @ w_ukv).reshape(B, L, MLA_HEADS, MLA_NOPE + MLA_V)
    k_nope, v_m = kv[..., :MLA_NOPE], kv[..., MLA_NOPE:]
    k_pe = apply_rope(krope[:, :, None, :], cos, sin)
    qh = jnp.concatenate([q_nope, q_pe], axis=-1)
    kh = jnp.concatenate([k_nope, jnp.broadcast_to(k_pe, (B, L, MLA_HEADS, MLA_ROPE))], axis=-1)
    y_mla = block_attention(qh, kh, v_m).reshape(B, L, MLA_V_W) @ w_mla_out

    merged = jax.nn.sigmoid(gate_a) * y_gla + jax.nn.sigmoid(gate_b) * y_mla
    h = h + merged @ w_o

    hn = rmsnorm(h, ln2)
    h = h + jnp.square(jax.nn.relu(hn @ w_ff1)) @ w_ff2
    return h


def setup_inputs(seed: int = 0) -> dict:
    key = jax.random.key(seed)
    ks = jax.random.split(key, 24)
    f32 = jnp.float32

    def nrm(k, shape, scale):
        return jax.random.normal(k, shape, f32) * scale

    def gain(k, shape):
        return 1.0 + 0.01 * jax.random.normal(k, shape, f32)

    return {
        "x": nrm(ks[0], (BATCH, SEQ, D_MODEL), 1.0),
        "meta_tokens": nrm(ks[1], (N_META, D_MODEL), 1.0),
        "ln1": gain(ks[2], (DEPTH, D_MODEL)),
        "w_in": nrm(ks[3], (DEPTH, D_MODEL, IN_WIDTH), D_MODEL ** -0.5),
        "gla_wf": nrm(ks[4], (DEPTH, GLA_GATE_RANK, GLA_QK_W), GLA_GATE_RANK ** -0.5),
        "gla_bf": nrm(ks[5], (DEPTH, GLA_QK_W), 0.01),
        "gla_wb": nrm(ks[6], (DEPTH, GLA_GATE_RANK, GLA_QK_W), GLA_GATE_RANK ** -0.5),
        "gla_bb": nrm(ks[7], (DEPTH, GLA_QK_W), 0.01),
        "gla_norm": gain(ks[8], (DEPTH, GLA_DV)),
        "q_norm": gain(ks[9], (DEPTH, MLA_Q_RANK)),
        "w_uq": nrm(ks[10], (DEPTH, MLA_Q_RANK, MLA_HEADS * MLA_QK_HEAD), MLA_Q_RANK ** -0.5),
        "kv_norm": gain(ks[11], (DEPTH, MLA_KV_RANK)),
        "w_ukv": nrm(ks[12], (DEPTH, MLA_KV_RANK, MLA_HEADS * (MLA_NOPE + MLA_V)), MLA_KV_RANK ** -0.5),
        "w_gla_out": nrm(ks[13], (DEPTH, GLA_V_W, D_MODEL), GLA_V_W ** -0.5),
        "w_mla_out": nrm(ks[14], (DEPTH, MLA_V_W, D_MODEL), MLA_V_W ** -0.5),
        "w_o": nrm(ks[15], (DEPTH, D_MODEL, D_MODEL), D_MODEL ** -0.5),
        "ln2": gain(ks[16], (DEPTH, D_MODEL)),
        "w_ff1": nrm(ks[17], (DEPTH, D_MODEL, D_FF), D_MODEL ** -0.5),
        "w_ff2": nrm(ks[18], (DEPTH, D_FF, D_MODEL), D_FF ** -0.5),
        "final_norm": gain(ks[19], (D_MODEL,)),
    }


def reference(x, meta_tokens, ln1, w_in, gla_wf, gla_bf, gla_wb, gla_bb, gla_norm,
              q_norm, w_uq, kv_norm, w_ukv, w_gla_out, w_mla_out, w_o,
              ln2, w_ff1, w_ff2, final_norm):
    B = x.shape[0]
    meta = jnp.broadcast_to(meta_tokens[None].astype(x.dtype), (B, N_META, D_MODEL))
    h = jnp.concatenate([meta, x], axis=1)
    L = h.shape[1]
    pos = jnp.arange(L, dtype=jnp.float32)
    inv_freq = ROPE_THETA ** (-jnp.arange(0, MLA_ROPE, 2, dtype=jnp.float32) / MLA_ROPE)
    ang = pos[:, None] * inv_freq[None, :]
    cos, sin = jnp.cos(ang), jnp.sin(ang)
    for i in range(DEPTH):
        h = hybrid_layer(h, cos, sin, ln1[i], w_in[i], gla_wf[i], gla_bf[i], gla_wb[i], gla_bb[i],
                         gla_norm[i], q_norm[i], w_uq[i], kv_norm[i], w_ukv[i], w_gla_out[i],
                         w_mla_out[i], w_o[i], ln2[i], w_ff1[i], w_ff2[i])
    return rmsnorm(h, final_norm)[:, N_META:]
```

```cpp
#include <hip/hip_runtime.h>
#include <cstdio>
#include <cstdint>
namespace pg8 {
#define PG8_LAS __attribute__((address_space(3)))
typedef unsigned short bf16_t;
typedef short bf16x8 __attribute__((ext_vector_type(8)));
typedef float f32x4 __attribute__((ext_vector_type(4)));
typedef unsigned u32x4 __attribute__((ext_vector_type(4)));
constexpr int BM = 256, BK = 64, HALF = 128, HTB = HALF * BK * 2  , STAGE_BYTES = 8 * HTB, NXCD = 8, WGM = 8;

__host__ __device__ __forceinline__ int lds_byte(int r, int c) { const int st = (r >> 4) * 2 + (c >> 5), rr = r & 15, cc = c & 31, ob = rr * 64 + cc * 2; return st * 1024 + (ob ^ (((ob >> 9) & 1) << 5)); }
__host__ __device__ __forceinline__ void stage_rc(int b, int& R, int& C) { const int st = b / 1024, sb = b % 1024, swz = sb ^ (((sb >> 9) & 1) << 5); R = (st >> 1) * 16 + swz / 64; C = (st & 1) * 32 + (swz % 64) / 2; }
__host__ __device__ __forceinline__ int perm32(int rho) { const int n = rho >> 4, i = rho & 15; return 8 * (i >> 2) + 4 * n + (i & 3); }

struct Unit { int pm, pn; };
struct Gemm { const bf16_t* A; const bf16_t* Bt; int M, N, K; };

struct StaticOrder {
    int nM, nN, nwg, G, c;
    __host__ __device__ void init(int M, int N, int G_, int c_) { nM = M / BM; nN = N / BM; nwg = nM * nN; G = G_; c = c_; }
    __host__ __device__ bool next(int i, Unit& u) const {
        const long L = (long)i * G + c; if (L >= nwg) return false;
        int wgid = (int)L; { const int q = nwg / NXCD, r = nwg % NXCD, xcd = wgid % NXCD, off = wgid / NXCD; wgid = (xcd < r ? xcd * (q + 1) : r * (q + 1) + (xcd - r) * q) + off; }
        const int nig = WGM * nN, gid = wgid / nig, fm = gid * WGM, gsz = (nM - fm) < WGM ? (nM - fm) : WGM;
        u.pm = fm + ((wgid % nig) % gsz); u.pn = (wgid % nig) / gsz; return true;
    }
    __device__ __forceinline__ void a_ready(const Unit&) const {}
    __device__ __forceinline__ void done(const Unit&) const {}
};

template <class Epi, class Sched, bool ALIGN_EPI = false, bool SP2 = false>
__device__ __forceinline__ void gemm_phase(PG8_LAS unsigned char* lds, const Gemm g, const Sched& S, const Epi& E) {
    int tid = threadIdx.x; asm volatile("" : "+v"(tid)); const int wid = __builtin_amdgcn_readfirstlane(tid >> 6), lane = tid & 63, wr = wid >> 2, wc = wid & 3, fr = lane & 15, fq = lane >> 4;
    const int K = g.K, nt = K / BK;
    unsigned voffA[2], voffB[2];
#pragma unroll
    for (int i = 0; i < 2; ++i) { int R, C; stage_rc(tid * 16 + i * 8192, R, C); const int Rb = Epi::PERM ? ((R & ~31) + perm32(R & 31)) : R;
        voffA[i] = (unsigned)(R * K + C) * 2u; voffB[i] = (unsigned)(Rb * K + C) * 2u; }
    const size_t kstep = (size_t)(BK * 2);
    const size_t hstep = (size_t)HALF * K * 2;
    const size_t tstep = 2 * hstep;
    const unsigned ldsw = (unsigned)wid * 1024u;
    const int aoff = lds_byte(wr * 64 + fr, fq * 8), boff = lds_byte(wc * 32 + fr, fq * 8);
#define PG8_SA(b, h) (((b) * 2 + (h)) * HTB)
#define PG8_SB(b, h) ((4 + (b) * 2 + (h)) * HTB)
#define PG8_STAGE(bufoff, gbase, voff) do { _Pragma("unroll") for (int _i = 0; _i < 2; ++_i) \
        __builtin_amdgcn_global_load_lds((const unsigned*)((const char*)(gbase) + (voff)[_i]), (PG8_LAS unsigned*)(lds + (bufoff) + ldsw + _i * 8192), 16, 0, 0); } while (0)
#define PG8_LDA(dst, b, h) do { _Pragma("unroll") for (int m = 0; m < 4; ++m) _Pragma("unroll") for (int k = 0; k < 2; ++k) dst[m][k] = *(const PG8_LAS bf16x8*)(lds + PG8_SA(b, h) + aoff + m * 2048 + k * 1024); } while (0)
#define PG8_LDB(dst, b, h) do { _Pragma("unroll") for (int n = 0; n < 2; ++n) _Pragma("unroll") for (int k = 0; k < 2; ++k) dst[n][k] = *(const PG8_LAS bf16x8*)(lds + PG8_SB(b, h) + boff + n * 2048 + k * 1024); } while (0)
#define PG8_MMA(ai, bj, At, Bt) do { __builtin_amdgcn_s_setprio(1); _Pragma("unroll") for (int m = 0; m < 4; ++m) _Pragma("unroll") for (int n = 0; n < 2; ++n) _Pragma("unroll") for (int k = 0; k < 2; ++k) \
        acc[ai][bj][m][n] = __builtin_amdgcn_mfma_f32_16x16x32_bf16(Bt[n][k], At[m][k], acc[ai][bj][m][n], 0, 0, 0); __builtin_amdgcn_s_setprio(0); } while (0)
#define PG8_WAIT_V(n) asm volatile("s_waitcnt vmcnt(" #n ")" ::: "memory")
#define PG8_WAIT_L(n) asm volatile("s_waitcnt lgkmcnt(" #n ")" ::: "memory")
#define PG8_BAR __builtin_amdgcn_s_barrier()
#define PG8_SCHED __builtin_amdgcn_sched_barrier(0)
    Unit cur, nxt; int ui = 0;
    if (!S.next(0, cur)) return;
    f32x4 acc[2][2][4][2];
#pragma unroll
    for (int a = 0; a < 2; ++a)
#pragma unroll
        for (int b = 0; b < 2; ++b)
#pragma unroll
            for (int m = 0; m < 4; ++m)
#pragma unroll
                for (int n = 0; n < 2; ++n) acc[a][b][m][n] = (f32x4){0.f, 0.f, 0.f, 0.f};
    bf16x8 At[4][2], B0[2][2], B1[2][2];
    const char* cA = (const char*)g.A + (size_t)cur.pm * tstep; const char* cB = (const char*)g.Bt + (size_t)cur.pn * tstep;
    S.a_ready(cur);
    if constexpr (SP2) {
        PG8_STAGE(PG8_SB(0, 0), cB, voffB); PG8_STAGE(PG8_SB(0, 1), cB + hstep, voffB); PG8_STAGE(PG8_SA(0, 0), cA, voffA); PG8_STAGE(PG8_SA(0, 1), cA + hstep, voffA);
        if (wr == 1) PG8_BAR;
        PG8_WAIT_V(2); PG8_BAR;
        PG8_STAGE(PG8_SB(1, 0), cB + kstep, voffB); PG8_STAGE(PG8_SA(1, 0), cA + kstep, voffA); PG8_STAGE(PG8_SB(1, 1), cB + hstep + kstep, voffB);
        PG8_WAIT_V(6); PG8_BAR;
    } else {
        PG8_STAGE(PG8_SB(0, 0), cB, voffB); PG8_STAGE(PG8_SA(0, 0), cA, voffA); PG8_STAGE(PG8_SB(0, 1), cB + hstep, voffB); PG8_STAGE(PG8_SA(0, 1), cA + hstep, voffA);
        if (wr == 1) PG8_BAR;
        PG8_WAIT_V(4); PG8_BAR;
        PG8_STAGE(PG8_SB(1, 0), cB + kstep, voffB); PG8_STAGE(PG8_SA(1, 0), cA + kstep, voffA); PG8_STAGE(PG8_SB(1, 1), cB + hstep + kstep, voffB);
        PG8_WAIT_V(6); PG8_BAR;
    }
    for (;;) {
        const bool has_next = S.next(ui + 1, nxt);
        const char* nA = has_next ? (const char*)g.A + (size_t)nxt.pm * tstep : cA; const char* nB = has_next ? (const char*)g.Bt + (size_t)nxt.pn * tstep : cB;
        for (int t = 0; t < nt; t += 2) {
            const bool last = (t == nt - 2);
            const char* a1 = cA + (size_t)(t + 1) * kstep;
            const char* a2 = last ? nA : cA + (size_t)(t + 2) * kstep; const char* b2 = last ? nB : cB + (size_t)(t + 2) * kstep;
            const char* a3 = a2 + kstep; const char* b3 = b2 + kstep;
            if (last && has_next) S.a_ready(nxt);
            if constexpr (SP2) {
            PG8_LDB(B0, 0, 0); PG8_LDB(B1, 0, 1); PG8_SCHED; PG8_LDA(At, 0, 0); PG8_STAGE(PG8_SA(1, 1), a1 + hstep, voffA);
            PG8_WAIT_V(8); PG8_WAIT_L(0); PG8_BAR; PG8_MMA(0, 0, At, B0); PG8_MMA(0, 1, At, B1); PG8_BAR; PG8_SCHED;
            PG8_LDA(At, 0, 1); PG8_STAGE(PG8_SB(0, 0), b2, voffB); PG8_STAGE(PG8_SB(0, 1), b2 + hstep, voffB); PG8_STAGE(PG8_SA(0, 0), a2, voffA);
            PG8_WAIT_V(8); PG8_WAIT_L(0); PG8_BAR; PG8_MMA(1, 0, At, B0); PG8_MMA(1, 1, At, B1); PG8_BAR; PG8_SCHED;
            PG8_LDB(B0, 1, 0); PG8_LDB(B1, 1, 1); PG8_SCHED; PG8_LDA(At, 1, 0); PG8_STAGE(PG8_SA(0, 1), a2 + hstep, voffA);
            PG8_WAIT_V(8); PG8_WAIT_L(0); PG8_BAR; PG8_MMA(0, 0, At, B0); PG8_MMA(0, 1, At, B1); PG8_BAR; PG8_SCHED;
            PG8_LDA(At, 1, 1); PG8_STAGE(PG8_SB(1, 0), b3, voffB); PG8_STAGE(PG8_SB(1, 1), b3 + hstep, voffB); PG8_STAGE(PG8_SA(1, 0), a3, voffA);
            PG8_WAIT_V(8); PG8_WAIT_L(0); PG8_BAR; PG8_MMA(1, 0, At, B0); PG8_MMA(1, 1, At, B1); PG8_BAR; PG8_SCHED;
            } else {
            PG8_LDB(B0, 0, 0); PG8_SCHED; PG8_LDA(At, 0, 0); PG8_STAGE(PG8_SA(1, 1), a1 + hstep, voffA);
            PG8_WAIT_L(8); PG8_BAR; PG8_WAIT_L(0); PG8_MMA(0, 0, At, B0); PG8_BAR; PG8_SCHED;
            PG8_LDB(B1, 0, 1); PG8_STAGE(PG8_SB(0, 0), b2, voffB);
            PG8_BAR; PG8_WAIT_L(0); PG8_MMA(0, 1, At, B1); PG8_BAR;
            PG8_LDA(At, 0, 1); PG8_STAGE(PG8_SA(0, 0), a2, voffA);
            PG8_BAR; PG8_WAIT_L(0); PG8_MMA(1, 0, At, B0); PG8_BAR; PG8_SCHED;
            PG8_STAGE(PG8_SB(0, 1), b2 + hstep, voffB);
            PG8_WAIT_V(6); PG8_BAR; PG8_MMA(1, 1, At, B1); PG8_BAR;
            PG8_LDB(B0, 1, 0); PG8_SCHED; PG8_LDA(At, 1, 0); PG8_STAGE(PG8_SA(0, 1), a2 + hstep, voffA);
            PG8_WAIT_L(8); PG8_BAR; PG8_WAIT_L(0); PG8_MMA(0, 0, At, B0); PG8_BAR; PG8_SCHED;
            PG8_LDB(B1, 1, 1); PG8_STAGE(PG8_SB(1, 0), b3, voffB);
            PG8_BAR; PG8_WAIT_L(0); PG8_MMA(0, 1, At, B1); PG8_BAR;
            PG8_LDA(At, 1, 1); PG8_STAGE(PG8_SA(1, 0), a3, voffA);
            PG8_BAR; PG8_WAIT_L(0); PG8_MMA(1, 0, At, B0); PG8_BAR; PG8_SCHED;
            PG8_STAGE(PG8_SB(1, 1), b3 + hstep, voffB);
            PG8_WAIT_V(6); PG8_BAR; PG8_MMA(1, 1, At, B1); PG8_BAR;
            }
        }
        if constexpr (ALIGN_EPI) { if (wr == 0) PG8_BAR; }
        if constexpr (!Epi::AFTER_DRAIN) { E(acc, cur, wr, wc, fr, fq); S.done(cur); }
        if (!has_next) break;
#pragma unroll
        for (int a = 0; a < 2; ++a)
#pragma unroll
            for (int b = 0; b < 2; ++b)
#pragma unroll
                for (int m = 0; m < 4; ++m)
#pragma unroll
                    for (int n = 0; n < 2; ++n) acc[a][b][m][n] = (f32x4){0.f, 0.f, 0.f, 0.f};
        cur = nxt; cA = nA; cB = nB; ++ui;
        if constexpr (ALIGN_EPI) { if (wr == 1) PG8_BAR; }
    }
    PG8_WAIT_V(0);
    if constexpr (!ALIGN_EPI) { if (wr == 0) PG8_BAR; }
    PG8_BAR;
    if constexpr (Epi::AFTER_DRAIN) { E.fused(acc, cur, wr, wc, fr, fq, lds, wid, lane); S.done(cur); }
#undef PG8_SA
#undef PG8_SB
#undef PG8_STAGE
#undef PG8_LDA
#undef PG8_LDB
#undef PG8_MMA
#undef PG8_WAIT_V
#undef PG8_WAIT_L
#undef PG8_BAR
#undef PG8_SCHED
}
}
#define LAS __attribute__((address_space(3)))
#define XB_TMO      128
#define XB_XCNT(j)  (256  + 64 * (j))
#define XB_XSUB(j)  (1280 + 64 * (j))
#define XB_XGEN(j)  (2304 + 64 * (j))
#define XB_TOP      3328
#define XB_TOPGEN   3392
#define XCD_BAR_WORDS 3456
#define XB_SPIN_CAP (1u << 18)

__device__ __forceinline__ unsigned xb_ld(unsigned* p)              { return __hip_atomic_load(p, __ATOMIC_RELAXED, __HIP_MEMORY_SCOPE_AGENT); }
__device__ __forceinline__ unsigned xb_add(unsigned* p, unsigned v) { return __hip_atomic_fetch_add(p, v, __ATOMIC_RELAXED, __HIP_MEMORY_SCOPE_AGENT); }
__device__ __forceinline__ unsigned xb_xcc_id() { return (unsigned)__builtin_amdgcn_s_getreg((3 << 11) | 20) & 0xFu; }
#define XB_SPIN(cond, bar) do { unsigned _sp = 0; while (cond) { __builtin_amdgcn_s_sleep(1); \
    if ((++_sp & 255u) == 0u) { if (xb_ld(&(bar)[XB_TMO])) break; if (_sp > XB_SPIN_CAP) { atomicAdd(&(bar)[XB_TMO], 1u); break; } } } } while (0)

struct XcdBarrier {
    unsigned* bar; unsigned x;
    volatile LAS unsigned* st;
};

__device__ __forceinline__ XcdBarrier xcd_barrier_post(unsigned* bar, volatile LAS unsigned* st) {
    XcdBarrier b; b.bar = bar; b.x = xb_xcc_id(); b.st = st;
    if (threadIdx.x == 0) (void)xb_add(&bar[XB_XCNT(b.x)], 1u);
    return b;
}
__device__ __forceinline__ void xcd_barrier_complete(unsigned* bar, unsigned x, unsigned& nloc, unsigned& nx) {
    const unsigned G = gridDim.x * gridDim.y * gridDim.z;
    unsigned sum, cnt, mine, sp = 0u;
    for (;;) {
        sum = 0u; cnt = 0u; mine = 0u;
#pragma unroll
        for (unsigned j = 0; j < 16; ++j) { const unsigned c = xb_ld(&bar[XB_XCNT(j)]); sum += c; cnt += (c > 0u) ? 1u : 0u; mine = (j == x) ? c : mine; }
        if (sum == G) break;
        __builtin_amdgcn_s_sleep(1);
        if ((++sp & 255u) == 0u) { if (xb_ld(&bar[XB_TMO])) break; if (sp > XB_SPIN_CAP) { atomicAdd(&bar[XB_TMO], 1u); break; } }
    }
    nloc = mine > 0u ? mine : 1u; nx = cnt > 0u ? cnt : 1u;
}

__device__ __forceinline__ void xcd_barrier(const XcdBarrier& b) {
    asm volatile("s_waitcnt vmcnt(0)" ::: "memory");
    __syncthreads();
    if (threadIdx.x == 0) {
        unsigned* bar = b.bar;
        __builtin_amdgcn_s_waitcnt(0);
        unsigned nloc = b.st[0], nx = b.st[1];
        if (nloc == 0u) { xcd_barrier_complete(bar, b.x, nloc, nx); b.st[0] = nloc; b.st[1] = nx; }
        const unsigned old = xb_add(&bar[XB_XSUB(b.x)], 1u);
        const unsigned gen = old / nloc;
        if (old + 1u == (gen + 1u) * nloc) {
            __builtin_amdgcn_fence(__ATOMIC_RELEASE, "agent");
            asm volatile("s_waitcnt vmcnt(0)" ::: "memory");
            const unsigned og = xb_add(&bar[XB_TOP], 1u);
            const unsigned tg = og / nx;
            if (og + 1u == (tg + 1u) * nx) xb_add(&bar[XB_TOPGEN], 1u);
            else XB_SPIN(xb_ld(&bar[XB_TOPGEN]) == tg, bar);
            __builtin_amdgcn_fence(__ATOMIC_ACQUIRE, "agent");
            xb_add(&bar[XB_XGEN(b.x)], 1u);
            asm volatile("s_waitcnt vmcnt(0)" ::: "memory");
        } else {
            XB_SPIN(xb_ld(&bar[XB_XGEN(b.x)]) == gen, bar);
            __builtin_amdgcn_fence(__ATOMIC_ACQUIRE, "agent");
            asm volatile("s_waitcnt vmcnt(0)" ::: "memory");
        }
    }
    __syncthreads();
}
constexpr int NWAVES = 8, NTHR = 512;
constexpr int DM = 4096, SEQ = 8192, NMETA = 16, LTOK = SEQ + NMETA  , LP = 8448  ;
constexpr int NPROJ = 16128;
constexpr int DFF = 16384;
constexpr int GH = 8, GDK = 128, GDV = 256, GCH = 64, NXC = SEQ / GCH  ;
constexpr int MH = 16, MQK = 192, MNOPE = 128, MROPE = 64, MV = 128, QRANK = 1024, KVRANK = 512;
constexpr float EPS = 1e-6f;
constexpr float GLA_QSCALE = 0.08838834764831845f;
constexpr float MLA_QSCALE = 0.07216878364870323f * 1.4426950408889634f;
constexpr size_t KiB = 1024, MiB = 1024 * 1024;
constexpr size_t WS_CTL = 0, CTL_BYTES = 1 * MiB;
constexpr size_t WS_W1T = WS_CTL + CTL_BYTES;
constexpr size_t WS_W2T = WS_W1T + (size_t)DFF * DM * 2;
constexpr size_t WS_WOT = WS_W2T + (size_t)DFF * DM * 2;
constexpr size_t WS_WGT = WS_WOT + (size_t)DM * DM * 2;
constexpr size_t WS_WMT = WS_WGT + (size_t)DM * 2048 * 2;
constexpr size_t WS_WUQT = WS_WMT + (size_t)DM * 2048 * 2;
constexpr size_t WS_WUKVT = WS_WUQT + (size_t)3072 * 1024 * 2;
constexpr size_t WS_STATS = WS_WUKVT + (size_t)4096 * 512 * 2;
constexpr size_t ST_RS1 = WS_STATS;
constexpr size_t ST_CQSS = ST_RS1 + (size_t)LP * 4;
constexpr size_t ST_CKVSS = ST_CQSS + (size_t)SEQ * 16 * 4;
constexpr size_t ST_H1SS = ST_CKVSS + (size_t)LP * 8 * 4;
constexpr size_t ST_H2SS = ST_H1SS + (size_t)SEQ * 64 * 4;
constexpr size_t ST_COS = ST_H2SS + (size_t)SEQ * 64 * 4;
constexpr size_t ST_SIN = ST_COS + (size_t)LTOK * 32 * 4;
constexpr size_t ST_DLF = ST_SIN + (size_t)LTOK * 32 * 4;
constexpr size_t ST_DLB = ST_DLF + (size_t)129 * 8 * 128 * 4;
constexpr size_t ST_SMALL = ST_DLB + (size_t)128 * 8 * 128 * 4;
constexpr size_t WS_R1 = (ST_SMALL + (size_t)LP * 96 * 4 + 4095) / 4096 * 4096;
constexpr size_t WS_WINT = WS_R1;
constexpr size_t WS_QM = WS_R1;
constexpr size_t WS_KF = WS_QM + (size_t)SEQ * 3072 * 2;
constexpr size_t WS_R2 = WS_R1 + (size_t)NPROJ * DM * 2;
static_assert(WS_KF + (size_t)LP * 3072 * 2 <= WS_R2, "R1 overlay");
constexpr size_t WS_H0B = WS_R2;
constexpr size_t WS_AO = WS_R2;
constexpr size_t WS_AG = WS_AO + (size_t)SEQ * 2048 * 2;
constexpr size_t WS_P = WS_R2 + (size_t)LP * DM * 2;
static_assert(WS_AG + (size_t)SEQ * 2048 * 2 <= WS_P, "R2 overlay");
constexpr size_t WS_GQ = WS_P;
constexpr size_t WS_GK = WS_GQ + (size_t)SEQ * 1024 * 2;
constexpr size_t WS_GV = WS_GK + (size_t)LP * 1024 * 2;
constexpr size_t WS_GOG = WS_GV + (size_t)LP * 2048 * 2;
constexpr size_t WS_MERGED = WS_P;
static_assert(WS_MERGED + (size_t)SEQ * DM * 2 <= WS_GOG, "merged overlay");
constexpr size_t WS_CQ = WS_GOG + (size_t)SEQ * 2048 * 2;
constexpr size_t WS_CKV = WS_CQ + (size_t)SEQ * 1024 * 2;
constexpr size_t WS_GA = WS_CKV + (size_t)LP * 512 * 2;
constexpr size_t WS_GB = WS_GA + (size_t)SEQ * DM * 2;
constexpr size_t WS_U = WS_R1;
constexpr size_t WS_VB = WS_GB + (size_t)SEQ * DM * 2;
static_assert(WS_U + (size_t)SEQ * DFF * 2 <= WS_VB, "U overlay");
constexpr size_t WS_KHTF = WS_VB + (size_t)LP * 2048 * 2;
constexpr size_t WS_KHTB = WS_KHTF + (size_t)129 * 8 * 128 * 64 * 2;
constexpr size_t WS_VT = WS_KHTB + (size_t)128 * 8 * 128 * 64 * 2;
constexpr size_t WS_SNAP = WS_VT + (size_t)129 * 8 * 256 * 64 * 2;
constexpr size_t WS_H1B = WS_SNAP;
constexpr size_t WS_END = WS_SNAP + (size_t)2 * 128 * 8 * 256 * 128 * 2;
static_assert(WS_END <= (size_t)1024 * MiB, "d_ws budget: 4 x largest tensor = 1 GiB");
constexpr int CW_BAR = 4096;
constexpr int LDS_BYTES = 163840;
constexpr int LDS_CTL = LDS_BYTES - 256;

#define GAS __attribute__((address_space(1)))
typedef unsigned short bf16;
typedef float f32x4 __attribute__((ext_vector_type(4)));
typedef float f32x16 __attribute__((ext_vector_type(16)));
typedef short bf16x8 __attribute__((ext_vector_type(8)));
typedef short s16x4 __attribute__((ext_vector_type(4)));
typedef unsigned u32x4 __attribute__((ext_vector_type(4)));
typedef unsigned u32x2 __attribute__((ext_vector_type(2)));
#define LDS_WAIT() asm volatile("s_waitcnt lgkmcnt(0)" ::: "memory")
#define VM_WAIT() asm volatile("s_waitcnt vmcnt(0)" ::: "memory")
#define SBAR() __builtin_amdgcn_sched_barrier(0)
typedef float f32x2_ __attribute__((ext_vector_type(2)));
typedef __bf16 bf16x2_ __attribute__((ext_vector_type(2)));
__device__ __forceinline__ unsigned cvtpk(float lo, float hi) { const f32x2_ v = {lo, hi}; return __builtin_bit_cast(unsigned, __builtin_convertvector(v, bf16x2_)); }
__device__ __forceinline__ float bf2f(unsigned short b) { return __uint_as_float(((unsigned)b) << 16); }
__device__ __forceinline__ float bflo(unsigned w) { return __uint_as_float(w << 16); }
__device__ __forceinline__ float bfhi(unsigned w) { return __uint_as_float(w & 0xffff0000u); }
__device__ __forceinline__ unsigned short f2bf(float f) { return (unsigned short)(cvtpk(f, 0.f) & 0xffffu); }
__device__ __forceinline__ float wave_sum(float v) {
#pragma unroll
    for (int o = 1; o < 64; o <<= 1) v += __shfl_xor(v, o);
    return v;
}
__device__ __forceinline__ float sigmoidf_(float x) { return __builtin_amdgcn_rcpf(1.f + __expf(-x)); }
__device__ __forceinline__ float logsig16(float z) { return (fminf(z, 0.f) - __logf(1.f + __expf(-fabsf(z)))) * 0.0625f; }
template <int KIND> __device__ __forceinline__ int srccol(int n) {
    if (KIND == 1) {
        if (n < 6144) return n;
        if (n < 7168) return 6176 + (n - 6144);
        if (n < 7680) return 7200 + (n - 7168);
        if (n < 15872) return 7776 + (n - 7680);
        if (n < 15936) return 7712 + (n - 15872);
        if (n < 15968) return 6144 + (n - 15936);
        return -1;
    } else if (KIND == 2) {
        const int h = n / 192, w = n - h * 192;
        if (w < 128) return n;
        const int p = w - 128, gp = p >> 5, fq = (p >> 3) & 3, nn = (p >> 2) & 1, j = p & 3;
        return h * 192 + 128 + 32 * nn + 16 * gp + 4 * fq + j;
    }
    return n;
}
template <int KIND> __device__ __forceinline__ void p0_item(const float* __restrict__ W, int K, int N, const float* __restrict__ gain, bf16* WT, LAS float* scr, int item, int nblk, int lane) {
    const int kb = item / nblk, nb = item - kb * nblk, k0 = 64 * kb, n0 = 32 * nb;
    const int sc = srccol<KIND>(n0 + (lane & 31)), kh = lane >> 5;
    float v[32];
#pragma unroll
    for (int i = 0; i < 32; ++i) v[i] = sc >= 0 ? W[(size_t)(k0 + 2 * i + kh) * N + sc] : 0.f;
    if (gain) {
#pragma unroll
        for (int i = 0; i < 32; ++i) v[i] *= gain[k0 + 2 * i + kh];
    }
#pragma unroll
    for (int i = 0; i < 32; ++i) scr[(2 * i + kh) * 33 + (lane & 31)] = v[i];
    LDS_WAIT(); asm volatile("" ::: "memory");
    const int c = lane & 7;
#pragma unroll
    for (int j = 0; j < 4; ++j) { const int n = (lane >> 3) + 8 * j; const LAS float* s = scr + (8 * c) * 33 + n;
        u32x4 o; o.x = cvtpk(s[0 * 33], s[1 * 33]); o.y = cvtpk(s[2 * 33], s[3 * 33]); o.z = cvtpk(s[4 * 33], s[5 * 33]); o.w = cvtpk(s[6 * 33], s[7 * 33]);
        *(GAS u32x4*)(WT + (size_t)(n0 + n) * K + k0 + 8 * c) = o; }
    LDS_WAIT(); asm volatile("" ::: "memory");
}
__device__ const double ROPE_INVF[32] = {
1.00000000000000000e+00, 7.49894209332455874e-01, 5.62341325190349073e-01, 4.21696503428582226e-01, 3.16227766016837941e-01, 2.37137370566165517e-01, 1.77827941003892293e-01, 1.33352143216332403e-01,
1.00000000000000006e-01, 7.49894209332455791e-02, 5.62341325190349114e-02, 4.21696503428582239e-02, 3.16227766016837913e-02, 2.37137370566165538e-02, 1.77827941003892293e-02, 1.33352143216332406e-02,
1.00000000000000002e-02, 7.49894209332455791e-03, 5.62341325190349097e-03, 4.21696503428582292e-03, 3.16227766016837939e-03, 2.37137370566165538e-03, 1.77827941003892275e-03, 1.33352143216332406e-03,
1.00000000000000002e-03, 7.49894209332455856e-04, 5.62341325190349097e-04, 4.21696503428582237e-04, 3.16227766016837939e-04, 2.37137370566165538e-04, 1.77827941003892270e-04, 1.33352143216332395e-04 };
__device__ __forceinline__ void rope_cs(int pos, int i, float& c, float& s) {
    const double x = (double)pos * ROPE_INVF[i];
    const double k = __builtin_rint(x * 0.15915494309189534561);
    double r = __builtin_fma(-k, 6.283185307179586, x); r = __builtin_fma(-k, 2.4492935982947064e-16, r);
    const double r2 = r * r;
    double ss = 1.0, cc = 1.0;
#pragma unroll
    for (int n = 14; n >= 1; --n) { ss = 1.0 - ss * r2 * (1.0 / (double)((2 * n) * (2 * n + 1))); cc = 1.0 - cc * r2 * (1.0 / (double)((2 * n - 1) * (2 * n))); }
    s = (float)(r * ss); c = (float)cc;
}
struct P0Args { const float *x, *meta, *ln1, *w_in, *q_norm, *w_uq, *kv_norm, *w_ukv, *w_gla_out, *w_mla_out, *w_o, *ln2, *w_ff1, *w_ff2; unsigned char* ws; };
__device__ __forceinline__ void p0_prologue(const P0Args& a, LAS unsigned char* lds, int gw, int NGW, int wave, int lane) {
    LAS float* scr = (LAS float*)(lds + wave * 16384);
    constexpr int I_IN = (DM / 64) * (NPROJ / 32), I_F1 = (DM / 64) * (DFF / 32), I_F2 = (DFF / 64) * (DM / 32), I_O = (DM / 64) * (DM / 32), I_G = (2048 / 64) * (DM / 32), I_M = I_G,
                  I_UQ = (QRANK / 64) * (3072 / 32), I_UKV = (KVRANK / 64) * (4096 / 32);
    constexpr int NITEMS = I_IN + I_F1 + I_F2 + I_O + I_G + I_M + I_UQ + I_UKV;
    unsigned char* ws = a.ws;
    for (int it = gw; it < NITEMS; it += NGW) {
        int r = it;
        if (r < I_IN) { p0_item<1>(a.w_in, DM, 15968, a.ln1, (bf16*)(ws + WS_WINT), scr, r, NPROJ / 32, lane); continue; } r -= I_IN;
        if (r < I_F1) { p0_item<0>(a.w_ff1, DM, DFF, a.ln2, (bf16*)(ws + WS_W1T), scr, r, DFF / 32, lane); continue; } r -= I_F1;
        if (r < I_F2) { p0_item<0>(a.w_ff2, DFF, DM, nullptr, (bf16*)(ws + WS_W2T), scr, r, DM / 32, lane); continue; } r -= I_F2;
        if (r < I_O) { p0_item<0>(a.w_o, DM, DM, nullptr, (bf16*)(ws + WS_WOT), scr, r, DM / 32, lane); continue; } r -= I_O;
        if (r < I_G) { p0_item<0>(a.w_gla_out, 2048, DM, nullptr, (bf16*)(ws + WS_WGT), scr, r, DM / 32, lane); continue; } r -= I_G;
        if (r < I_M) { p0_item<0>(a.w_mla_out, 2048, DM, nullptr, (bf16*)(ws + WS_WMT), scr, r, DM / 32, lane); continue; } r -= I_M;
        if (r < I_UQ) { p0_item<2>(a.w_uq, QRANK, 3072, a.q_norm, (bf16*)(ws + WS_WUQT), scr, r, 3072 / 32, lane); continue; } r -= I_UQ;
        p0_item<0>(a.w_ukv, KVRANK, 4096, a.kv_norm, (bf16*)(ws + WS_WUKVT), scr, r, 4096 / 32, lane);
    }
    bf16* H0B = (bf16*)(ws + WS_H0B); float* RS1 = (float*)(ws + ST_RS1);
    for (int m = gw; m < LP; m += NGW) {
        GAS u32x2* o8 = (GAS u32x2*)(H0B + (size_t)m * DM) + lane;
        if (m >= LTOK) {
#pragma unroll
            for (int j = 0; j < 16; ++j) o8[64 * j] = (u32x2){0u, 0u};
            if (lane == 0) RS1[m] = 0.f;
            continue;
        }
        const float* src = m < SEQ ? a.x + (size_t)m * DM : a.meta + (size_t)(m - SEQ) * DM;
        const GAS f32x4* xr = (const GAS f32x4*)src + lane;
        f32x4 v[16]; float s = 0.f;
#pragma unroll
        for (int j = 0; j < 16; ++j) { v[j] = xr[64 * j]; s += (v[j].x * v[j].x + v[j].y * v[j].y) + (v[j].z * v[j].z + v[j].w * v[j].w); }
        s = wave_sum(s);
        if (lane == 0) RS1[m] = 1.f / sqrtf(s * (1.f / DM) + EPS);
#pragma unroll
        for (int j = 0; j < 16; ++j) o8[64 * j] = (u32x2){cvtpk(v[j].x, v[j].y), cvtpk(v[j].z, v[j].w)};
    }
    float* COS = (float*)(ws + ST_COS); float* SIN = (float*)(ws + ST_SIN);
    for (int i = gw * 64 + lane; i < LTOK * 32; i += NGW * 64) { float c, s; rope_cs(i >> 5, i & 31, c, s); COS[i] = c; SIN[i] = s; }
}
__device__ __forceinline__ void st_bf8(bf16* p, f32x4 v0, f32x4 v1) { u32x4 w; w.x = cvtpk(v0[0], v0[1]); w.y = cvtpk(v0[2], v0[3]); w.z = cvtpk(v1[0], v1[1]); w.w = cvtpk(v1[2], v1[3]); *(GAS u32x4*)p = w; }
__device__ __forceinline__ void ld_bf8(const bf16* p, f32x4& a, f32x4& b) { const u32x4 w = *(const GAS u32x4*)p; a = (f32x4){bflo(w.x), bfhi(w.x), bflo(w.y), bfhi(w.y)}; b = (f32x4){bflo(w.z), bfhi(w.z), bflo(w.w), bfhi(w.w)}; }
__device__ __forceinline__ float dot4(f32x4 a) { return (a[0] * a[0] + a[1] * a[1]) + (a[2] * a[2] + a[3] * a[3]); }
#define EPI_ROWS(ai, m) _Pragma("unroll") for (int ai = 0; ai < 2; ++ai) _Pragma("unroll") for (int m = 0; m < 4; ++m)

struct ProjOrder {
    pg8::StaticOrder so; int G, c;
    __device__ void init(int G_, int c_) { so.init(SEQ, NPROJ, G_, c_); G = G_; c = c_; }
    __device__ bool next(int i, pg8::Unit& u) const {
        const int L = i * G + c;
        if (L < 32 * 63) return so.next(i, u);
        const int e = L - 32 * 63; if (e >= 15) return false;
        u.pm = 32; u.pn = e < 12 ? 4 + e : (e == 12 ? 28 : (e == 13 ? 29 : 62)); return true;
    }
    __device__ __forceinline__ void a_ready(const pg8::Unit&) const {}
    __device__ __forceinline__ void done(const pg8::Unit&) const {}
};
struct EpiProj {
    static constexpr bool PERM = true, AFTER_DRAIN = false;
    unsigned char* ws;
    __device__ __forceinline__ void operator()(const f32x4 (&acc)[2][2][4][2], const pg8::Unit& u, int wr, int wc, int fr, int fq) const {
        const float* RS1 = (const float*)(ws + ST_RS1);
        const int pn = u.pn, row0 = u.pm * 256 + wr * 64 + fr, cl = wc * 32 + 8 * fq;
        int mode, ld, ct, ssld = 0; bf16* base = nullptr; float* ss = nullptr; bool xonly = true;
        if (pn < 4) { mode = 1; base = (bf16*)(ws + WS_GQ); ld = 1024; ct = pn; }
        else if (pn < 8) { mode = 0; base = (bf16*)(ws + WS_GK); ld = 1024; ct = pn - 4; xonly = false; }
        else if (pn < 16) { mode = 0; base = (bf16*)(ws + WS_GV); ld = 2048; ct = pn - 8; xonly = false; }
        else if (pn < 24) { mode = 2; base = (bf16*)(ws + WS_GOG); ld = 2048; ct = pn - 16; }
        else if (pn < 28) { mode = 4; base = (bf16*)(ws + WS_CQ); ld = 1024; ct = pn - 24; ss = (float*)(ws + ST_CQSS); ssld = 16; }
        else if (pn < 30) { mode = 4; base = (bf16*)(ws + WS_CKV); ld = 512; ct = pn - 28; ss = (float*)(ws + ST_CKVSS); ssld = 8; xonly = false; }
        else if (pn < 46) { mode = 3; base = (bf16*)(ws + WS_GA); ld = 4096; ct = pn - 30; }
        else if (pn < 62) { mode = 3; base = (bf16*)(ws + WS_GB); ld = 4096; ct = pn - 46; }
        else { mode = 5; ld = 96; ct = 0; xonly = false; }
        if (xonly && u.pm >= 32) return;
        float* SMALL = (float*)(ws + ST_SMALL);
        EPI_ROWS(ai, m) {
            const int row = row0 + ai * 128 + m * 16; const float rs = RS1[row]; float ssum = 0.f;
#pragma unroll
            for (int bj = 0; bj < 2; ++bj) {
                f32x4 v0 = acc[ai][bj][m][0] * rs, v1 = acc[ai][bj][m][1] * rs;
                if (mode == 5) { if (bj == 0 && wc < 3) { GAS f32x4* d = (GAS f32x4*)(SMALL + (size_t)row * 96 + cl); d[0] = v0; d[1] = v1; } continue; }
                if (mode == 1) { v0 = v0 * GLA_QSCALE; v1 = v1 * GLA_QSCALE; }
                else if (mode == 2) {
#pragma unroll
                    for (int j = 0; j < 4; ++j) { v0[j] = v0[j] * sigmoidf_(v0[j]); v1[j] = v1[j] * sigmoidf_(v1[j]); } }
                else if (mode == 3) {
#pragma unroll
                    for (int j = 0; j < 4; ++j) { v0[j] = sigmoidf_(v0[j]); v1[j] = sigmoidf_(v1[j]); } }
                else if (mode == 4) ssum += dot4(v0) + dot4(v1);
                st_bf8(base + (size_t)row * ld + ct * 256 + bj * 128 + cl, v0, v1);
            }
            if (mode == 4) { ssum += __shfl_xor(ssum, 16); ssum += __shfl_xor(ssum, 32); if (fq == 0) ss[(size_t)row * ssld + ct * 4 + wc] = ssum; }
        }
    }
};
struct EpiQ {
    static constexpr bool PERM = true, AFTER_DRAIN = false;
    unsigned char* ws;
    __device__ __forceinline__ void operator()(const f32x4 (&acc)[2][2][4][2], const pg8::Unit& u, int wr, int wc, int fr, int fq) const {
        const float* SS = (const float*)(ws + ST_CQSS); const float* COS = (const float*)(ws + ST_COS); const float* SIN = (const float*)(ws + ST_SIN); bf16* QM = (bf16*)(ws + WS_QM);
        const int row0 = u.pm * 256 + wr * 64 + fr;
        EPI_ROWS(ai, m) {
            const int row = row0 + ai * 128 + m * 16;
            float s = 0.f; { const f32x4 t = *(const GAS f32x4*)(SS + (size_t)row * 16 + 4 * fq); s = (t[0] + t[1]) + (t[2] + t[3]); }
            s += __shfl_xor(s, 16); s += __shfl_xor(s, 32);
            const float rs = MLA_QSCALE / sqrtf(s * (1.f / QRANK) + EPS);
#pragma unroll
            for (int bj = 0; bj < 2; ++bj) {
                const int g = 8 * u.pn + 4 * bj + wc, head = g / 6, gi = g - 6 * head;
                f32x4 v0 = acc[ai][bj][m][0], v1 = acc[ai][bj][m][1];
                if (gi >= 4) {
                    const int f0 = 16 * (gi - 4) + 4 * fq, pos = row + NMETA;
                    const f32x4 c4 = *(const GAS f32x4*)(COS + (size_t)pos * 32 + f0), s4 = *(const GAS f32x4*)(SIN + (size_t)pos * 32 + f0);
                    const f32x4 o1 = v0 * c4 - v1 * s4, o2 = v0 * s4 + v1 * c4; v0 = o1; v1 = o2;
                }
                st_bf8(QM + (size_t)row * 3072 + head * 192 + gi * 32 + 8 * fq, v0 * rs, v1 * rs);
            }
        }
    }
};
struct EpiKV {
    static constexpr bool PERM = true, AFTER_DRAIN = false;
    unsigned char* ws;
    __device__ __forceinline__ void operator()(const f32x4 (&acc)[2][2][4][2], const pg8::Unit& u, int wr, int wc, int fr, int fq) const {
        const float* SS = (const float*)(ws + ST_CKVSS); bf16* KF = (bf16*)(ws + WS_KF); bf16* VB = (bf16*)(ws + WS_VB);
        const int row0 = u.pm * 256 + wr * 64 + fr, cl = wc * 32 + 8 * fq;
        EPI_ROWS(ai, m) {
            const int row = row0 + ai * 128 + m * 16;
            const f32x4 t0 = *(const GAS f32x4*)(SS + (size_t)row * 8), t1 = *(const GAS f32x4*)(SS + (size_t)row * 8 + 4);
            const float s = ((t0[0] + t0[1]) + (t0[2] + t0[3])) + ((t1[0] + t1[1]) + (t1[2] + t1[3]));
            const float rs = 1.f / sqrtf(s * (1.f / KVRANK) + EPS);
            st_bf8(KF + (size_t)row * 3072 + u.pn * 192 + cl, acc[ai][0][m][0] * rs, acc[ai][0][m][1] * rs);
            st_bf8(VB + (size_t)row * 2048 + u.pn * 128 + cl, acc[ai][1][m][0] * rs, acc[ai][1][m][1] * rs);
        }
    }
};
struct EpiGla {
    static constexpr bool PERM = true, AFTER_DRAIN = false;
    unsigned char* ws;
    __device__ __forceinline__ void operator()(const f32x4 (&acc)[2][2][4][2], const pg8::Unit& u, int wr, int wc, int fr, int fq) const {
        const bf16* GA = (const bf16*)(ws + WS_GA); bf16* MG = (bf16*)(ws + WS_MERGED);
        const int row0 = u.pm * 256 + wr * 64 + fr, col0 = u.pn * 256 + wc * 32 + 8 * fq;
        EPI_ROWS(ai, m) {
            const size_t ro = (size_t)(row0 + ai * 128 + m * 16) * DM + col0;
#pragma unroll
            for (int bj = 0; bj < 2; ++bj) { f32x4 g0, g1; ld_bf8(GA + ro + bj * 128, g0, g1); st_bf8(MG + ro + bj * 128, acc[ai][bj][m][0] * g0, acc[ai][bj][m][1] * g1); }
        }
    }
};
struct EpiMla {
    static constexpr bool PERM = true, AFTER_DRAIN = false;
    unsigned char* ws;
    __device__ __forceinline__ void operator()(const f32x4 (&acc)[2][2][4][2], const pg8::Unit& u, int wr, int wc, int fr, int fq) const {
        const bf16* GB = (const bf16*)(ws + WS_GB); bf16* MG = (bf16*)(ws + WS_MERGED);
        const int row0 = u.pm * 256 + wr * 64 + fr, col0 = u.pn * 256 + wc * 32 + 8 * fq;
        EPI_ROWS(ai, m) {
            const size_t ro = (size_t)(row0 + ai * 128 + m * 16) * DM + col0;
#pragma unroll
            for (int bj = 0; bj < 2; ++bj) { f32x4 g0, g1, p0, p1; ld_bf8(GB + ro + bj * 128, g0, g1); ld_bf8(MG + ro + bj * 128, p0, p1);
                st_bf8(MG + ro + bj * 128, p0 + acc[ai][bj][m][0] * g0, p1 + acc[ai][bj][m][1] * g1); }
        }
    }
};
struct EpiWo {
    static constexpr bool PERM = true, AFTER_DRAIN = false;
    unsigned char* ws; const float* x; float* out;
    __device__ __forceinline__ void operator()(const f32x4 (&acc)[2][2][4][2], const pg8::Unit& u, int wr, int wc, int fr, int fq) const {
        bf16* H1B = (bf16*)(ws + WS_H1B); float* SS = (float*)(ws + ST_H1SS);
        const int row0 = u.pm * 256 + wr * 64 + fr, col0 = u.pn * 256 + wc * 32 + 8 * fq;
        EPI_ROWS(ai, m) {
            const int row = row0 + ai * 128 + m * 16; const size_t ro = (size_t)row * DM + col0; float ssum = 0.f;
#pragma unroll
            for (int bj = 0; bj < 2; ++bj) {
                const GAS f32x4* xp = (const GAS f32x4*)(x + ro + bj * 128);
                const f32x4 v0 = xp[0] + acc[ai][bj][m][0], v1 = xp[1] + acc[ai][bj][m][1];
                GAS f32x4* op = (GAS f32x4*)(out + ro + bj * 128); op[0] = v0; op[1] = v1;
                st_bf8(H1B + ro + bj * 128, v0, v1); ssum += dot4(v0) + dot4(v1);
            }
            ssum += __shfl_xor(ssum, 16); ssum += __shfl_xor(ssum, 32); if (fq == 0) SS[(size_t)row * 64 + u.pn * 4 + wc] = ssum;
        }
    }
};
struct EpiFF1 {
    static constexpr bool PERM = true, AFTER_DRAIN = false;
    unsigned char* ws;
    __device__ __forceinline__ void operator()(const f32x4 (&acc)[2][2][4][2], const pg8::Unit& u, int wr, int wc, int fr, int fq) const {
        const float* SS = (const float*)(ws + ST_H1SS); bf16* U = (bf16*)(ws + WS_U);
        const int row0 = u.pm * 256 + wr * 64 + fr, col0 = u.pn * 256 + wc * 32 + 8 * fq;
        EPI_ROWS(ai, m) {
            const int row = row0 + ai * 128 + m * 16;
            float s = 0.f;
#pragma unroll
            for (int q = 0; q < 4; ++q) { const f32x4 t = *(const GAS f32x4*)(SS + (size_t)row * 64 + 16 * fq + 4 * q); s += (t[0] + t[1]) + (t[2] + t[3]); }
            s += __shfl_xor(s, 16); s += __shfl_xor(s, 32);
            const float rs = 1.f / sqrtf(s * (1.f / DM) + EPS);
#pragma unroll
            for (int bj = 0; bj < 2; ++bj) { f32x4 v0 = acc[ai][bj][m][0] * rs, v1 = acc[ai][bj][m][1] * rs;
#pragma unroll
                for (int j = 0; j < 4; ++j) { const float a = fmaxf(v0[j], 0.f), b = fmaxf(v1[j], 0.f); v0[j] = a * a; v1[j] = b * b; }
                st_bf8(U + (size_t)row * DFF + col0 + bj * 128, v0, v1); }
        }
    }
};
struct EpiFF2 {
    static constexpr bool PERM = true, AFTER_DRAIN = false;
    unsigned char* ws; float* out;
    __device__ __forceinline__ void operator()(const f32x4 (&acc)[2][2][4][2], const pg8::Unit& u, int wr, int wc, int fr, int fq) const {
        float* SS = (float*)(ws + ST_H2SS);
        const int row0 = u.pm * 256 + wr * 64 + fr, col0 = u.pn * 256 + wc * 32 + 8 * fq;
        EPI_ROWS(ai, m) {
            const int row = row0 + ai * 128 + m * 16; const size_t ro = (size_t)row * DM + col0; float ssum = 0.f;
#pragma unroll
            for (int bj = 0; bj < 2; ++bj) {
                GAS f32x4* op = (GAS f32x4*)(out + ro + bj * 128);
                const f32x4 v0 = op[0] + acc[ai][bj][m][0], v1 = op[1] + acc[ai][bj][m][1];
                op[0] = v0; op[1] = v1; ssum += dot4(v0) + dot4(v1);
            }
            ssum += __shfl_xor(ssum, 16); ssum += __shfl_xor(ssum, 32); if (fq == 0) SS[(size_t)row * 64 + u.pn * 4 + wc] = ssum;
        }
    }
};
__device__ __forceinline__ int gla_row(int c, int t) { return c == 0 ? (t < 48 ? -1 : SEQ + (t - 48)) : 64 * (c - 1) + t; }

struct GateW { float Wf[16], Wb[16], biasf, biasb; };
__device__ __forceinline__ void gate_lg(const GateW& w, const LAS float* GL, int t, bool valid, float& lgf, float& lgb) {
    float zf = w.biasf, zb = w.biasb;
#pragma unroll
    for (int q = 0; q < 4; ++q) { const f32x4 gf = *(const LAS f32x4*)(GL + t * 32 + 4 * q), gb = *(const LAS f32x4*)(GL + t * 32 + 16 + 4 * q);
#pragma unroll
        for (int j = 0; j < 4; ++j) { zf = fmaf(gf[j], w.Wf[4 * q + j], zf); zb = fmaf(gb[j], w.Wb[4 * q + j], zb); } }
    lgf = valid ? logsig16(zf) : 0.f; lgb = valid ? logsig16(zb) : 0.f;
}
struct GateTot { float offF, F63, sumB, offR, R0; };
__device__ __forceinline__ void gates_begin(GateW& w, GateTot& T, const unsigned char* ws, const float* wf, const float* bfv, const float* wb, const float* bbv, int c, int h, LAS unsigned char* lds, int tid) {
    const float* SMALL = (const float*)(ws + ST_SMALL);
    LAS float* GL = (LAS float*)lds; LAS float* TOT = (LAS float*)(lds + 8192);
    { const int t = tid >> 3, part = tid & 7, row = gla_row(c, t);
      f32x4 v = (f32x4){0.f, 0.f, 0.f, 0.f}; if (row >= 0) v = *(const GAS f32x4*)(SMALL + (size_t)row * 96 + 64 + 4 * part);
      *(LAS f32x4*)(GL + t * 32 + 4 * part) = v; }
    const int d = tid & 127, tq = tid >> 7, col = h * 128 + d;
#pragma unroll
    for (int r = 0; r < 16; ++r) { w.Wf[r] = wf[r * 1024 + col]; w.Wb[r] = wb[r * 1024 + col]; }
    w.biasf = bfv[col]; w.biasb = bbv[col];
    __syncthreads();
    float sF = 0.f, sB = 0.f;
#pragma unroll 2
    for (int i = 0; i < 16; ++i) { const int t = 16 * tq + i; float lf, lb; gate_lg(w, GL, t, gla_row(c, t) >= 0, lf, lb); sF += lf; sB += lb; }
    TOT[tq * 128 + d] = sF; TOT[512 + tq * 128 + d] = sB;
    __syncthreads();
    float offF = 0.f, offR = 0.f, totF = 0.f, totR = 0.f;
#pragma unroll
    for (int q = 0; q < 4; ++q) { const float a = TOT[q * 128 + d], b = TOT[512 + q * 128 + d]; totF += a; totR += b; if (q < tq) offF += a; if (q > tq) offR += b; }
    T.offF = offF; T.F63 = totF; T.sumB = sB; T.offR = offR; T.R0 = totR;
}
struct GlaW { const float *wf, *bf, *wb, *bb, *gnorm; };
__device__ __forceinline__ void stage_tile(LAS bf16* dst, const bf16* src, int ld, int col0, int c, int tid) {
#pragma unroll
    for (int k = 0; k < 2; ++k) { const int idx = tid + 512 * k, t = idx >> 4, ch = idx & 15, row = gla_row(c, t);
        u32x4 v = (u32x4){0u, 0u, 0u, 0u}; if (row >= 0) v = *(const GAS u32x4*)(src + (size_t)row * ld + col0 + 8 * ch);
        *(LAS u32x4*)(dst + t * 128 + 8 * ch) = v; }
}
constexpr int PA_K = 16384, PA_KTF = 32768, PA_KTB = PA_KTF + 128 * 132, PA_END = PA_KTB + 128 * 132;
__device__ __forceinline__ void gla_pass_a(unsigned char* ws, const GlaW& gw, LAS unsigned char* lds, int tid, int G, int bid) {
    const bf16* GK = (const bf16*)(ws + WS_GK); const bf16* GV = (const bf16*)(ws + WS_GV);
    bf16* KHTF = (bf16*)(ws + WS_KHTF); bf16* KHTB = (bf16*)(ws + WS_KHTB); bf16* VT = (bf16*)(ws + WS_VT);
    float* DLF = (float*)(ws + ST_DLF); float* DLB = (float*)(ws + ST_DLB);
    LAS float* GL = (LAS float*)lds; LAS bf16* KS = (LAS bf16*)(lds + PA_K); LAS bf16* KTF = (LAS bf16*)(lds + PA_KTF); LAS bf16* KTB = (LAS bf16*)(lds + PA_KTB);
    for (int u = bid; u < 129 * GH; u += G) {
        const int c = u >> 3, h = u & 7;
        __syncthreads();
        stage_tile(KS, GK, 1024, h * 128, c, tid);
        GateW w; GateTot T; gates_begin(w, T, ws, gw.wf, gw.bf, gw.wb, gw.bb, c, h, lds, tid);
        const int d = tid & 127, tq = tid >> 7;
        { float runF = T.offF, runB = 0.f;
#pragma unroll 2
          for (int i = 0; i < 16; ++i) { const int t = 16 * tq + i; float lf, lb; gate_lg(w, GL, t, gla_row(c, t) >= 0, lf, lb);
              runF += lf; const float R = T.offR + (T.sumB - runB); runB += lb;
              const float k = bf2f(KS[t * 128 + d]);
              KTF[d * 66 + t] = f2bf(k * __expf(T.F63 - runF)); KTB[d * 66 + t] = f2bf(k * __expf(T.R0 - R)); } }
        if (tq == 0) { DLF[(size_t)(c * GH + h) * 128 + d] = __expf(T.F63); if (c >= 1) DLB[(size_t)((c - 1) * GH + h) * 128 + d] = __expf(T.R0); }
        __syncthreads();
        { GAS unsigned* of = (GAS unsigned*)(KHTF + (size_t)(c * GH + h) * 128 * 64); GAS unsigned* ob = (GAS unsigned*)(KHTB + (size_t)((c > 0 ? c - 1 : 0) * GH + h) * 128 * 64);
#pragma unroll
          for (int k = 0; k < 8; ++k) { const int idx = tid + 512 * k, dd = idx >> 5, dw = idx & 31;
              of[idx] = *(const LAS unsigned*)(KTF + dd * 66 + 2 * dw); if (c >= 1) ob[idx] = *(const LAS unsigned*)(KTB + dd * 66 + 2 * dw); } }
        { const int e = tid & 255, th = tid >> 8; unsigned pv[16];
#pragma unroll
          for (int i = 0; i < 32; i += 2) { const int r0 = gla_row(c, 32 * th + i), r1 = gla_row(c, 32 * th + i + 1);
              const unsigned a = r0 >= 0 ? GV[(size_t)r0 * 2048 + h * 256 + e] : 0u, b = r1 >= 0 ? GV[(size_t)r1 * 2048 + h * 256 + e] : 0u; pv[i >> 1] = a | (b << 16); }
          GAS u32x4* o = (GAS u32x4*)(VT + ((size_t)(c * GH + h) * 256 + e) * 64 + 32 * th);
#pragma unroll
          for (int q = 0; q < 4; ++q) o[q] = (u32x4){pv[4 * q], pv[4 * q + 1], pv[4 * q + 2], pv[4 * q + 3]}; }
    }
}
__device__ __forceinline__ void gla_chain(unsigned char* ws, int gwave, int NGW, int lane) {
    const bf16* KHTF = (const bf16*)(ws + WS_KHTF); const bf16* KHTB = (const bf16*)(ws + WS_KHTB); const bf16* VT = (const bf16*)(ws + WS_VT);
    const float* DLF = (const float*)(ws + ST_DLF); const float* DLB = (const float*)(ws + ST_DLB); bf16* SNAP = (bf16*)(ws + WS_SNAP);
    const int l15 = lane & 15, lq = lane >> 4;
    for (int w = gwave; w < 2048; w += NGW) {
        const int dir = w >> 10, h = (w >> 7) & 7, e0 = 16 * ((w >> 3) & 15), d0 = 16 * (w & 7);
        f32x4 S = (f32x4){0.f, 0.f, 0.f, 0.f};
        bf16* snap = SNAP + (size_t)dir * 128 * GH * 256 * 128 + ((size_t)h * 256 + e0 + l15) * 128 + d0 + 4 * lq;
        const bf16* khb = (dir == 0 ? KHTF : KHTB) + ((size_t)h * 128 + d0 + l15) * 64 + 8 * lq;
        const bf16* vtb = VT + ((size_t)h * 256 + e0 + l15) * 64 + 8 * lq;
        const float* dlb = (dir == 0 ? DLF : DLB) + (size_t)h * 128 + d0 + 4 * lq;
        bf16x8 A0[4], A1[4], B0[4], B1[4]; f32x4 DV[4];
#define CH_LOAD(slot, s_) do { const int kc_ = dir == 0 ? (s_) : 127 - (s_), vc_ = dir == 0 ? (s_) : 128 - (s_); \
            const bf16* kh_ = khb + (size_t)kc_ * (GH * 128 * 64); const bf16* vt_ = vtb + (size_t)vc_ * (GH * 256 * 64); \
            A0[slot] = *(const GAS bf16x8*)kh_; A1[slot] = *(const GAS bf16x8*)(kh_ + 32); B0[slot] = *(const GAS bf16x8*)vt_; B1[slot] = *(const GAS bf16x8*)(vt_ + 32); \
            DV[slot] = *(const GAS f32x4*)(dlb + (size_t)kc_ * (GH * 128)); } while (0)
#pragma unroll
        for (int p = 0; p < 4; ++p) CH_LOAD(p, p);
        for (int sb = 0; sb < 128; sb += 4) {
#pragma unroll
            for (int p = 0; p < 4; ++p) {
                const int s = sb + p;
                if (dir == 1) *(GAS u32x2*)(snap + (size_t)(127 - s) * (GH * 256 * 128)) = (u32x2){cvtpk(S[0], S[1]), cvtpk(S[2], S[3])};
                S = S * DV[p];
                S = __builtin_amdgcn_mfma_f32_16x16x32_bf16(A0[p], B0[p], S, 0, 0, 0);
                S = __builtin_amdgcn_mfma_f32_16x16x32_bf16(A1[p], B1[p], S, 0, 0, 0);
                if (dir == 0) *(GAS u32x2*)(snap + (size_t)s * (GH * 256 * 128)) = (u32x2){cvtpk(S[0], S[1]), cvtpk(S[2], S[3])};
                if (s + 4 < 128) CH_LOAD(p, s + 4);
            }
        }
#undef CH_LOAD
    }
}
__device__ __forceinline__ int crow(int r, int hi) { return (r & 3) + 8 * (r >> 2) + 4 * hi; }
constexpr int PC_RED = 12288, PC_RN = 14336, PC_OPS = 16384, PC_OPB = 64 * 272, PC_ATT = PC_OPS + 6 * PC_OPB, PC_ATTB = 64 * 144, PC_END = PC_ATT + 2 * PC_ATTB;
constexpr int PC_STK = PC_ATT, PC_STQ = PC_STK + 16384;
static_assert(PC_END <= LDS_CTL && PC_STQ + 16384 <= LDS_CTL, "pass C LDS");
__device__ __forceinline__ void gla_pass_c(unsigned char* ws, const GlaW& gw, LAS unsigned char* lds, int tid, int G, int bid) {
    const bf16* GQ = (const bf16*)(ws + WS_GQ); const bf16* GK = (const bf16*)(ws + WS_GK); const bf16* GOG = (const bf16*)(ws + WS_GOG);
    const bf16* VT = (const bf16*)(ws + WS_VT); const bf16* SNAP = (const bf16*)(ws + WS_SNAP); bf16* AG = (bf16*)(ws + WS_AG);
    const int wave = __builtin_amdgcn_readfirstlane(tid >> 6), lane = tid & 63, r32 = lane & 31, hi = lane >> 5;
    LAS float* RED = (LAS float*)(lds + PC_RED); LAS float* RN = (LAS float*)(lds + PC_RN);
#define PC_OP(i) ((LAS bf16*)(lds + PC_OPS + (i) * PC_OPB))
#define PC_AT(i) ((LAS bf16*)(lds + PC_ATT + (i) * PC_ATTB))
    for (int u = bid; u < NXC * GH; u += G) {
        const int xc = u >> 3, h = u & 7, c = xc + 1;
        __syncthreads();
        stage_tile((LAS bf16*)(lds + PC_STK), GK, 1024, h * 128, c, tid); stage_tile((LAS bf16*)(lds + PC_STQ), GQ, 1024, h * 128, c, tid);
        GateW w; GateTot T; gates_begin(w, T, ws, gw.wf, gw.bf, gw.wb, gw.bb, c, h, lds, tid);
        { const int d = tid & 127, tq = tid >> 7; const LAS float* GL = (const LAS float*)lds; const LAS bf16* KS = (const LAS bf16*)(lds + PC_STK); const LAS bf16* QS = (const LAS bf16*)(lds + PC_STQ);
          float runF = T.offF, runB = 0.f;
#pragma unroll 2
          for (int i = 0; i < 16; ++i) { const int t = 16 * tq + i; float lf, lb; gate_lg(w, GL, t, true, lf, lb);
              runF += lf; const float R = T.offR + (T.sumB - runB); runB += lb;
              const float q = bf2f(QS[t * 128 + d]), k = bf2f(KS[t * 128 + d]);
              PC_OP(0)[t * 136 + d] = f2bf(q * __expf(runF - T.F63)); PC_OP(1)[t * 136 + d] = f2bf(k * __expf(T.F63 - runF)); PC_OP(4)[t * 136 + d] = f2bf(q * __expf(runF));
              PC_OP(2)[t * 136 + d] = f2bf(q * __expf(R - T.R0)); PC_OP(3)[t * 136 + d] = f2bf(k * __expf(T.R0 - R)); PC_OP(5)[t * 136 + d] = f2bf(q * __expf(R)); } }
        __syncthreads();
        { const int dirw = wave >> 2, ti = (wave >> 1) & 1, sj = wave & 1;
          f32x16 a = {};
          const bool live = dirw == 0 ? sj <= ti : sj >= ti;
          if (live) {
              const LAS bf16* QH = PC_OP(2 * dirw) + (32 * ti + r32) * 136 + 8 * hi; const LAS bf16* KH = PC_OP(2 * dirw + 1) + (32 * sj + r32) * 136 + 8 * hi;
#pragma unroll
              for (int ks = 0; ks < 8; ++ks) a = __builtin_amdgcn_mfma_f32_32x32x16_bf16(*(const LAS bf16x8*)(QH + 16 * ks), *(const LAS bf16x8*)(KH + 16 * ks), a, 0, 0, 0);
          }
          LAS bf16* AT = PC_AT(dirw);
#pragma unroll
          for (int r = 0; r < 16; ++r) { const int t = 32 * ti + crow(r, hi), s = 32 * sj + r32; const bool keep = dirw == 0 ? s <= t : s >= t; AT[t * 72 + s] = f2bf(keep ? a[r] : 0.f); } }
        __syncthreads();
        const int e0 = 32 * wave;
        f32x16 o0 = {}, o1 = {};
#pragma unroll
        for (int dir = 0; dir < 2; ++dir) {
            const bf16* sp = SNAP + (size_t)dir * 128 * GH * 256 * 128 + ((size_t)(xc * GH + h) * 256 + e0 + r32) * 128 + 8 * hi;
            const LAS bf16* QT = PC_OP(4 + dir) + r32 * 136 + 8 * hi;
#pragma unroll
            for (int ks = 0; ks < 8; ++ks) { if (ks == 4) SBAR(); const bf16x8 b = *(const GAS bf16x8*)(sp + 16 * ks);
                o0 = __builtin_amdgcn_mfma_f32_32x32x16_bf16(*(const LAS bf16x8*)(QT + 16 * ks), b, o0, 0, 0, 0);
                o1 = __builtin_amdgcn_mfma_f32_32x32x16_bf16(*(const LAS bf16x8*)(QT + 32 * 136 + 16 * ks), b, o1, 0, 0, 0); }
        }
        { const bf16* vp = VT + ((size_t)(c * GH + h) * 256 + e0 + r32) * 64 + 8 * hi;
#pragma unroll
          for (int dir = 0; dir < 2; ++dir) { const LAS bf16* AT = PC_AT(dir) + r32 * 72 + 8 * hi;
#pragma unroll
              for (int ks = 0; ks < 4; ++ks) { const bf16x8 b = *(const GAS bf16x8*)(vp + 16 * ks);
                  o0 = __builtin_amdgcn_mfma_f32_32x32x16_bf16(*(const LAS bf16x8*)(AT + 16 * ks), b, o0, 0, 0, 0);
                  o1 = __builtin_amdgcn_mfma_f32_32x32x16_bf16(*(const LAS bf16x8*)(AT + 32 * 72 + 16 * ks), b, o1, 0, 0, 0); } } }
#pragma unroll
        for (int r = 0; r < 16; ++r) { float s0 = o0[r] * o0[r], s1 = o1[r] * o1[r];
#pragma unroll
            for (int x = 1; x < 32; x <<= 1) { s0 += __shfl_xor(s0, x); s1 += __shfl_xor(s1, x); }
            if (r32 == 0) { RED[crow(r, hi) * 8 + wave] = s0; RED[(32 + crow(r, hi)) * 8 + wave] = s1; } }
        __syncthreads();
        if (tid < 64) { float s = 0.f;
#pragma unroll
            for (int w = 0; w < 8; ++w) s += RED[tid * 8 + w];
            RN[tid] = 1.f / sqrtf(s * (1.f / GDV) + EPS); }
        __syncthreads();
        const float gn = gw.gnorm[e0 + r32];
#pragma unroll
        for (int r = 0; r < 16; ++r) {
            const int t0 = crow(r, hi), t1 = 32 + t0; const size_t ro0 = (size_t)(64 * xc + t0) * 2048 + h * 256 + e0 + r32, ro1 = (size_t)(64 * xc + t1) * 2048 + h * 256 + e0 + r32;
            AG[ro0] = f2bf(o0[r] * RN[t0] * gn * bf2f(GOG[ro0])); AG[ro1] = f2bf(o1[r] * RN[t1] * gn * bf2f(GOG[ro1]));
        }
    }
#undef PC_OP
#undef PC_AT
}
namespace att {
constexpr int NW = 8, QBLK = 32, KVBLK = 64, NT = 130, LDQ = 3072, LDK = 3072, LDV = 2048, LDO = 2048;
constexpr float THR = 11.5f;
constexpr int SHM_V = KVBLK * 128 * 2, SHM_KN = KVBLK * 128 * 2, SHM_KR = KVBLK * 64 * 2;
constexpr int OFF_V = 0, OFF_KN = 2 * SHM_V, OFF_KR = OFF_KN + 2 * SHM_KN, OFF_WS = OFF_KR + 2 * SHM_KR, SHM_ATTN = OFF_WS + NW * 64 * 4;
#define KSWZ(row, colB) ((row) * 256 + ((colB) ^ (((row) & 7) << 4)))
#define KRSWZ(row, chunk) ((row) * 128 + ((((chunk) ^ (((row) >> 1) & 7))) << 4))
constexpr float NEG = -1e30f;
__device__ __forceinline__ void partialSM(f32x16& p0, f32x16& p1, float& m_reg, float& mn, float& alpha) {
    float pmax = p0[0];
#pragma unroll
    for (int r = 1; r < 16; ++r) pmax = fmaxf(pmax, p0[r]);
#pragma unroll
    for (int r = 0; r < 16; ++r) pmax = fmaxf(pmax, p1[r]);
    { auto rr = __builtin_amdgcn_permlane32_swap(__float_as_uint(pmax), __float_as_uint(pmax), false, false);
      pmax = fmaxf(__uint_as_float(rr[0]), __uint_as_float(rr[1])); }
    if (__builtin_expect(__all(pmax - m_reg <= THR), 1)) { mn = m_reg; alpha = 1.f; }
    else { mn = fmaxf(m_reg, pmax); alpha = __builtin_amdgcn_exp2f(m_reg - mn); m_reg = mn; }
#pragma unroll
    for (int r = 0; r < 16; ++r) p0[r] = p0[r] - mn;
#pragma unroll
    for (int r = 0; r < 16; ++r) p1[r] = p1[r] - mn;
#pragma unroll
    for (int r = 0; r < 16; ++r) p0[r] = __builtin_amdgcn_exp2f(p0[r]);
}
__device__ __forceinline__ void finishSM(f32x16& p0, f32x16& p1, float alpha, float& l_reg, bf16x8& pa0, bf16x8& pa1, bf16x8& pa2, bf16x8& pa3) {
#pragma unroll
    for (int r = 0; r < 16; ++r) p1[r] = __builtin_amdgcn_exp2f(p1[r]);
    float ps = 0;
#pragma unroll
    for (int r = 0; r < 16; ++r) ps += p0[r];
#pragma unroll
    for (int r = 0; r < 16; ++r) ps += p1[r];
    { auto rr = __builtin_amdgcn_permlane32_swap(__float_as_uint(ps), __float_as_uint(ps), false, false);
      ps = __uint_as_float(rr[0]) + __uint_as_float(rr[1]); }
    l_reg = l_reg * alpha + ps;
#define PK4(P, BASE, OUT) do { unsigned a0 = cvtpk(P[BASE + 0], P[BASE + 1]), a1 = cvtpk(P[BASE + 2], P[BASE + 3]);   \
    unsigned b0 = cvtpk(P[BASE + 4], P[BASE + 5]), b1 = cvtpk(P[BASE + 6], P[BASE + 7]);                              \
    auto r0 = __builtin_amdgcn_permlane32_swap(a0, b0, false, false); auto r1 = __builtin_amdgcn_permlane32_swap(a1, b1, false, false); \
    u32x4 w = {r0[0], r1[0], r0[1], r1[1]}; OUT = *reinterpret_cast<bf16x8*>(&w); } while (0)
    PK4(p0, 0, pa0); PK4(p0, 8, pa1); PK4(p1, 0, pa2); PK4(p1, 8, pa3);
#undef PK4
}
__device__ __forceinline__ void qkt(f32x16& p0, f32x16& p1, const LAS char* Kn, const LAS char* Kr, const bf16x8* qr, int r32, int hi) {
    p0 = f32x16{}; p1 = f32x16{};
#pragma unroll
    for (int d0 = 0; d0 < 8; ++d0) { const int cb = (d0 * 16 + hi * 8) * 2;
        const bf16x8 b0 = *(const LAS bf16x8*)(Kn + KSWZ(r32, cb)), b1 = *(const LAS bf16x8*)(Kn + KSWZ(32 + r32, cb));
        p0 = __builtin_amdgcn_mfma_f32_32x32x16_bf16(b0, qr[d0], p0, 0, 0, 0);
        p1 = __builtin_amdgcn_mfma_f32_32x32x16_bf16(b1, qr[d0], p1, 0, 0, 0); if (d0 == 3) SBAR(); }
    SBAR();
#pragma unroll
    for (int d0 = 0; d0 < 4; ++d0) { const int ch = d0 * 2 + hi;
        const bf16x8 b0 = *(const LAS bf16x8*)(Kr + KRSWZ(r32, ch)), b1 = *(const LAS bf16x8*)(Kr + KRSWZ(32 + r32, ch));
        p0 = __builtin_amdgcn_mfma_f32_32x32x16_bf16(b0, qr[8 + d0], p0, 0, 0, 0);
        p1 = __builtin_amdgcn_mfma_f32_32x32x16_bf16(b1, qr[8 + d0], p1, 0, 0, 0); }
}
template <int MODE> __device__ __forceinline__ void maskp(f32x16& p0, f32x16& p1) {
    if (MODE == 1) {
#pragma unroll
        for (int r = 8; r < 16; ++r) p0[r] = NEG;
    } else {
#pragma unroll
        for (int r = 0; r < 16; ++r) p0[r] = NEG;
    }
#pragma unroll
    for (int r = 0; r < 16; ++r) p1[r] = NEG;
}
__device__ __forceinline__ int v_st(int k, int c) { const int kk = (k & ~0xC) | ((k & 4) << 1) | ((k & 8) >> 1); return ((kk >> 3) * 4 + (c >> 5)) * 512 + ((kk & 7) * 32 + (c & 31)) * 2; }
__device__ __forceinline__ int v_rd_base(int lane) { return ((lane & 3) << 3) | (((lane >> 2) & 3) << 6) | (((lane >> 4) & 1) << 5) | (((lane >> 5) & 1) << 8); }
constexpr int v_rd_off(int d0, int ks, int half) { return d0 * 512 + ks * 4096 + half * 2048; }
template <int OFF> __device__ __forceinline__ s16x4 tr_read(int vb) {
    s16x4 r; asm volatile("ds_read_b64_tr_b16 %0, %1 offset:%2" : "=&v"(r) : "v"(vb), "i"(OFF) : "memory"); return r;
}
template <int D0> __device__ __forceinline__ void pv_one(f32x16& od, int vb, bf16x8 pa0, bf16x8 pa1, bf16x8 pa2, bf16x8 pa3) {
    const s16x4 l0 = tr_read<v_rd_off(D0, 0, 0)>(vb), h0 = tr_read<v_rd_off(D0, 0, 1)>(vb), l1 = tr_read<v_rd_off(D0, 1, 0)>(vb), h1 = tr_read<v_rd_off(D0, 1, 1)>(vb);
    const s16x4 l2 = tr_read<v_rd_off(D0, 2, 0)>(vb), h2 = tr_read<v_rd_off(D0, 2, 1)>(vb), l3 = tr_read<v_rd_off(D0, 3, 0)>(vb), h3 = tr_read<v_rd_off(D0, 3, 1)>(vb);
    asm volatile("s_waitcnt lgkmcnt(0)" ::: "memory"); SBAR();
#define PK(L, H) (bf16x8){L[0], L[1], L[2], L[3], H[0], H[1], H[2], H[3]}
    od = __builtin_amdgcn_mfma_f32_32x32x16_bf16(pa0, PK(l0, h0), od, 0, 0, 0);
    od = __builtin_amdgcn_mfma_f32_32x32x16_bf16(pa1, PK(l1, h1), od, 0, 0, 0);
    od = __builtin_amdgcn_mfma_f32_32x32x16_bf16(pa2, PK(l2, h2), od, 0, 0, 0);
    od = __builtin_amdgcn_mfma_f32_32x32x16_bf16(pa3, PK(l3, h3), od, 0, 0, 0);
#undef PK
}
__device__ __forceinline__ void pv_d0(f32x16* o, int vb, bf16x8 pa0, bf16x8 pa1, bf16x8 pa2, bf16x8 pa3) {
    pv_one<0>(o[0], vb, pa0, pa1, pa2, pa3); pv_one<1>(o[1], vb, pa0, pa1, pa2, pa3); pv_one<2>(o[2], vb, pa0, pa1, pa2, pa3); pv_one<3>(o[3], vb, pa0, pa1, pa2, pa3);
}
__device__ __forceinline__ void attn_body(const bf16* __restrict__ Qb, const bf16* __restrict__ Kh, const bf16* __restrict__ Vh, bf16* __restrict__ Ob, LAS char* lds) {
    int tid = threadIdx.x; asm volatile("" : "+v"(tid)); const int wid = tid >> 6, lane = tid & 63, r32 = lane & 31, hi = lane >> 5;
    LAS char* V_lds = lds + OFF_V; LAS char* Kn_lds = lds + OFF_KN; LAS char* Kr_lds = lds + OFF_KR;
    LAS float* wsf = (LAS float*)(lds + OFF_WS) + wid * 64; LAS float* li_l = wsf; LAS float* al_l = wsf + 32;
    float m_reg = -1e30f, l_reg = 0; f32x16 o[4] = {}; bf16x8 qr[12];
    const bf16* Qw = Qb + (long)(wid * QBLK + r32) * LDQ + hi * 8;
#pragma unroll
    for (int d0 = 0; d0 < 12; ++d0) qr[d0] = *(const GAS bf16x8*)(Qw + d0 * 16);
    const int sr = tid >> 4, sc = (tid & 15) * 8, vst0 = v_st(sr, sc), vst1 = v_st(32 + sr, sc);
    const int rr = tid >> 3, rc = tid & 7;
    const int vb0 = (int)(uintptr_t)V_lds + v_rd_base(lane);
    struct { bf16x8 vs0, vs1, ks0, ks1, kr; } sr_;
    const unsigned voV = (unsigned)(sr * LDV + sc) * 2u, voK = (unsigned)(sr * LDK + sc) * 2u, voR = (unsigned)(rr * LDK + 128 + rc * 8) * 2u;
#define SLOAD(k0) do { const char* vt_ = (const char*)Vh + (size_t)(k0) * (LDV * 2); const char* kt_ = (const char*)Kh + (size_t)(k0) * (LDK * 2); \
    sr_.vs0 = *(const GAS bf16x8*)(vt_ + voV); sr_.vs1 = *(const GAS bf16x8*)(vt_ + 32 * LDV * 2 + voV); \
    sr_.ks0 = *(const GAS bf16x8*)(kt_ + voK); sr_.ks1 = *(const GAS bf16x8*)(kt_ + 32 * LDK * 2 + voK); \
    sr_.kr = *(const GAS bf16x8*)(kt_ + voR); } while (0)
#define SWRITE(b) do { *(LAS bf16x8*)(V_lds + (b) * SHM_V + vst0) = sr_.vs0; *(LAS bf16x8*)(V_lds + (b) * SHM_V + vst1) = sr_.vs1; const int kc = sc * 2; \
    *(LAS bf16x8*)(Kn_lds + (b) * SHM_KN + KSWZ(sr, kc)) = sr_.ks0; *(LAS bf16x8*)(Kn_lds + (b) * SHM_KN + KSWZ(32 + sr, kc)) = sr_.ks1; \
    *(LAS bf16x8*)(Kr_lds + (b) * SHM_KR + KRSWZ(rr, rc)) = sr_.kr; } while (0)
#define RESC(a) do { if (__any((a) < 1.f)) { if (hi == 0) al_l[r32] = (a); asm volatile("s_waitcnt lgkmcnt(0)" ::: "memory"); \
    _Pragma("unroll") for (int d = 0; d < 4; ++d) _Pragma("unroll") for (int r = 0; r < 16; ++r) o[d][r] *= al_l[crow(r, hi)]; } } while (0)
    f32x16 p0, p1; float mn, al; bf16x8 pa0, pa1, pa2, pa3;
    SLOAD(0); VM_WAIT(); SWRITE(0); SLOAD(KVBLK); __syncthreads();
#define STEP(j, b) do { \
        SWRITE(1 - (b)); if ((j) + 2 < NT) SLOAD(((j) + 2) * KVBLK); SBAR(); \
        qkt(p0, p1, Kn_lds + (b) * SHM_KN, Kr_lds + (b) * SHM_KR, qr, r32, hi); \
        if ((j) == NT - 2) maskp<1>(p0, p1); if ((j) == NT - 1) maskp<2>(p0, p1); \
        partialSM(p0, p1, m_reg, mn, al); RESC(al); \
        finishSM(p0, p1, al, l_reg, pa0, pa1, pa2, pa3); SBAR(); \
        pv_d0(o, vb0 + (b) * SHM_V, pa0, pa1, pa2, pa3); \
        __syncthreads(); } while (0)
    for (int j = 0; j < NT; j += 2) { STEP(j, 0); STEP(j + 1, 1); }
#undef STEP
    if (hi == 0) li_l[r32] = l_reg; LDS_WAIT();
    float rli[16];
#pragma unroll
    for (int r = 0; r < 16; ++r) rli[r] = __builtin_amdgcn_rcpf(li_l[crow(r, hi)]);
    bf16* Ow = Ob + (long)(wid * QBLK) * LDO;
#pragma unroll
    for (int r = 0; r < 16; ++r) { const int orow = crow(r, hi);
#pragma unroll
        for (int d0 = 0; d0 < 4; ++d0) Ow[(long)orow * LDO + d0 * 32 + r32] = f2bf(o[d0][r] * rli[r]); }
#undef SLOAD
#undef SWRITE
#undef RESC
}
__device__ __forceinline__ void attn_phase(unsigned char* ws, LAS unsigned char* lds, int G, int bid) {
    const bf16* QM = (const bf16*)(ws + WS_QM); const bf16* KF = (const bf16*)(ws + WS_KF); const bf16* VB = (const bf16*)(ws + WS_VB); bf16* AO = (bf16*)(ws + WS_AO);
    for (int u = bid; u < MH * (SEQ / 256); u += G) {
        const int b = u & 255, r = u >> 8, h = 2 * (b & 7) + r, qb = b >> 3;
        __syncthreads();
        attn_body(QM + (size_t)(256 * qb) * 3072 + h * 192, KF + h * 192, VB + h * 128, AO + (size_t)(256 * qb) * 2048 + h * 128, (LAS char*)lds);
    }
}
}
__device__ __forceinline__ void kpe_pass(unsigned char* ws, int gw, int NGW, int lane) {
    const float* SMALL = (const float*)(ws + ST_SMALL); const float* COS = (const float*)(ws + ST_COS); const float* SIN = (const float*)(ws + ST_SIN); bf16* KF = (bf16*)(ws + WS_KF);
    const int p = lane, gp = p >> 5, fq = (p >> 3) & 3, nn = (p >> 2) & 1, j = p & 3, f = 16 * gp + 4 * fq + j;
    for (int row = gw; row < LP; row += NGW) {
        float val = 0.f;
        if (row < LTOK) {
            const int pos = row < SEQ ? row + NMETA : row - SEQ;
            const float x1 = SMALL[(size_t)row * 96 + f], x2 = SMALL[(size_t)row * 96 + 32 + f], c = COS[pos * 32 + f], s = SIN[pos * 32 + f];
            val = nn == 0 ? x1 * c - x2 * s : x1 * s + x2 * c;
        }
        const unsigned short b = f2bf(val);
#pragma unroll
        for (int h = 0; h < MH; ++h) KF[(size_t)row * 3072 + h * 192 + 128 + p] = b;
    }
}
__device__ __forceinline__ void final_norm(unsigned char* ws, float* out, const float* g, int gw, int NGW, int lane) {
    const float* SS = (const float*)(ws + ST_H2SS);
    for (int row = gw; row < SEQ; row += NGW) {
        const float s = wave_sum(SS[(size_t)row * 64 + lane]);
        const float rs = 1.f / sqrtf(s * (1.f / DM) + EPS);
        GAS f32x4* o = (GAS f32x4*)(out + (size_t)row * DM) + lane; const GAS f32x4* gp = (const GAS f32x4*)g + lane;
#pragma unroll
        for (int j = 0; j < 16; ++j) o[64 * j] = o[64 * j] * rs * gp[64 * j];
    }
}

struct Args { const float* in[20]; float* out; unsigned char* ws; int ph_lo, ph_hi; };
constexpr int NPHASE = 10;
__global__ void __launch_bounds__(NTHR, 2) mega_fwd(Args args) {
    extern __shared__ __attribute__((aligned(16))) unsigned char lds_raw[];
    LAS unsigned char* lds = (LAS unsigned char*)lds_raw;
#define FRESH_IDS() int tid = threadIdx.x; asm volatile("" : "+v"(tid)); const int lane = tid & 63, wave = __builtin_amdgcn_readfirstlane(tid >> 6), gw = bid * NWAVES + wave; (void)lane; (void)gw
    const int G = gridDim.x, bid = blockIdx.x, NGW = G * NWAVES;
    unsigned char* ws = args.ws;
    volatile LAS unsigned* MISC = (volatile LAS unsigned*)(lds + LDS_CTL);
    if (threadIdx.x < 64) MISC[threadIdx.x] = 0u;
    __syncthreads();
    XcdBarrier bar = xcd_barrier_post((unsigned*)(ws + WS_CTL) + CW_BAR, MISC + 8);
    const int lo = args.ph_lo, hi = args.ph_hi;
#ifndef PH_MASK
#define PH_MASK 0x3ff
#endif
#define IN(k) ((((PH_MASK) >> (k)) & 1) && lo <= (k) && (k) < hi)
#define SEAM(k) do { if (IN(k) && IN((k) + 1)) xcd_barrier(bar); } while (0)
    GlaW glw{args.in[4], args.in[5], args.in[6], args.in[7], args.in[8]};

    if (IN(0)) {
        P0Args a{args.in[0], args.in[1], args.in[2], args.in[3], args.in[9], args.in[10], args.in[11], args.in[12], args.in[13], args.in[14], args.in[15], args.in[16], args.in[17], args.in[18], ws};
        FRESH_IDS(); p0_prologue(a, lds, gw, NGW, wave, lane);
    }
    SEAM(0);
    if (IN(1)) {
        pg8::Gemm g{(const bf16*)(ws + WS_H0B), (const bf16*)(ws + WS_WINT), LP, NPROJ, DM}; ProjOrder S; S.init(G, bid); EpiProj E{ws};
        pg8::gemm_phase<EpiProj, ProjOrder, true, true>(lds, g, S, E);
    }
    SEAM(1);
    if (IN(2)) {
        { pg8::Gemm g{(const bf16*)(ws + WS_CQ), (const bf16*)(ws + WS_WUQT), SEQ, 3072, QRANK}; pg8::StaticOrder S; S.init(SEQ, 3072, G, bid); EpiQ E{ws};
          pg8::gemm_phase<EpiQ, pg8::StaticOrder, true, true>(lds, g, S, E); }
        { pg8::Gemm g{(const bf16*)(ws + WS_CKV), (const bf16*)(ws + WS_WUKVT), LP, 4096, KVRANK}; pg8::StaticOrder S; S.init(LP, 4096, G, bid); EpiKV E{ws};
          pg8::gemm_phase<EpiKV, pg8::StaticOrder, true, true>(lds, g, S, E); }
        { FRESH_IDS(); kpe_pass(ws, gw, NGW, lane); }
        { FRESH_IDS(); gla_pass_a(ws, glw, lds, tid, G, bid); }
    }
    SEAM(2);
    if (IN(3)) {
#ifndef NO_CHAIN
        { FRESH_IDS(); gla_chain(ws, gw, NGW, lane); }
#endif
#ifndef NO_ATT
        att::attn_phase(ws, lds, G, bid);
#endif
    }
    SEAM(3);
    if (IN(4)) { FRESH_IDS(); gla_pass_c(ws, glw, lds, tid, G, bid); }
    SEAM(4);
    if (IN(5)) {
        { pg8::Gemm g{(const bf16*)(ws + WS_AG), (const bf16*)(ws + WS_WGT), SEQ, DM, 2048}; pg8::StaticOrder S; S.init(SEQ, DM, G, bid); EpiGla E{ws};
          pg8::gemm_phase<EpiGla, pg8::StaticOrder, true, true>(lds, g, S, E); }
        { pg8::Gemm g{(const bf16*)(ws + WS_AO), (const bf16*)(ws + WS_WMT), SEQ, DM, 2048}; pg8::StaticOrder S; S.init(SEQ, DM, G, bid); EpiMla E{ws};
          pg8::gemm_phase<EpiMla, pg8::StaticOrder, true, true>(lds, g, S, E); }
    }
    SEAM(5);
    if (IN(6)) {
        pg8::Gemm g{(const bf16*)(ws + WS_MERGED), (const bf16*)(ws + WS_WOT), SEQ, DM, DM}; pg8::StaticOrder S; S.init(SEQ, DM, G, bid); EpiWo E{ws, args.in[0], args.out};
        pg8::gemm_phase<EpiWo, pg8::StaticOrder, true, true>(lds, g, S, E);
    }
    SEAM(6);
    if (IN(7)) {
        pg8::Gemm g{(const bf16*)(ws + WS_H1B), (const bf16*)(ws + WS_W1T), SEQ, DFF, DM}; pg8::StaticOrder S; S.init(SEQ, DFF, G, bid); EpiFF1 E{ws};
        pg8::gemm_phase<EpiFF1, pg8::StaticOrder, true, true>(lds, g, S, E);
    }
    SEAM(7);
    if (IN(8)) {
        pg8::Gemm g{(const bf16*)(ws + WS_U), (const bf16*)(ws + WS_W2T), SEQ, DM, DFF}; pg8::StaticOrder S; S.init(SEQ, DM, G, bid); EpiFF2 E{ws, args.out};
        pg8::gemm_phase<EpiFF2, pg8::StaticOrder, true, true>(lds, g, S, E);
    }
    SEAM(8);
    if (IN(9)) { FRESH_IDS(); final_norm(ws, args.out, args.in[19], gw, NGW, lane); }
#undef IN
#undef SEAM
}

#if defined(DBG_BISECT)
__global__ void __launch_bounds__(256) dbg_cksum(const unsigned* p, size_t nwords, unsigned* slot) {
    unsigned s = 0;
    for (size_t i = (size_t)blockIdx.x * 256 + threadIdx.x; i < nwords; i += (size_t)gridDim.x * 256) { const unsigned w = p[i]; s += w * 2654435761u + (unsigned)(i & 0xffff) * (w >> 7); }
    for (int o = 1; o < 64; o <<= 1) s += __shfl_xor(s, o);
    if ((threadIdx.x & 63) == 0) atomicAdd(slot, s);
}
__global__ void dbg_report(const unsigned* tab, int nbuf, float* out, size_t nout) {
    int first = 0;
    for (int i = 0; i < nbuf; ++i) if (tab[i] != tab[64 + i]) { first = i + 1; break; }
    for (size_t i = (size_t)blockIdx.x * blockDim.x + threadIdx.x; i < nout; i += (size_t)gridDim.x * blockDim.x) out[i] = (float)first * 1000.f;
}
struct DbgBuf { size_t off, bytes; int phase; int where; };
static const DbgBuf DBG_BUFS[] = {
    {WS_WINT, (size_t)NPROJ * DM * 2, 0, 0}, {WS_W1T, (size_t)DFF * DM * 2, 0, 0}, {WS_W2T, (size_t)DFF * DM * 2, 0, 0}, {WS_WOT, (size_t)DM * DM * 2, 0, 0},
    {WS_WGT, (size_t)DM * 2048 * 2, 0, 0}, {WS_WMT, (size_t)DM * 2048 * 2, 0, 0}, {WS_WUQT, (size_t)3072 * 1024 * 2, 0, 0}, {WS_WUKVT, (size_t)4096 * 512 * 2, 0, 0},
    {WS_H0B, (size_t)LP * DM * 2, 0, 0}, {ST_RS1, (size_t)LP * 4, 0, 0}, {ST_COS, (size_t)LTOK * 32 * 4, 0, 0}, {ST_SIN, (size_t)LTOK * 32 * 4, 0, 0},
    {WS_GQ, (size_t)SEQ * 1024 * 2, 1, 0}, {WS_GK, (size_t)LP * 1024 * 2, 1, 0}, {WS_GV, (size_t)LP * 2048 * 2, 1, 0}, {WS_GOG, (size_t)SEQ * 2048 * 2, 1, 0},
    {WS_CQ, (size_t)SEQ * 1024 * 2, 1, 0}, {WS_CKV, (size_t)LP * 512 * 2, 1, 0}, {WS_GA, (size_t)SEQ * DM * 2, 1, 0}, {WS_GB, (size_t)SEQ * DM * 2, 1, 0},
    {ST_SMALL, (size_t)LP * 96 * 4, 1, 0}, {ST_CQSS, (size_t)SEQ * 16 * 4, 1, 0}, {ST_CKVSS, (size_t)LP * 8 * 4, 1, 0},
    {WS_QM, (size_t)SEQ * 3072 * 2, 2, 0}, {WS_KF, (size_t)LP * 3072 * 2, 2, 0}, {WS_VB, (size_t)LP * 2048 * 2, 2, 0},
    {WS_KHTF, (size_t)129 * 8 * 128 * 64 * 2, 2, 0}, {WS_KHTB, (size_t)128 * 8 * 128 * 64 * 2, 2, 0}, {WS_VT, (size_t)129 * 8 * 256 * 64 * 2, 2, 0},
    {ST_DLF, (size_t)129 * 8 * 128 * 4, 2, 0}, {ST_DLB, (size_t)128 * 8 * 128 * 4, 2, 0},
    {WS_SNAP, (size_t)2 * 128 * 8 * 256 * 128 * 2, 3, 0}, {WS_AO, (size_t)SEQ * 2048 * 2, 3, 0},
    {WS_AG, (size_t)SEQ * 2048 * 2, 4, 0},
    {WS_MERGED, (size_t)SEQ * DM * 2, 5, 0},
    {0, (size_t)SEQ * DM * 4, 6, 1}, {WS_H1B, (size_t)SEQ * DM * 2, 6, 0}, {ST_H1SS, (size_t)SEQ * 64 * 4, 6, 0},
    {WS_U, (size_t)SEQ * DFF * 2, 7, 0},
    {0, (size_t)SEQ * DM * 4, 8, 1}, {ST_H2SS, (size_t)SEQ * 64 * 4, 8, 0},
    {0, (size_t)SEQ * DM * 4, 9, 1},
};
static void dbg_launch(Args a, int grid, void* d_out, void* d_ws, hipStream_t stream) {
    const int nbuf = (int)(sizeof(DBG_BUFS) / sizeof(DBG_BUFS[0]));
    unsigned* tab = (unsigned*)((char*)d_ws + WS_CTL + 65536);
    for (int run = 0; run < 2; ++run)
        for (int p = 0; p < NPHASE; ++p) {
            a.ph_lo = p; a.ph_hi = p + 1; hipLaunchKernelGGL(mega_fwd, dim3(grid), dim3(NTHR), LDS_BYTES, stream, a);
            for (int i = 0; i < nbuf; ++i) if (DBG_BUFS[i].phase == p) {
                const char* base = DBG_BUFS[i].where ? (const char*)d_out : (const char*)d_ws + DBG_BUFS[i].off;
                hipLaunchKernelGGL(dbg_cksum, dim3(1024), dim3(256), 0, stream, (const unsigned*)base, DBG_BUFS[i].bytes / 4, tab + run * 64 + i);
            }
        }
    hipLaunchKernelGGL(dbg_report, dim3(1024), dim3(256), 0, stream, (const unsigned*)tab, nbuf, (float*)d_out, (size_t)SEQ * DM);
}

#endif
#ifndef MK_N_LAUNCHES
#define MK_N_LAUNCHES 1
#endif
extern "C" void kernel_launch(void* const* d_in, const int* in_sizes, int n_in, void* d_out, int out_size, void* d_ws, size_t ws_size, hipStream_t stream) {
    static int grid = 0;
    if (grid == 0) {
        if (n_in != 20 || out_size != SEQ * DM || ws_size < WS_END) { fprintf(stderr, "kernel_launch: unexpected shapes: n_in %d out %d ws %zu (need %zu)\n", n_in, out_size, ws_size, (size_t)WS_END); grid = -1; return; }
        int dev = 0, cus = 0, per_cu = 0;
        if (hipGetDevice(&dev) != hipSuccess || hipDeviceGetAttribute(&cus, hipDeviceAttributeMultiprocessorCount, dev) != hipSuccess) { grid = -1; return; }
        if (hipFuncSetAttribute((const void*)mega_fwd, hipFuncAttributeMaxDynamicSharedMemorySize, LDS_BYTES) != hipSuccess) { fprintf(stderr, "kernel_launch: hipFuncSetAttribute failed\n"); grid = -1; return; }
        if (hipOccupancyMaxActiveBlocksPerMultiprocessor(&per_cu, (const void*)mega_fwd, NTHR, LDS_BYTES) != hipSuccess || per_cu < 1) fprintf(stderr, "kernel_launch: occupancy query says %d\n", per_cu);
        (void)hipGetLastError();
        grid = cus;
    }
    if (grid < 0) return;
    if (hipMemsetAsync((char*)d_ws + WS_CTL, 0, CTL_BYTES, stream) != hipSuccess) return;
    Args a{};
    for (int i = 0; i < 20; ++i) a.in[i] = (const float*)d_in[i];
    a.out = (float*)d_out; a.ws = (unsigned char*)d_ws;
#if defined(DBG_BISECT)
    dbg_launch(a, grid, d_out, d_ws, stream);
#elif MK_N_LAUNCHES == 1
    a.ph_lo = 0; a.ph_hi = NPHASE;
    hipLaunchKernelGGL(mega_fwd, dim3(grid), dim3(NTHR), LDS_BYTES, stream, a);
#else
    for (int p = 0; p < NPHASE; ++p) { a.ph_lo = p; a.ph_hi = p + 1; hipLaunchKernelGGL(mega_fwd, dim3(grid), dim3(NTHR), LDS_BYTES, stream, a); }
#endif
    const hipError_t le = hipPeekAtLastError();
    if (le != hipSuccess) fprintf(stderr, "kernel_launch: launch failed: %s\n", hipGetErrorName(le));
}
```

```cpp
#include <hip/hip_runtime.h>
#include <cstdio>
#include <cstdint>
namespace pg8 {
#define PG8_LAS __attribute__((address_space(3)))
typedef unsigned short bf16_t;
typedef short bf16x8 __attribute__((ext_vector_type(8)));
typedef float f32x4 __attribute__((ext_vector_type(4)));
typedef unsigned u32x4 __attribute__((ext_vector_type(4)));
constexpr int BM = 256, BK = 64, HALF = 128, HTB = HALF * BK * 2  , STAGE_BYTES = 8 * HTB, NXCD = 8, WGM = 8;

__host__ __device__ __forceinline__ int lds_byte(int r, int c) { const int st = (r >> 4) * 2 + (c >> 5), rr = r & 15, cc = c & 31, ob = rr * 64 + cc * 2; return st * 1024 + (ob ^ (((ob >> 9) & 1) << 5)); }
__host__ __device__ __forceinline__ void stage_rc(int b, int& R, int& C) { const int st = b / 1024, sb = b % 1024, swz = sb ^ (((sb >> 9) & 1) << 5); R = (st >> 1) * 16 + swz / 64; C = (st & 1) * 32 + (swz % 64) / 2; }
__host__ __device__ __forceinline__ int perm32(int rho) { const int n = rho >> 4, i = rho & 15; return 8 * (i >> 2) + 4 * n + (i & 3); }

struct Unit { int pm, pn, sel; };
struct Gemm { const bf16_t* A; const bf16_t* Bt; int M, N, K; const bf16_t* A2; const bf16_t* Bt2; int lda, ldb; };

struct StaticOrder {
    int nM, nN, nwg, G, c;
    __host__ __device__ void init(int M, int N, int G_, int c_) { nM = M / BM; nN = N / BM; nwg = nM * nN; G = G_; c = c_; }
    __host__ __device__ __forceinline__ bool next(int i, Unit& u) const {
        const long L = (long)i * G + c; if (L >= nwg) return false;
        int wgid = (int)L; { const int q = nwg / NXCD, r = nwg % NXCD, xcd = wgid % NXCD, off = wgid / NXCD; wgid = (xcd < r ? xcd * (q + 1) : r * (q + 1) + (xcd - r) * q) + off; }
        const int nig = WGM * nN, gid = wgid / nig, fm = gid * WGM, gsz = (nM - fm) < WGM ? (nM - fm) : WGM;
        u.pm = fm + ((wgid % nig) % gsz); u.pn = (wgid % nig) / gsz; return true;
    }
    __device__ __forceinline__ void a_ready(const Unit&) const {}
    __device__ __forceinline__ void done(const Unit&) const {}
};

template <class Epi, class Sched, bool ALIGN_EPI = false, bool SP2 = false>
__device__ __forceinline__ void gemm_phase(PG8_LAS unsigned char* lds, const Gemm g, const Sched& S, const Epi& E) {
    int tid = threadIdx.x; asm volatile("" : "+v"(tid)); const int wid = __builtin_amdgcn_readfirstlane(tid >> 6), lane = tid & 63, wr = wid >> 2, wc = wid & 3, fr = lane & 15, fq = lane >> 4;
    const int K = g.K, nt = K / BK, lda = g.lda ? g.lda : K, ldb = g.ldb ? g.ldb : K;
    unsigned voffA[2], voffB[2];
#pragma unroll
    for (int i = 0; i < 2; ++i) { int R, C; stage_rc(tid * 16 + i * 8192, R, C); const int Rb = Epi::PERM ? ((R & ~31) + perm32(R & 31)) : R;
        voffA[i] = (unsigned)(R * lda + C) * 2u; voffB[i] = (unsigned)(Rb * ldb + C) * 2u; }
    const size_t kstep = (size_t)(BK * 2);
    const size_t hstepA = (size_t)HALF * lda * 2, hstepB = (size_t)HALF * ldb * 2;
    const size_t tstepA = 2 * hstepA, tstepB = 2 * hstepB;
    const unsigned ldsw = (unsigned)wid * 1024u;
    const int aoff = lds_byte(wr * 64 + fr, fq * 8), boff = lds_byte(wc * 32 + fr, fq * 8);
#define PG8_SA(b, h) (((b) * 2 + (h)) * HTB)
#define PG8_SB(b, h) ((4 + (b) * 2 + (h)) * HTB)
#define PG8_STAGE(bufoff, gbase, voff) do { _Pragma("unroll") for (int _i = 0; _i < 2; ++_i) \
        asm volatile("s_mov_b32 m0, %2\n\ts_nop 0\n\tglobal_load_lds_dwordx4 %0, %1" :: "v"((voff)[_i]), "s"((const char*)(gbase)), "s"((unsigned)(uintptr_t)(lds + (bufoff) + ldsw + _i * 8192)) : "memory", "m0"); } while (0)
#define PG8_LDA(dst, b, h) do { _Pragma("unroll") for (int m = 0; m < 4; ++m) _Pragma("unroll") for (int k = 0; k < 2; ++k) dst[m][k] = *(const PG8_LAS bf16x8*)(lds + PG8_SA(b, h) + aoff + m * 2048 + k * 1024); } while (0)
#define PG8_LDB(dst, b, h) do { _Pragma("unroll") for (int n = 0; n < 2; ++n) _Pragma("unroll") for (int k = 0; k < 2; ++k) dst[n][k] = *(const PG8_LAS bf16x8*)(lds + PG8_SB(b, h) + boff + n * 2048 + k * 1024); } while (0)
#define PG8_MMA(ai, bj, At, Bt) do { __builtin_amdgcn_s_setprio(1); _Pragma("unroll") for (int m = 0; m < 4; ++m) _Pragma("unroll") for (int n = 0; n < 2; ++n) _Pragma("unroll") for (int k = 0; k < 2; ++k) \
        acc[ai][bj][m][n] = __builtin_amdgcn_mfma_f32_16x16x32_bf16(Bt[n][k], At[m][k], acc[ai][bj][m][n], 0, 0, 0); __builtin_amdgcn_s_setprio(0); } while (0)
#define PG8_WAIT_V(n) asm volatile("s_waitcnt vmcnt(" #n ")" ::: "memory")
#define PG8_WAIT_L(n) asm volatile("s_waitcnt lgkmcnt(" #n ")" ::: "memory")
#define PG8_BAR __builtin_amdgcn_s_barrier()
#define PG8_SCHED __builtin_amdgcn_sched_barrier(0)
    Unit cur, nxt; int ui = 0;
    if (!S.next(0, cur)) return;
    f32x4 acc[2][2][4][2];
#pragma unroll
    for (int a = 0; a < 2; ++a)
#pragma unroll
        for (int b = 0; b < 2; ++b)
#pragma unroll
            for (int m = 0; m < 4; ++m)
#pragma unroll
                for (int n = 0; n < 2; ++n) acc[a][b][m][n] = (f32x4){0.f, 0.f, 0.f, 0.f};
    bf16x8 At[4][2], B0[2][2], B1[2][2];
    const char* cA = (const char*)((Epi::PAIRED && cur.sel) ? g.A2 : g.A) + (size_t)cur.pm * tstepA; const char* cB = (const char*)((Epi::PAIRED && cur.sel) ? g.Bt2 : g.Bt) + (size_t)cur.pn * tstepB;
    S.a_ready(cur);
    if constexpr (SP2) {
        PG8_STAGE(PG8_SB(0, 0), cB, voffB); PG8_STAGE(PG8_SB(0, 1), cB + hstepB, voffB); PG8_STAGE(PG8_SA(0, 0), cA, voffA); PG8_STAGE(PG8_SA(0, 1), cA + hstepA, voffA);
        if (wr == 1) PG8_BAR;
        PG8_WAIT_V(2); PG8_BAR;
        PG8_STAGE(PG8_SB(1, 0), cB + kstep, voffB); PG8_STAGE(PG8_SA(1, 0), cA + kstep, voffA); PG8_STAGE(PG8_SB(1, 1), cB + hstepB + kstep, voffB);
        PG8_WAIT_V(6); PG8_BAR;
    } else {
        PG8_STAGE(PG8_SB(0, 0), cB, voffB); PG8_STAGE(PG8_SA(0, 0), cA, voffA); PG8_STAGE(PG8_SB(0, 1), cB + hstepB, voffB); PG8_STAGE(PG8_SA(0, 1), cA + hstepA, voffA);
        if (wr == 1) PG8_BAR;
        PG8_WAIT_V(4); PG8_BAR;
        PG8_STAGE(PG8_SB(1, 0), cB + kstep, voffB); PG8_STAGE(PG8_SA(1, 0), cA + kstep, voffA); PG8_STAGE(PG8_SB(1, 1), cB + hstepB + kstep, voffB);
        PG8_WAIT_V(6); PG8_BAR;
    }
    for (;;) {
        const bool has_next = S.next(ui + 1, nxt);
        const char* nA = has_next ? (const char*)((Epi::PAIRED && nxt.sel) ? g.A2 : g.A) + (size_t)nxt.pm * tstepA : cA; const char* nB = has_next ? (const char*)((Epi::PAIRED && nxt.sel) ? g.Bt2 : g.Bt) + (size_t)nxt.pn * tstepB : cB;
        for (int t = 0; t < nt; t += 2) {
            const bool last = (t == nt - 2);
            const char* a1 = cA + (size_t)(t + 1) * kstep;
            const char* a2 = last ? nA : cA + (size_t)(t + 2) * kstep; const char* b2 = last ? nB : cB + (size_t)(t + 2) * kstep;
            const char* a3 = a2 + kstep; const char* b3 = b2 + kstep;
            if (last && has_next) S.a_ready(nxt);
            if constexpr (SP2) {
            PG8_LDB(B0, 0, 0); PG8_LDB(B1, 0, 1); PG8_SCHED; PG8_LDA(At, 0, 0); PG8_STAGE(PG8_SA(1, 1), a1 + hstepA, voffA);
            PG8_WAIT_V(8); PG8_WAIT_L(0); PG8_BAR; PG8_MMA(0, 0, At, B0); PG8_MMA(0, 1, At, B1); PG8_BAR; PG8_SCHED;
            PG8_LDA(At, 0, 1); PG8_STAGE(PG8_SB(0, 0), b2, voffB); PG8_STAGE(PG8_SB(0, 1), b2 + hstepB, voffB); PG8_STAGE(PG8_SA(0, 0), a2, voffA);
            PG8_WAIT_V(8); PG8_WAIT_L(0); PG8_BAR; PG8_MMA(1, 0, At, B0); PG8_MMA(1, 1, At, B1); PG8_BAR; PG8_SCHED;
            PG8_LDB(B0, 1, 0); PG8_LDB(B1, 1, 1); PG8_SCHED; PG8_LDA(At, 1, 0); PG8_STAGE(PG8_SA(0, 1), a2 + hstepA, voffA);
            PG8_WAIT_V(8); PG8_WAIT_L(0); PG8_BAR; PG8_MMA(0, 0, At, B0); PG8_MMA(0, 1, At, B1); PG8_BAR; PG8_SCHED;
            PG8_LDA(At, 1, 1); PG8_STAGE(PG8_SB(1, 0), b3, voffB); PG8_STAGE(PG8_SB(1, 1), b3 + hstepB, voffB); PG8_STAGE(PG8_SA(1, 0), a3, voffA);
            PG8_WAIT_V(8); PG8_WAIT_L(0); PG8_BAR; PG8_MMA(1, 0, At, B0); PG8_MMA(1, 1, At, B1); PG8_BAR; PG8_SCHED;
            } else {
            PG8_LDB(B0, 0, 0); PG8_SCHED; PG8_LDA(At, 0, 0); PG8_STAGE(PG8_SA(1, 1), a1 + hstepA, voffA);
            PG8_WAIT_L(8); PG8_BAR; PG8_WAIT_L(0); PG8_MMA(0, 0, At, B0); PG8_BAR; PG8_SCHED;
            PG8_LDB(B1, 0, 1); PG8_STAGE(PG8_SB(0, 0), b2, voffB);
            PG8_BAR; PG8_WAIT_L(0); PG8_MMA(0, 1, At, B1); PG8_BAR;
            PG8_LDA(At, 0, 1); PG8_STAGE(PG8_SA(0, 0), a2, voffA);
            PG8_BAR; PG8_WAIT_L(0); PG8_MMA(1, 0, At, B0); PG8_BAR; PG8_SCHED;
            PG8_STAGE(PG8_SB(0, 1), b2 + hstepB, voffB);
            PG8_WAIT_V(6); PG8_BAR; PG8_MMA(1, 1, At, B1); PG8_BAR;
            PG8_LDB(B0, 1, 0); PG8_SCHED; PG8_LDA(At, 1, 0); PG8_STAGE(PG8_SA(0, 1), a2 + hstepA, voffA);
            PG8_WAIT_L(8); PG8_BAR; PG8_WAIT_L(0); PG8_MMA(0, 0, At, B0); PG8_BAR; PG8_SCHED;
            PG8_LDB(B1, 1, 1); PG8_STAGE(PG8_SB(1, 0), b3, voffB);
            PG8_BAR; PG8_WAIT_L(0); PG8_MMA(0, 1, At, B1); PG8_BAR;
            PG8_LDA(At, 1, 1); PG8_STAGE(PG8_SA(1, 0), a3, voffA);
            PG8_BAR; PG8_WAIT_L(0); PG8_MMA(1, 0, At, B0); PG8_BAR; PG8_SCHED;
            PG8_STAGE(PG8_SB(1, 1), b3 + hstepB, voffB);
            PG8_WAIT_V(6); PG8_BAR; PG8_MMA(1, 1, At, B1); PG8_BAR;
            }
        }
        if constexpr (ALIGN_EPI) { if (wr == 0) PG8_BAR; }
        bool keep_acc = false;
        if constexpr (Epi::PAIRED) { if (cur.sel == 0) { E.mid(acc, cur, wr, wc, fr, fq); keep_acc = true; } else { E(acc, cur, wr, wc, fr, fq); S.done(cur); } }
        else if constexpr (!Epi::AFTER_DRAIN) { E(acc, cur, wr, wc, fr, fq); S.done(cur); }
        if (!has_next) break;
        if (!keep_acc)
#pragma unroll
        for (int a = 0; a < 2; ++a)
#pragma unroll
            for (int b = 0; b < 2; ++b)
#pragma unroll
                for (int m = 0; m < 4; ++m)
#pragma unroll
                    for (int n = 0; n < 2; ++n) acc[a][b][m][n] = (f32x4){0.f, 0.f, 0.f, 0.f};
        cur = nxt; cA = nA; cB = nB; ++ui;
        if constexpr (ALIGN_EPI) { if (wr == 1) PG8_BAR; }
    }
    PG8_WAIT_V(0);
    if constexpr (!ALIGN_EPI) { if (wr == 0) PG8_BAR; }
    PG8_BAR;
    if constexpr (Epi::AFTER_DRAIN) { E.fused(acc, cur, wr, wc, fr, fq, lds, wid, lane); S.done(cur); }
#undef PG8_SA
#undef PG8_SB
#undef PG8_STAGE
#undef PG8_LDA
#undef PG8_LDB
#undef PG8_MMA
#undef PG8_WAIT_V
#undef PG8_WAIT_L
#undef PG8_BAR
#undef PG8_SCHED
}
}
#define LAS __attribute__((address_space(3)))
#define XB_TMO      128
#define XB_XCNT(j)  (256  + 64 * (j))
#define XB_XSUB(j)  (1280 + 64 * (j))
#define XB_XGEN(j)  (2304 + 64 * (j))
#define XB_TOP      3328
#define XB_TOPGEN   3392
#define XCD_BAR_WORDS 3456
#define XB_SPIN_CAP (1u << 18)

__device__ __forceinline__ unsigned xb_ld(unsigned* p)              { return __hip_atomic_load(p, __ATOMIC_RELAXED, __HIP_MEMORY_SCOPE_AGENT); }
__device__ __forceinline__ unsigned xb_add(unsigned* p, unsigned v) { return __hip_atomic_fetch_add(p, v, __ATOMIC_RELAXED, __HIP_MEMORY_SCOPE_AGENT); }
__device__ __forceinline__ unsigned xb_xcc_id() { return (unsigned)__builtin_amdgcn_s_getreg((3 << 11) | 20) & 0xFu; }
#define XB_SPIN(cond, bar) do { unsigned _sp = 0; while (cond) { __builtin_amdgcn_s_sleep(1); \
    if ((++_sp & 255u) == 0u) { if (xb_ld(&(bar)[XB_TMO])) break; if (_sp > XB_SPIN_CAP) { atomicAdd(&(bar)[XB_TMO], 1u); break; } } } } while (0)

struct XcdBarrier {
    unsigned* bar; unsigned x;
    volatile LAS unsigned* st;
};

__device__ __forceinline__ XcdBarrier xcd_barrier_post(unsigned* bar, volatile LAS unsigned* st) {
    XcdBarrier b; b.bar = bar; b.x = xb_xcc_id(); b.st = st;
    if (threadIdx.x == 0) (void)xb_add(&bar[XB_XCNT(b.x)], 1u);
    return b;
}
__device__ __forceinline__ void xcd_barrier_complete(unsigned* bar, unsigned x, unsigned& nloc, unsigned& nx) {
    const unsigned G = gridDim.x * gridDim.y * gridDim.z;
    unsigned sum, cnt, mine, sp = 0u;
    for (;;) {
        sum = 0u; cnt = 0u; mine = 0u;
#pragma unroll
        for (unsigned j = 0; j < 16; ++j) { const unsigned c = xb_ld(&bar[XB_XCNT(j)]); sum += c; cnt += (c > 0u) ? 1u : 0u; mine = (j == x) ? c : mine; }
        if (sum == G) break;
        __builtin_amdgcn_s_sleep(1);
        if ((++sp & 255u) == 0u) { if (xb_ld(&bar[XB_TMO])) break; if (sp > XB_SPIN_CAP) { atomicAdd(&bar[XB_TMO], 1u); break; } }
    }
    nloc = mine > 0u ? mine : 1u; nx = cnt > 0u ? cnt : 1u;
}

__device__ __forceinline__ void xcd_barrier(const XcdBarrier& b) {
    asm volatile("s_waitcnt vmcnt(0)" ::: "memory");
    __syncthreads();
    if (threadIdx.x == 0) {
        unsigned* bar = b.bar;
        __builtin_amdgcn_s_waitcnt(0);
        unsigned nloc = b.st[0], nx = b.st[1];
        if (nloc == 0u) { xcd_barrier_complete(bar, b.x, nloc, nx); b.st[0] = nloc; b.st[1] = nx; }
        const unsigned old = xb_add(&bar[XB_XSUB(b.x)], 1u);
        const unsigned gen = old / nloc;
        if (old + 1u == (gen + 1u) * nloc) {
            __builtin_amdgcn_fence(__ATOMIC_RELEASE, "agent");
            asm volatile("s_waitcnt vmcnt(0)" ::: "memory");
            const unsigned og = xb_add(&bar[XB_TOP], 1u);
            const unsigned tg = og / nx;
            if (og + 1u == (tg + 1u) * nx) xb_add(&bar[XB_TOPGEN], 1u);
            else XB_SPIN(xb_ld(&bar[XB_TOPGEN]) == tg, bar);
            __builtin_amdgcn_fence(__ATOMIC_ACQUIRE, "agent");
            xb_add(&bar[XB_XGEN(b.x)], 1u);
            asm volatile("s_waitcnt vmcnt(0)" ::: "memory");
        } else {
            XB_SPIN(xb_ld(&bar[XB_XGEN(b.x)]) == gen, bar);
            __builtin_amdgcn_fence(__ATOMIC_ACQUIRE, "agent");
            asm volatile("s_waitcnt vmcnt(0)" ::: "memory");
        }
    }
    __syncthreads();
}
constexpr int NWAVES = 8, NTHR = 512;
constexpr int DM = 4096, SEQ = 8192, NMETA = 16, LTOK = SEQ + NMETA  , LP = 8448  ;
constexpr int NPROJ = 16128;
constexpr int DFF = 16384;
constexpr int GH = 8, GDK = 128, GDV = 256, GCH = 64, NXC = SEQ / GCH  ;
constexpr int MH = 16, MQK = 192, MNOPE = 128, MROPE = 64, MV = 128, QRANK = 1024, KVRANK = 512;
constexpr float EPS = 1e-6f;
constexpr float GLA_QSCALE = 0.08838834764831845f;
constexpr float MLA_QSCALE = 0.07216878364870323f * 1.4426950408889634f;
constexpr size_t KiB = 1024, MiB = 1024 * 1024;
constexpr size_t WS_CTL = 0, CTL_BYTES = 1 * MiB;
constexpr size_t WS_W1T = WS_CTL + CTL_BYTES;
constexpr size_t WS_W2T = WS_W1T + (size_t)DFF * DM * 2;
constexpr size_t WS_WOT = WS_W2T + (size_t)DFF * DM * 2;
constexpr size_t WS_WGT = WS_WOT + (size_t)DM * DM * 2;
constexpr size_t WS_WMT = WS_WGT + (size_t)DM * 2048 * 2;
constexpr size_t WS_WUQT = WS_WMT + (size_t)DM * 2048 * 2;
constexpr size_t WS_WUKVT = WS_WUQT + (size_t)3072 * 1024 * 2;
constexpr size_t WS_STATS = WS_WUKVT + (size_t)4096 * 512 * 2;
constexpr size_t ST_RS1 = WS_STATS;
constexpr size_t ST_CQSS = ST_RS1 + (size_t)LP * 4;
constexpr size_t ST_CKVSS = ST_CQSS + (size_t)SEQ * 16 * 4;
constexpr size_t ST_H1SS = ST_CKVSS + (size_t)LP * 8 * 4;
constexpr size_t ST_H2SS = ST_H1SS + (size_t)SEQ * 64 * 4;
constexpr size_t ST_COS = ST_H2SS + (size_t)SEQ * 64 * 4;
constexpr size_t ST_SIN = ST_COS + (size_t)LTOK * 32 * 4;
constexpr size_t ST_DLF = ST_SIN + (size_t)LTOK * 32 * 4;
constexpr size_t ST_DLB = ST_DLF + (size_t)129 * 8 * 128 * 4;
constexpr size_t ST_SMALL = ST_DLB + (size_t)128 * 8 * 128 * 4;
constexpr size_t WS_R1 = (ST_SMALL + (size_t)LP * 96 * 4 + 4095) / 4096 * 4096;
constexpr size_t WS_WINT = WS_R1;
constexpr size_t WS_QM = WS_R1;
constexpr size_t WS_KF = WS_QM + (size_t)SEQ * 3072 * 2;
constexpr size_t WS_R2 = WS_R1 + (size_t)NPROJ * DM * 2;
static_assert(WS_KF + (size_t)LP * 3072 * 2 <= WS_R2, "R1 overlay");
constexpr size_t WS_H0B = WS_R2;
constexpr size_t WS_AO = WS_R2;
constexpr size_t WS_AG = WS_AO + (size_t)SEQ * 2048 * 2;
constexpr size_t WS_P = WS_R2 + (size_t)LP * DM * 2;
static_assert(WS_AG + (size_t)SEQ * 2048 * 2 <= WS_P, "R2 overlay");
constexpr size_t WS_GQ = WS_P;
constexpr size_t WS_GK = WS_GQ + (size_t)SEQ * 1024 * 2;
constexpr size_t WS_GV = WS_GK + (size_t)LP * 1024 * 2;
constexpr size_t WS_GOG = WS_GV + (size_t)LP * 2048 * 2;
constexpr size_t WS_MERGED = WS_P;
static_assert(WS_MERGED + (size_t)SEQ * DM * 2 <= WS_GOG, "merged overlay");
constexpr size_t WS_CQ = WS_GOG + (size_t)SEQ * 2048 * 2;
constexpr size_t WS_CKV = WS_CQ + (size_t)SEQ * 1024 * 2;
constexpr size_t WS_GA = WS_CKV + (size_t)LP * 512 * 2;
constexpr size_t WS_GB = WS_GA + (size_t)SEQ * DM * 2;
constexpr size_t WS_U = WS_R1;
constexpr size_t WS_VB = WS_GB + (size_t)SEQ * DM * 2;
constexpr int LDU = DFF;
static_assert(WS_U + (size_t)SEQ * LDU * 2 <= WS_VB, "U overlay");
constexpr size_t WS_KHTF = WS_VB + (size_t)LP * 2048 * 2;
constexpr size_t WS_KHTB = WS_KHTF + (size_t)129 * 8 * 128 * 64 * 2;
constexpr size_t WS_VT = WS_KHTB + (size_t)128 * 8 * 128 * 64 * 2;
constexpr size_t WS_SNAP = WS_VT + (size_t)129 * 8 * 256 * 64 * 2;
constexpr size_t WS_H1B = WS_SNAP;
constexpr size_t WS_END = WS_SNAP + (size_t)2 * 128 * 8 * 256 * 128 * 2;
static_assert(WS_END <= (size_t)1024 * MiB, "d_ws budget: 4 x largest tensor = 1 GiB");
constexpr int CW_PAQ = 128;
constexpr int CW_BAR = 4096;
constexpr int LDS_BYTES = 163840;
constexpr int LDS_CTL = LDS_BYTES - 256;

#define GAS __attribute__((address_space(1)))
typedef unsigned short bf16;
typedef float f32x4 __attribute__((ext_vector_type(4)));
typedef float f32x16 __attribute__((ext_vector_type(16)));
typedef short bf16x8 __attribute__((ext_vector_type(8)));
typedef short s16x4 __attribute__((ext_vector_type(4)));
typedef unsigned u32x4 __attribute__((ext_vector_type(4)));
typedef unsigned u32x2 __attribute__((ext_vector_type(2)));
#define LDS_WAIT() asm volatile("s_waitcnt lgkmcnt(0)" ::: "memory")
#define VM_WAIT() asm volatile("s_waitcnt vmcnt(0)" ::: "memory")
#define SBAR() __builtin_amdgcn_sched_barrier(0)
typedef float f32x2_ __attribute__((ext_vector_type(2)));
typedef __bf16 bf16x2_ __attribute__((ext_vector_type(2)));
__device__ __forceinline__ unsigned cvtpk(float lo, float hi) { const f32x2_ v = {lo, hi}; return __builtin_bit_cast(unsigned, __builtin_convertvector(v, bf16x2_)); }
__device__ __forceinline__ float bf2f(unsigned short b) { return __uint_as_float(((unsigned)b) << 16); }
__device__ __forceinline__ float bflo(unsigned w) { return __uint_as_float(w << 16); }
__device__ __forceinline__ float bfhi(unsigned w) { return __uint_as_float(w & 0xffff0000u); }
__device__ __forceinline__ unsigned short f2bf(float f) { return (unsigned short)(cvtpk(f, 0.f) & 0xffffu); }
__device__ __forceinline__ float wave_sum(float v) {
#pragma unroll
    for (int o = 1; o < 64; o <<= 1) v += __shfl_xor(v, o);
    return v;
}
__device__ __forceinline__ float sigmoidf_(float x) { return __builtin_amdgcn_rcpf(1.f + __expf(-x)); }
__device__ __forceinline__ float logsig16(float z) { return (fminf(z, 0.f) - __logf(1.f + __expf(-fabsf(z)))) * 0.0625f; }
template <int KIND> __device__ __forceinline__ int srccol(int n) {
    if (KIND == 1) {
        if (n < 6144) return n;
        if (n < 7168) return 6176 + (n - 6144);
        if (n < 7680) return 7200 + (n - 7168);
        if (n < 15872) return 7776 + (n - 7680);
        if (n < 15936) return 7712 + (n - 15872);
        if (n < 15968) return 6144 + (n - 15936);
        return -1;
    } else if (KIND == 2) {
        const int h = n / 192, w = n - h * 192;
        if (w < 128) return n;
        const int p = w - 128, gp = p >> 5, fq = (p >> 3) & 3, nn = (p >> 2) & 1, j = p & 3;
        return h * 192 + 128 + 32 * nn + 16 * gp + 4 * fq + j;
    }
    return n;
}
constexpr int P0_SCR = 64 * 65 * 4;
struct P0Item { const float* W; const float* gain; bf16* WT; int K, N, kind, k0, n0; };
template <int KIND> __device__ __forceinline__ void p0_load_k(const P0Item& d, f32x4 (&v)[16], int lane) {
    const int sc = srccol<KIND>(d.n0 + 4 * (lane & 15)), kr = lane >> 4;
#pragma unroll
    for (int i = 0; i < 16; ++i) v[i] = sc >= 0 ? *(const GAS f32x4*)(d.W + (size_t)(d.k0 + 4 * i + kr) * d.N + sc) : (f32x4){0.f, 0.f, 0.f, 0.f};
}
__device__ __forceinline__ void p0_load(const P0Item& d, f32x4 (&v)[16], int lane) {
    if (d.kind == 1) p0_load_k<1>(d, v, lane); else if (d.kind == 2) p0_load_k<2>(d, v, lane); else p0_load_k<0>(d, v, lane);
}
__device__ __forceinline__ void p0_finish(const P0Item& d, const f32x4 (&v)[16], LAS float* scr, int lane) {
    const int kr = lane >> 4, c4 = 4 * (lane & 15), c = lane & 7;
    f32x4 g0 = (f32x4){1.f, 1.f, 1.f, 1.f}, g1 = g0;
    if (d.gain) { g0 = *(const GAS f32x4*)(d.gain + d.k0 + 8 * c); g1 = *(const GAS f32x4*)(d.gain + d.k0 + 8 * c + 4); }
#pragma unroll
    for (int i = 0; i < 16; ++i) { LAS float* w = scr + (4 * i + kr) * 65 + c4; w[0] = v[i][0]; w[1] = v[i][1]; w[2] = v[i][2]; w[3] = v[i][3]; }
    LDS_WAIT(); asm volatile("" ::: "memory");
#pragma unroll
    for (int j = 0; j < 8; ++j) { const int n = (lane >> 3) + 8 * j; const LAS float* s = scr + (8 * c) * 65 + n;
        u32x4 o; o.x = cvtpk(s[0 * 65] * g0[0], s[1 * 65] * g0[1]); o.y = cvtpk(s[2 * 65] * g0[2], s[3 * 65] * g0[3]); o.z = cvtpk(s[4 * 65] * g1[0], s[5 * 65] * g1[1]); o.w = cvtpk(s[6 * 65] * g1[2], s[7 * 65] * g1[3]);
        *(GAS u32x4*)(d.WT + (size_t)(d.n0 + n) * d.K + d.k0 + 8 * c) = o; }
    LDS_WAIT(); asm volatile("" ::: "memory");
}
__device__ __forceinline__ void p0_mk(P0Item& d, const float* W, int K, int N, const float* gain, bf16* WT, int kind, int item, int nblk) {
    const int kb = item / nblk, nb = item - kb * nblk; d.W = W; d.gain = gain; d.WT = WT; d.K = K; d.N = N; d.kind = kind; d.k0 = 64 * kb; d.n0 = 64 * nb;
}
__device__ const double ROPE_INVF[32] = {
1.00000000000000000e+00, 7.49894209332455874e-01, 5.62341325190349073e-01, 4.21696503428582226e-01, 3.16227766016837941e-01, 2.37137370566165517e-01, 1.77827941003892293e-01, 1.33352143216332403e-01,
1.00000000000000006e-01, 7.49894209332455791e-02, 5.62341325190349114e-02, 4.21696503428582239e-02, 3.16227766016837913e-02, 2.37137370566165538e-02, 1.77827941003892293e-02, 1.33352143216332406e-02,
1.00000000000000002e-02, 7.49894209332455791e-03, 5.62341325190349097e-03, 4.21696503428582292e-03, 3.16227766016837939e-03, 2.37137370566165538e-03, 1.77827941003892275e-03, 1.33352143216332406e-03,
1.00000000000000002e-03, 7.49894209332455856e-04, 5.62341325190349097e-04, 4.21696503428582237e-04, 3.16227766016837939e-04, 2.37137370566165538e-04, 1.77827941003892270e-04, 1.33352143216332395e-04 };
__device__ __forceinline__ void rope_cs(int pos, int i, float& c, float& s) {
    const double x = (double)pos * ROPE_INVF[i];
    const double k = __builtin_rint(x * 0.15915494309189534561);
    double r = __builtin_fma(-k, 6.283185307179586, x); r = __builtin_fma(-k, 2.4492935982947064e-16, r);
    const double r2 = r * r;
    double ss = 1.0, cc = 1.0;
#pragma unroll
    for (int n = 14; n >= 1; --n) { ss = 1.0 - ss * r2 * (1.0 / (double)((2 * n) * (2 * n + 1))); cc = 1.0 - cc * r2 * (1.0 / (double)((2 * n - 1) * (2 * n))); }
    s = (float)(r * ss); c = (float)cc;
}
struct P0Args { const float *x, *meta, *ln1, *w_in, *q_norm, *w_uq, *kv_norm, *w_ukv, *w_gla_out, *w_mla_out, *w_o, *ln2, *w_ff1, *w_ff2; unsigned char* ws; };
__device__ __forceinline__ bool p0_item_early(const P0Args& a, int it, P0Item& d) {
    constexpr int I_IN = (DM / 64) * (NPROJ / 64), I_UQ = (QRANK / 64) * (3072 / 64), I_UKV = (KVRANK / 64) * (4096 / 64), NITEMS = I_IN + I_UQ + I_UKV;
    if (it >= NITEMS) return false;
    unsigned char* ws = a.ws; int r = it;
    if (r < I_IN) { p0_mk(d, a.w_in, DM, 15968, a.ln1, (bf16*)(ws + WS_WINT), 1, r, NPROJ / 64); return true; } r -= I_IN;
    if (r < I_UQ) { p0_mk(d, a.w_uq, QRANK, 3072, a.q_norm, (bf16*)(ws + WS_WUQT), 2, r, 3072 / 64); return true; } r -= I_UQ;
    p0_mk(d, a.w_ukv, KVRANK, 4096, a.kv_norm, (bf16*)(ws + WS_WUKVT), 0, r, 4096 / 64); return true;
}
__device__ __forceinline__ bool p0_item_late(const P0Args& a, int it, P0Item& d) {
    constexpr int I_F1 = (DM / 64) * (DFF / 64), I_F2 = (DFF / 64) * (DM / 64), I_O = (DM / 64) * (DM / 64), I_G = (2048 / 64) * (DM / 64), I_M = I_G, NITEMS = I_F1 + I_F2 + I_O + I_G + I_M;
    if (it >= NITEMS) return false;
    unsigned char* ws = a.ws; int r = it;
    if (r < I_G) { p0_mk(d, a.w_gla_out, 2048, DM, nullptr, (bf16*)(ws + WS_WGT), 0, r, DM / 64); return true; } r -= I_G;
    if (r < I_M) { p0_mk(d, a.w_mla_out, 2048, DM, nullptr, (bf16*)(ws + WS_WMT), 0, r, DM / 64); return true; } r -= I_M;
    if (r < I_O) { p0_mk(d, a.w_o, DM, DM, nullptr, (bf16*)(ws + WS_WOT), 0, r, DM / 64); return true; } r -= I_O;
    if (r < I_F1) { p0_mk(d, a.w_ff1, DM, DFF, a.ln2, (bf16*)(ws + WS_W1T), 0, r, DFF / 64); return true; } r -= I_F1;
    p0_mk(d, a.w_ff2, DFF, DM, nullptr, (bf16*)(ws + WS_W2T), 0, r, DM / 64); return true;
}
template <bool LATE> __device__ __forceinline__ void p0_weights(const P0Args& a, LAS unsigned char* lds, int gw, int NGW, int wave, int lane) {
    LAS float* scr = (LAS float*)(lds + wave * P0_SCR);
    P0Item cur, nxt; f32x4 va[16], vb[16];
    bool have = LATE ? p0_item_late(a, gw, cur) : p0_item_early(a, gw, cur);
    if (have) p0_load(cur, va, lane);
    for (int it = gw; have; it += 2 * NGW) {
        const bool h1 = LATE ? p0_item_late(a, it + NGW, nxt) : p0_item_early(a, it + NGW, nxt);
        if (h1) p0_load(nxt, vb, lane);
        p0_finish(cur, va, scr, lane);
        if (!h1) break;
        have = LATE ? p0_item_late(a, it + 2 * NGW, cur) : p0_item_early(a, it + 2 * NGW, cur);
        if (have) p0_load(cur, va, lane);
        p0_finish(nxt, vb, scr, lane);
    }
}
__device__ __forceinline__ void p0_weights_early(const P0Args& a, LAS unsigned char* lds, int gw, int NGW, int wave, int lane) { p0_weights<false>(a, lds, gw, NGW, wave, lane); }
__device__ __forceinline__ void p0_weights_late(const P0Args& a, LAS unsigned char* lds, int gw, int NGW, int wave, int lane) { p0_weights<true>(a, lds, gw, NGW, wave, lane); }
__device__ __forceinline__ void p0_prologue(const P0Args& a, LAS unsigned char* lds, int gw, int NGW, int wave, int lane) {
    p0_weights_early(a, lds, gw, NGW, wave, lane);
    unsigned char* ws = a.ws;
    bf16* H0B = (bf16*)(ws + WS_H0B); float* RS1 = (float*)(ws + ST_RS1);
    for (int m = gw; m < LP; m += NGW) {
        GAS u32x2* o8 = (GAS u32x2*)(H0B + (size_t)m * DM) + lane;
        if (m >= LTOK) {
#pragma unroll
            for (int j = 0; j < 16; ++j) o8[64 * j] = (u32x2){0u, 0u};
            if (lane == 0) RS1[m] = 0.f;
            continue;
        }
        const float* src = m < SEQ ? a.x + (size_t)m * DM : a.meta + (size_t)(m - SEQ) * DM;
        const GAS f32x4* xr = (const GAS f32x4*)src + lane;
        f32x4 v[16]; float s = 0.f;
#pragma unroll
        for (int j = 0; j < 16; ++j) { v[j] = xr[64 * j]; s += (v[j].x * v[j].x + v[j].y * v[j].y) + (v[j].z * v[j].z + v[j].w * v[j].w); }
        s = wave_sum(s);
        if (lane == 0) RS1[m] = 1.f / sqrtf(s * (1.f / DM) + EPS);
#pragma unroll
        for (int j = 0; j < 16; ++j) o8[64 * j] = (u32x2){cvtpk(v[j].x, v[j].y), cvtpk(v[j].z, v[j].w)};
    }
    float* COS = (float*)(ws + ST_COS); float* SIN = (float*)(ws + ST_SIN);
    for (int i = gw * 64 + lane; i < LTOK * 32; i += NGW * 64) { float c, s; rope_cs(i >> 5, i & 31, c, s); COS[i] = c; SIN[i] = s; }
}
__device__ __forceinline__ void st_bf8(bf16* p, f32x4 v0, f32x4 v1) { u32x4 w; w.x = cvtpk(v0[0], v0[1]); w.y = cvtpk(v0[2], v0[3]); w.z = cvtpk(v1[0], v1[1]); w.w = cvtpk(v1[2], v1[3]); *(GAS u32x4*)p = w; }
__device__ __forceinline__ void st_bf8_nt(bf16* p, f32x4 v0, f32x4 v1) { u32x4 w; w.x = cvtpk(v0[0], v0[1]); w.y = cvtpk(v0[2], v0[3]); w.z = cvtpk(v1[0], v1[1]); w.w = cvtpk(v1[2], v1[3]); __builtin_nontemporal_store(w, (GAS u32x4*)p); }
__device__ __forceinline__ void ld_bf8(const bf16* p, f32x4& a, f32x4& b) { const u32x4 w = *(const GAS u32x4*)p; a = (f32x4){bflo(w.x), bfhi(w.x), bflo(w.y), bfhi(w.y)}; b = (f32x4){bflo(w.z), bfhi(w.z), bflo(w.w), bfhi(w.w)}; }
__device__ __forceinline__ float dot4(f32x4 a) { return (a[0] * a[0] + a[1] * a[1]) + (a[2] * a[2] + a[3] * a[3]); }
#define EPI_ROWS(ai, m) _Pragma("unroll") for (int ai = 0; ai < 2; ++ai) _Pragma("unroll") for (int m = 0; m < 4; ++m)

struct ProjOrder {
    pg8::StaticOrder so; int G, c;
    __device__ void init(int G_, int c_) { so.init(SEQ, NPROJ, G_, c_); G = G_; c = c_; }
    __device__ bool next(int i, pg8::Unit& u) const {
        const int L = i * G + c;
        if (L < 32 * 63) { const bool ok = so.next(i, u); const int p2 = 2 * u.pn; u.pn = p2 < 63 ? p2 : p2 - 63; return ok; }
        const int e = L - 32 * 63; if (e >= 15) return false;
        u.pm = 32; u.pn = e < 12 ? 4 + e : (e == 12 ? 28 : (e == 13 ? 29 : 62)); return true;
    }
    __device__ __forceinline__ void a_ready(const pg8::Unit&) const {}
    __device__ __forceinline__ void done(const pg8::Unit&) const {}
};
struct EpiProj {
    static constexpr bool PERM = true, AFTER_DRAIN = false, PAIRED = false;
    unsigned char* ws;
    template <int MODE> __device__ __forceinline__ void body(const f32x4 (&acc)[2][2][4][2], bf16* base, int ld, int ct, float* ss, int ssld, int row0, int cl, int wc, int fq) const {
        const float* RS1 = (const float*)(ws + ST_RS1); float* SMALL = (float*)(ws + ST_SMALL);
        float rsv[2][4];
        EPI_ROWS(ai, m) rsv[ai][m] = RS1[row0 + ai * 128 + m * 16];
        EPI_ROWS(ai, m) {
            const int row = row0 + ai * 128 + m * 16; const float rs = rsv[ai][m]; float ssum = 0.f;
#pragma unroll
            for (int bj = 0; bj < 2; ++bj) {
                f32x4 v0 = acc[ai][bj][m][0] * rs, v1 = acc[ai][bj][m][1] * rs;
                if constexpr (MODE == 5) { if (bj == 0 && wc < 3) { GAS f32x4* d = (GAS f32x4*)(SMALL + (size_t)row * 96 + cl); d[0] = v0; d[1] = v1; } }
                else {
                    if constexpr (MODE == 1) { v0 = v0 * GLA_QSCALE; v1 = v1 * GLA_QSCALE; }
                    if constexpr (MODE == 2 || MODE == 3) {
                        f32x4 e0 = v0 * (-1.4426950408889634f), e1 = v1 * (-1.4426950408889634f);
#pragma unroll
                        for (int j = 0; j < 4; ++j) { e0[j] = __builtin_amdgcn_exp2f(e0[j]); e1[j] = __builtin_amdgcn_exp2f(e1[j]); }
                        asm volatile("" : "+v"(e0), "+v"(e1));
                        e0 = e0 + 1.f; e1 = e1 + 1.f;
#pragma unroll
                        for (int j = 0; j < 4; ++j) { e0[j] = __builtin_amdgcn_rcpf(e0[j]); e1[j] = __builtin_amdgcn_rcpf(e1[j]); }
                        asm volatile("" : "+v"(e0), "+v"(e1));
                        if constexpr (MODE == 2) { v0 = v0 * e0; v1 = v1 * e1; } else { v0 = e0; v1 = e1; } }
                    if constexpr (MODE == 4) ssum += dot4(v0) + dot4(v1);
                    st_bf8(base + (size_t)row * ld + ct * 256 + bj * 128 + cl, v0, v1);
                }
            }
            if constexpr (MODE == 4) { ssum += __shfl_xor(ssum, 16); ssum += __shfl_xor(ssum, 32); if (fq == 0) ss[(size_t)row * ssld + ct * 4 + wc] = ssum; }
        }
    }
    __device__ __forceinline__ void operator()(const f32x4 (&acc)[2][2][4][2], const pg8::Unit& u, int wr, int wc, int fr, int fq) const {
        const int pn = u.pn, row0 = u.pm * 256 + wr * 64 + fr, cl = wc * 32 + 8 * fq;
        int mode, ld, ct, ssld = 0; bf16* base = nullptr; float* ss = nullptr; bool xonly = true;
        if (pn < 4) { mode = 1; base = (bf16*)(ws + WS_GQ); ld = 1024; ct = pn; }
        else if (pn < 8) { mode = 0; base = (bf16*)(ws + WS_GK); ld = 1024; ct = pn - 4; xonly = false; }
        else if (pn < 16) { mode = 0; base = (bf16*)(ws + WS_GV); ld = 2048; ct = pn - 8; xonly = false; }
        else if (pn < 24) { mode = 2; base = (bf16*)(ws + WS_GOG); ld = 2048; ct = pn - 16; }
        else if (pn < 28) { mode = 4; base = (bf16*)(ws + WS_CQ); ld = 1024; ct = pn - 24; ss = (float*)(ws + ST_CQSS); ssld = 16; }
        else if (pn < 30) { mode = 4; base = (bf16*)(ws + WS_CKV); ld = 512; ct = pn - 28; ss = (float*)(ws + ST_CKVSS); ssld = 8; xonly = false; }
        else if (pn < 46) { mode = 3; base = (bf16*)(ws + WS_GA); ld = 4096; ct = pn - 30; }
        else if (pn < 62) { mode = 3; base = (bf16*)(ws + WS_GB); ld = 4096; ct = pn - 46; }
        else { mode = 5; ld = 96; ct = 0; xonly = false; }
        if (xonly && u.pm >= 32) return;
        if (mode == 3) body<3>(acc, base, ld, ct, ss, ssld, row0, cl, wc, fq);
        else if (mode == 2) body<2>(acc, base, ld, ct, ss, ssld, row0, cl, wc, fq);
        else if (mode == 0) body<0>(acc, base, ld, ct, ss, ssld, row0, cl, wc, fq);
        else if (mode == 1) body<1>(acc, base, ld, ct, ss, ssld, row0, cl, wc, fq);
        else if (mode == 4) body<4>(acc, base, ld, ct, ss, ssld, row0, cl, wc, fq);
        else body<5>(acc, base, ld, ct, ss, ssld, row0, cl, wc, fq);
    }
};
struct EpiQ {
    static constexpr bool PERM = true, AFTER_DRAIN = false, PAIRED = false;
    unsigned char* ws;
    template <bool R0, bool R1> __device__ __forceinline__ void body(const f32x4 (&acc)[2][2][4][2], int row0, int g0, int g1, int fq) const {
        const float* SS = (const float*)(ws + ST_CQSS); const float* COS = (const float*)(ws + ST_COS); const float* SIN = (const float*)(ws + ST_SIN); bf16* QM = (bf16*)(ws + WS_QM);
        const int f0 = (R0 || R1) ? 16 * ((R0 ? g0 : g1) % 6 - 4) + 4 * fq : 4 * fq;
        const int head0 = g0 / 6, gi0 = g0 - 6 * head0, head1 = g1 / 6, gi1 = g1 - 6 * head1;
#pragma unroll
        for (int ai = 0; ai < 2; ++ai) {
            f32x4 ssv[4], cv[4], sv[4];
#pragma unroll
            for (int m = 0; m < 4; ++m) { const int row = row0 + ai * 128 + m * 16; ssv[m] = *(const GAS f32x4*)(SS + (size_t)row * 16 + 4 * fq);
                if (R0 || R1) { cv[m] = *(const GAS f32x4*)(COS + (size_t)(row + NMETA) * 32 + f0); sv[m] = *(const GAS f32x4*)(SIN + (size_t)(row + NMETA) * 32 + f0); } }
            SBAR();
#pragma unroll
            for (int m = 0; m < 4; ++m) {
                const int row = row0 + ai * 128 + m * 16;
                float s = (ssv[m][0] + ssv[m][1]) + (ssv[m][2] + ssv[m][3]);
                s += __shfl_xor(s, 16); s += __shfl_xor(s, 32);
                const float rs = MLA_QSCALE / sqrtf(s * (1.f / QRANK) + EPS);
#pragma unroll
                for (int bj = 0; bj < 2; ++bj) {
                    f32x4 v0 = acc[ai][bj][m][0], v1 = acc[ai][bj][m][1];
                    if ((bj == 0 && R0) || (bj == 1 && R1)) { const f32x4 o1 = v0 * cv[m] - v1 * sv[m], o2 = v0 * sv[m] + v1 * cv[m]; v0 = o1; v1 = o2; }
                    st_bf8(QM + (size_t)row * 3072 + (bj ? head1 : head0) * 192 + (bj ? gi1 : gi0) * 32 + 8 * fq, v0 * rs, v1 * rs);
                }
            }
        }
    }
    __device__ __forceinline__ void operator()(const f32x4 (&acc)[2][2][4][2], const pg8::Unit& u, int wr, int wc, int fr, int fq) const {
        const int row0 = u.pm * 256 + wr * 64 + fr;
        const int g0 = 8 * u.pn + wc, g1 = g0 + 4;
        const bool rope0 = (g0 % 6) >= 4, rope1 = (g1 % 6) >= 4;
        if (rope0) body<true, false>(acc, row0, g0, g1, fq); else if (rope1) body<false, true>(acc, row0, g0, g1, fq); else body<false, false>(acc, row0, g0, g1, fq);
    }
};
struct EpiKV {
    static constexpr bool PERM = true, AFTER_DRAIN = false, PAIRED = false;
    unsigned char* ws;
    __device__ __forceinline__ void operator()(const f32x4 (&acc)[2][2][4][2], const pg8::Unit& u, int wr, int wc, int fr, int fq) const {
        const float* SS = (const float*)(ws + ST_CKVSS); bf16* KF = (bf16*)(ws + WS_KF); bf16* VB = (bf16*)(ws + WS_VB);
        const int row0 = u.pm * 256 + wr * 64 + fr, cl = wc * 32 + 8 * fq;
        f32x4 t0[2][4], t1[2][4];
        EPI_ROWS(ai, m) { const int row = row0 + ai * 128 + m * 16; t0[ai][m] = *(const GAS f32x4*)(SS + (size_t)row * 8); t1[ai][m] = *(const GAS f32x4*)(SS + (size_t)row * 8 + 4); }
        EPI_ROWS(ai, m) {
            const int row = row0 + ai * 128 + m * 16;
            const float s = ((t0[ai][m][0] + t0[ai][m][1]) + (t0[ai][m][2] + t0[ai][m][3])) + ((t1[ai][m][0] + t1[ai][m][1]) + (t1[ai][m][2] + t1[ai][m][3]));
            const float rs = 1.f / sqrtf(s * (1.f / KVRANK) + EPS);
            st_bf8(KF + (size_t)row * 3072 + u.pn * 192 + cl, acc[ai][0][m][0] * rs, acc[ai][0][m][1] * rs);
            st_bf8(VB + (size_t)row * 2048 + u.pn * 128 + cl, acc[ai][1][m][0] * rs, acc[ai][1][m][1] * rs);
        }
    }
};
struct EpiGla {
    static constexpr bool PERM = true, AFTER_DRAIN = false, PAIRED = false;
    unsigned char* ws;
    __device__ __forceinline__ void operator()(const f32x4 (&acc)[2][2][4][2], const pg8::Unit& u, int wr, int wc, int fr, int fq) const {
        const bf16* GA = (const bf16*)(ws + WS_GA); bf16* MG = (bf16*)(ws + WS_MERGED);
        const int row0 = u.pm * 256 + wr * 64 + fr, col0 = u.pn * 256 + wc * 32 + 8 * fq;
        u32x4 gv[2][4][2];
        EPI_ROWS(ai, m) { const size_t ro = (size_t)(row0 + ai * 128 + m * 16) * DM + col0; gv[ai][m][0] = *(const GAS u32x4*)(GA + ro); gv[ai][m][1] = *(const GAS u32x4*)(GA + ro + 128); }
        EPI_ROWS(ai, m) {
            const size_t ro = (size_t)(row0 + ai * 128 + m * 16) * DM + col0;
#pragma unroll
            for (int bj = 0; bj < 2; ++bj) { const u32x4 w = gv[ai][m][bj];
                const f32x4 g0 = (f32x4){bflo(w.x), bfhi(w.x), bflo(w.y), bfhi(w.y)}, g1 = (f32x4){bflo(w.z), bfhi(w.z), bflo(w.w), bfhi(w.w)};
                st_bf8(MG + ro + bj * 128, acc[ai][bj][m][0] * g0, acc[ai][bj][m][1] * g1); }
        }
    }
};
struct EpiMla {
    static constexpr bool PERM = true, AFTER_DRAIN = false, PAIRED = false;
    unsigned char* ws;
    __device__ __forceinline__ void operator()(const f32x4 (&acc)[2][2][4][2], const pg8::Unit& u, int wr, int wc, int fr, int fq) const {
        const bf16* GB = (const bf16*)(ws + WS_GB); bf16* MG = (bf16*)(ws + WS_MERGED);
        const int row0 = u.pm * 256 + wr * 64 + fr, col0 = u.pn * 256 + wc * 32 + 8 * fq;
#pragma unroll
        for (int ai = 0; ai < 2; ++ai) {
            u32x4 gv[4][2], pv[4][2];
#pragma unroll
            for (int m = 0; m < 4; ++m) { const size_t ro = (size_t)(row0 + ai * 128 + m * 16) * DM + col0;
                gv[m][0] = *(const GAS u32x4*)(GB + ro); gv[m][1] = *(const GAS u32x4*)(GB + ro + 128); pv[m][0] = *(const GAS u32x4*)(MG + ro); pv[m][1] = *(const GAS u32x4*)(MG + ro + 128); }
#pragma unroll
            for (int m = 0; m < 4; ++m) { const size_t ro = (size_t)(row0 + ai * 128 + m * 16) * DM + col0;
#pragma unroll
                for (int bj = 0; bj < 2; ++bj) { const u32x4 w = gv[m][bj], q = pv[m][bj];
                    const f32x4 g0 = (f32x4){bflo(w.x), bfhi(w.x), bflo(w.y), bfhi(w.y)}, g1 = (f32x4){bflo(w.z), bfhi(w.z), bflo(w.w), bfhi(w.w)};
                    const f32x4 p0 = (f32x4){bflo(q.x), bfhi(q.x), bflo(q.y), bfhi(q.y)}, p1 = (f32x4){bflo(q.z), bfhi(q.z), bflo(q.w), bfhi(q.w)};
                    st_bf8(MG + ro + bj * 128, p0 + acc[ai][bj][m][0] * g0, p1 + acc[ai][bj][m][1] * g1); } }
        }
    }
};
struct EpiWo {
    static constexpr bool PERM = true, AFTER_DRAIN = false, PAIRED = false;
    unsigned char* ws; const float* x; float* out;
    __device__ __forceinline__ void operator()(const f32x4 (&acc)[2][2][4][2], const pg8::Unit& u, int wr, int wc, int fr, int fq) const {
        bf16* H1B = (bf16*)(ws + WS_H1B); float* SS = (float*)(ws + ST_H1SS); const bf16* XB = (const bf16*)(ws + WS_H0B);
        const int row0 = u.pm * 256 + wr * 64 + fr, col0 = u.pn * 256 + wc * 32 + 8 * fq;
        u32x4 xv[2][4][2];
        EPI_ROWS(ai, m) { const size_t ro = (size_t)(row0 + ai * 128 + m * 16) * DM + col0; xv[ai][m][0] = *(const GAS u32x4*)(XB + ro); xv[ai][m][1] = *(const GAS u32x4*)(XB + ro + 128); }
        EPI_ROWS(ai, m) { const int row = row0 + ai * 128 + m * 16; const size_t ro = (size_t)row * DM + col0; float ssum = 0.f;
#pragma unroll
            for (int bj = 0; bj < 2; ++bj) { const u32x4 w = xv[ai][m][bj];
                const f32x4 x0 = (f32x4){bflo(w.x), bfhi(w.x), bflo(w.y), bfhi(w.y)}, x1 = (f32x4){bflo(w.z), bfhi(w.z), bflo(w.w), bfhi(w.w)};
                const f32x4 v0 = x0 + acc[ai][bj][m][0], v1 = x1 + acc[ai][bj][m][1];
                st_bf8(H1B + ro + bj * 128, v0, v1); ssum += dot4(v0) + dot4(v1);
            }
            ssum += __shfl_xor(ssum, 16); ssum += __shfl_xor(ssum, 32); if (fq == 0) SS[(size_t)row * 64 + u.pn * 4 + wc] = ssum; }
    }
};
constexpr int LDS_RSTAB = 131072;
struct EpiFF1 {
    static constexpr bool PERM = true, AFTER_DRAIN = false, PAIRED = false;
    unsigned char* ws; LAS unsigned char* lds; int pm0;
    __device__ __forceinline__ void operator()(const f32x4 (&acc)[2][2][4][2], const pg8::Unit& u, int wr, int wc, int fr, int fq) const {
        const float* SS = (const float*)(ws + ST_H1SS); bf16* U = (bf16*)(ws + WS_U);
        const int row0 = u.pm * 256 + wr * 64 + fr, col0 = u.pn * 256 + wc * 32 + 8 * fq;
        float rsv[2][4];
        if (u.pm == pm0) { const LAS float* T = (const LAS float*)(lds + LDS_RSTAB) + wr * 64 + fr; EPI_ROWS(ai, m) rsv[ai][m] = T[ai * 128 + m * 16]; }
        else {
            EPI_ROWS(ai, m) { const float* p = SS + (size_t)(row0 + ai * 128 + m * 16) * 64 + 16 * fq;
                const f32x4 a = *(const GAS f32x4*)p, b = *(const GAS f32x4*)(p + 4), c = *(const GAS f32x4*)(p + 8), d = *(const GAS f32x4*)(p + 12);
                float s = (((a[0] + a[1]) + (a[2] + a[3])) + ((b[0] + b[1]) + (b[2] + b[3]))) + (((c[0] + c[1]) + (c[2] + c[3])) + ((d[0] + d[1]) + (d[2] + d[3])));
                s += __shfl_xor(s, 16); s += __shfl_xor(s, 32); rsv[ai][m] = 1.f / sqrtf(s * (1.f / DM) + EPS); }
        }
        EPI_ROWS(ai, m) {
            const int row = row0 + ai * 128 + m * 16; const float rs = rsv[ai][m];
#pragma unroll
            for (int bj = 0; bj < 2; ++bj) { f32x4 v0 = acc[ai][bj][m][0] * rs, v1 = acc[ai][bj][m][1] * rs;
#pragma unroll
                for (int j = 0; j < 4; ++j) { const float a = fmaxf(v0[j], 0.f), b = fmaxf(v1[j], 0.f); v0[j] = a * a; v1[j] = b * b; }
                st_bf8(U + (size_t)row * LDU + col0 + bj * 128, v0, v1); }
        }
    }
};
__device__ __forceinline__ void ff1_rs_table(const unsigned char* ws, LAS unsigned char* lds, int pm0, int tid) {
    const float* SS = (const float*)(ws + ST_H1SS) + (size_t)(pm0 * 256 + (tid >> 1)) * 64 + 32 * (tid & 1);
    float s = 0.f;
#pragma unroll
    for (int q = 0; q < 8; ++q) { const f32x4 a = *(const GAS f32x4*)(SS + 4 * q); s += (a[0] + a[1]) + (a[2] + a[3]); }
    s += __shfl_xor(s, 1);
    if ((tid & 1) == 0) ((LAS float*)(lds + LDS_RSTAB))[tid >> 1] = 1.f / sqrtf(s * (1.f / DM) + EPS);
    __syncthreads();
}
struct EpiFF2 {
    static constexpr bool PERM = true, AFTER_DRAIN = false, PAIRED = false;
    unsigned char* ws; float* out;
    __device__ __forceinline__ void operator()(const f32x4 (&acc)[2][2][4][2], const pg8::Unit& u, int wr, int wc, int fr, int fq) const {
        float* SS = (float*)(ws + ST_H2SS); const bf16* H1B = (const bf16*)(ws + WS_H1B);
        const int row0 = u.pm * 256 + wr * 64 + fr, col0 = u.pn * 256 + wc * 32 + 8 * fq;
        u32x4 hv[2][4][2];
        EPI_ROWS(ai, m) { const size_t ro = (size_t)(row0 + ai * 128 + m * 16) * DM + col0; hv[ai][m][0] = *(const GAS u32x4*)(H1B + ro); hv[ai][m][1] = *(const GAS u32x4*)(H1B + ro + 128); }
        EPI_ROWS(ai, m) {
            const int row = row0 + ai * 128 + m * 16; const size_t ro = (size_t)row * DM + col0; float ssum = 0.f;
#pragma unroll
            for (int bj = 0; bj < 2; ++bj) { const u32x4 w = hv[ai][m][bj];
                const f32x4 h0 = (f32x4){bflo(w.x), bfhi(w.x), bflo(w.y), bfhi(w.y)}, h1 = (f32x4){bflo(w.z), bfhi(w.z), bflo(w.w), bfhi(w.w)};
                const f32x4 v0 = h0 + acc[ai][bj][m][0], v1 = h1 + acc[ai][bj][m][1];
                st_bf8((bf16*)(ws + WS_H1B) + ro + bj * 128, v0, v1); ssum += dot4(v0) + dot4(v1);
            }
            ssum += __shfl_xor(ssum, 16); ssum += __shfl_xor(ssum, 32); if (fq == 0) SS[(size_t)row * 64 + u.pn * 4 + wc] = ssum;
        }
    }
};
struct EpiNull {
    static constexpr bool PERM = true, AFTER_DRAIN = false, PAIRED = false;
    unsigned char* ws;
    __device__ __forceinline__ void operator()(const f32x4 (&acc)[2][2][4][2], const pg8::Unit& u, int wr, int wc, int fr, int fq) const {
        float s = 0.f;
        EPI_ROWS(ai, m) {
#pragma unroll
            for (int bj = 0; bj < 2; ++bj) s += dot4(acc[ai][bj][m][0]) + dot4(acc[ai][bj][m][1]); }
        if (s == 1234567.125f) ((float*)(ws + ST_H2SS))[0] = s;
    }
};

struct PairOrder {
    pg8::StaticOrder so;
    __device__ void init(int M, int N, int G_, int c_) { so.init(M, N, G_, c_); }
    __device__ __forceinline__ bool next(int i, pg8::Unit& u) const { const bool ok = so.next(i >> 1, u); u.sel = i & 1; return ok; }
    __device__ __forceinline__ void a_ready(const pg8::Unit&) const {}
    __device__ __forceinline__ void done(const pg8::Unit&) const {}
};
struct EpiMerged {
    static constexpr bool PERM = true, AFTER_DRAIN = false, PAIRED = true;
    unsigned char* ws;
    static __device__ __forceinline__ void unpack(const u32x4 w, f32x4& a, f32x4& b) { a = (f32x4){bflo(w.x), bfhi(w.x), bflo(w.y), bfhi(w.y)}; b = (f32x4){bflo(w.z), bfhi(w.z), bflo(w.w), bfhi(w.w)}; }
    __device__ __forceinline__ void mid(f32x4 (&acc)[2][2][4][2], const pg8::Unit& u, int wr, int wc, int fr, int fq) const {
        const bf16* GA = (const bf16*)(ws + WS_GA); const bf16* GB = (const bf16*)(ws + WS_GB);
        const int row0 = u.pm * 256 + wr * 64 + fr, col0 = u.pn * 256 + wc * 32 + 8 * fq;
#pragma unroll
        for (int ai = 0; ai < 2; ++ai) {
            u32x4 av[4][2], bv[4][2];
#pragma unroll
            for (int m = 0; m < 4; ++m) { const size_t ro = (size_t)(row0 + ai * 128 + m * 16) * DM + col0;
                av[m][0] = *(const GAS u32x4*)(GA + ro); av[m][1] = *(const GAS u32x4*)(GA + ro + 128); bv[m][0] = *(const GAS u32x4*)(GB + ro); bv[m][1] = *(const GAS u32x4*)(GB + ro + 128); }
#pragma unroll
            for (int m = 0; m < 4; ++m)
#pragma unroll
                for (int bj = 0; bj < 2; ++bj) { f32x4 a0, a1, b0, b1; unpack(av[m][bj], a0, a1); unpack(bv[m][bj], b0, b1);
#pragma unroll
                    for (int j = 0; j < 4; ++j) { acc[ai][bj][m][0][j] *= a0[j] * __builtin_amdgcn_rcpf(fmaxf(b0[j], 1e-6f)); acc[ai][bj][m][1][j] *= a1[j] * __builtin_amdgcn_rcpf(fmaxf(b1[j], 1e-6f)); } }
        }
    }
    __device__ __forceinline__ void operator()(const f32x4 (&acc)[2][2][4][2], const pg8::Unit& u, int wr, int wc, int fr, int fq) const {
        const bf16* GB = (const bf16*)(ws + WS_GB); bf16* MG = (bf16*)(ws + WS_MERGED);
        const int row0 = u.pm * 256 + wr * 64 + fr, col0 = u.pn * 256 + wc * 32 + 8 * fq;
        u32x4 bv[2][4][2];
        EPI_ROWS(ai, m) { const size_t ro = (size_t)(row0 + ai * 128 + m * 16) * DM + col0; bv[ai][m][0] = *(const GAS u32x4*)(GB + ro); bv[ai][m][1] = *(const GAS u32x4*)(GB + ro + 128); }
        EPI_ROWS(ai, m) { const size_t ro = (size_t)(row0 + ai * 128 + m * 16) * DM + col0;
#pragma unroll
            for (int bj = 0; bj < 2; ++bj) { f32x4 b0, b1; unpack(bv[ai][m][bj], b0, b1);
#pragma unroll
                for (int j = 0; j < 4; ++j) { b0[j] = fmaxf(b0[j], 1e-6f); b1[j] = fmaxf(b1[j], 1e-6f); }
                st_bf8(MG + ro + bj * 128, acc[ai][bj][m][0] * b0, acc[ai][bj][m][1] * b1); } }
    }
};
__device__ __forceinline__ int gla_row(int c, int t) { return c == 0 ? (t < 48 ? -1 : SEQ + (t - 48)) : 64 * (c - 1) + t; }

struct GateW { float Wf[16], Wb[16], biasf, biasb; };
__device__ __forceinline__ void gate_lg(const GateW& w, const LAS float* GL, int t, bool valid, float& lgf, float& lgb) {
    float zf = w.biasf, zb = w.biasb;
#pragma unroll
    for (int q = 0; q < 4; ++q) { const f32x4 gf = *(const LAS f32x4*)(GL + t * 32 + 4 * q), gb = *(const LAS f32x4*)(GL + t * 32 + 16 + 4 * q);
#pragma unroll
        for (int j = 0; j < 4; ++j) { zf = fmaf(gf[j], w.Wf[4 * q + j], zf); zb = fmaf(gb[j], w.Wb[4 * q + j], zb); } }
    lgf = valid ? logsig16(zf) : 0.f; lgb = valid ? logsig16(zb) : 0.f;
}
struct GateTot { float offF, F63, sumB, offR, R0; };
__device__ __forceinline__ void gates_begin(GateW& w, GateTot& T, const unsigned char* ws, const float* wf, const float* bfv, const float* wb, const float* bbv, int c, int h, LAS unsigned char* lds, int tid) {
    const float* SMALL = (const float*)(ws + ST_SMALL);
    LAS float* GL = (LAS float*)lds; LAS float* TOT = (LAS float*)(lds + 8192);
    { const int t = tid >> 3, part = tid & 7, row = gla_row(c, t);
      f32x4 v = (f32x4){0.f, 0.f, 0.f, 0.f}; if (row >= 0) v = *(const GAS f32x4*)(SMALL + (size_t)row * 96 + 64 + 4 * part);
      *(LAS f32x4*)(GL + t * 32 + 4 * part) = v; }
    const int d = tid & 127, tq = tid >> 7, col = h * 128 + d;
#pragma unroll
    for (int r = 0; r < 16; ++r) { w.Wf[r] = wf[r * 1024 + col]; w.Wb[r] = wb[r * 1024 + col]; }
    w.biasf = bfv[col]; w.biasb = bbv[col];
    __syncthreads();
    float sF = 0.f, sB = 0.f;
#pragma unroll 2
    for (int i = 0; i < 16; ++i) { const int t = 16 * tq + i; float lf, lb; gate_lg(w, GL, t, gla_row(c, t) >= 0, lf, lb); sF += lf; sB += lb; }
    TOT[tq * 128 + d] = sF; TOT[512 + tq * 128 + d] = sB;
    __syncthreads();
    float offF = 0.f, offR = 0.f, totF = 0.f, totR = 0.f;
#pragma unroll
    for (int q = 0; q < 4; ++q) { const float a = TOT[q * 128 + d], b = TOT[512 + q * 128 + d]; totF += a; totR += b; if (q < tq) offF += a; if (q > tq) offR += b; }
    T.offF = offF; T.F63 = totF; T.sumB = sB; T.offR = offR; T.R0 = totR;
}
struct GlaW { const float *wf, *bf, *wb, *bb, *gnorm; };
__device__ __forceinline__ void stage_tile(LAS bf16* dst, const bf16* src, int ld, int col0, int c, int tid) {
#pragma unroll
    for (int k = 0; k < 2; ++k) { const int idx = tid + 512 * k, t = idx >> 4, ch = idx & 15, row = gla_row(c, t);
        u32x4 v = (u32x4){0u, 0u, 0u, 0u}; if (row >= 0) v = *(const GAS u32x4*)(src + (size_t)row * ld + col0 + 8 * ch);
        *(LAS u32x4*)(dst + t * 128 + 8 * ch) = v; }
}
constexpr int PA_K = 16384, PA_KTF = 32768, PA_KTB = PA_KTF + 128 * 132, PA_LG = PA_KTB + 128 * 132, PA_VS = PA_LG, PA_VSS = 264;
static_assert(PA_LG + 2 * 64 * 128 * 4 <= LDS_CTL && PA_VS + 64 * PA_VSS * 2 <= LDS_CTL, "pass A LDS");
__device__ __forceinline__ void gla_pass_a(unsigned char* ws, const GlaW& gw, LAS unsigned char* lds, int tid, int G, int bid, float* LG) {
    const bf16* GK = (const bf16*)(ws + WS_GK); const bf16* GV = (const bf16*)(ws + WS_GV); const float* SMALL = (const float*)(ws + ST_SMALL);
    bf16* KHTF = (bf16*)(ws + WS_KHTF); bf16* KHTB = (bf16*)(ws + WS_KHTB); bf16* VT = (bf16*)(ws + WS_VT);
    float* DLF = (float*)(ws + ST_DLF); float* DLB = (float*)(ws + ST_DLB);
    LAS float* GL = (LAS float*)lds; LAS float* TOT = (LAS float*)(lds + 8192); LAS bf16* KS = (LAS bf16*)(lds + PA_K); LAS bf16* KTF = (LAS bf16*)(lds + PA_KTF); LAS bf16* KTB = (LAS bf16*)(lds + PA_KTB);
    LAS float* LGC = (LAS float*)(lds + PA_LG); LAS bf16* VS = (LAS bf16*)(lds + PA_VS);
    LAS volatile int* UQ = (LAS volatile int*)(lds + 12288);
    unsigned* ctr = (unsigned*)(ws + WS_CTL) + CW_PAQ;
    for (;;) {
        __syncthreads();
        if (tid == 0) *UQ = (int)__hip_atomic_fetch_add(ctr, 1u, __ATOMIC_RELAXED, __HIP_MEMORY_SCOPE_AGENT);
        __syncthreads();
        const int u = *UQ; if (u >= NXC * GH + GH) break;
        const bool meta = u >= NXC * GH;
        const int c = meta ? 0 : 1 + (u >> 3), h = meta ? u - NXC * GH : (u & 7);
        const int d = tid & 127, tq = tid >> 7, col = h * 128 + d;
        __syncthreads();
        u32x4 vreg[4];
#pragma unroll
        for (int q = 0; q < 4; ++q) { const int idx = tid + 512 * q, t = idx >> 5, ch = idx & 31, row = gla_row(c, t);
            vreg[q] = (u32x4){0u, 0u, 0u, 0u}; if (row >= 0) vreg[q] = *(const GAS u32x4*)(GV + (size_t)row * 2048 + h * 256 + 8 * ch); }
        stage_tile(KS, GK, 1024, h * 128, c, tid);
        { const int t = tid >> 3, part = tid & 7, row = gla_row(c, t);
          f32x4 v = (f32x4){0.f, 0.f, 0.f, 0.f}; if (row >= 0) v = *(const GAS f32x4*)(SMALL + (size_t)row * 96 + 64 + 4 * part);
          *(LAS f32x4*)(GL + t * 32 + 4 * part) = v; }
        GateW w;
#pragma unroll
        for (int r = 0; r < 16; ++r) { w.Wf[r] = gw.wf[r * 1024 + col]; w.Wb[r] = gw.wb[r * 1024 + col]; }
        w.biasf = gw.bf[col]; w.biasb = gw.bb[col];
        __syncthreads();
        float sF = 0.f, sB = 0.f;
#pragma unroll 2
        for (int i = 0; i < 16; ++i) { const int t = 16 * tq + i, row = gla_row(c, t); float lf, lb; gate_lg(w, GL, t, row >= 0, lf, lb); sF += lf; sB += lb;
            LGC[t * 128 + d] = lf; LGC[8192 + t * 128 + d] = lb;
            if (c >= 1) { LG[(size_t)row * 1024 + col] = lf; LG[(size_t)SEQ * 1024 + (size_t)row * 1024 + col] = lb; } }
        TOT[tq * 128 + d] = sF; TOT[512 + tq * 128 + d] = sB;
        __syncthreads();
        float offF = 0.f, offR = 0.f, F63 = 0.f, R0 = 0.f;
#pragma unroll
        for (int q = 0; q < 4; ++q) { const float a = TOT[q * 128 + d], b2 = TOT[512 + q * 128 + d]; F63 += a; R0 += b2; if (q < tq) offF += a; if (q > tq) offR += b2; }
        { float runF = offF, runB = 0.f;
#pragma unroll 4
          for (int i = 0; i < 16; ++i) { const int t = 16 * tq + i; const float lf = LGC[t * 128 + d], lb = LGC[8192 + t * 128 + d];
              runF += lf; const float R = offR + (sB - runB); runB += lb;
              const float kv = bf2f(KS[t * 128 + d]);
              KTF[d * 66 + t] = f2bf(kv * __expf(F63 - runF)); KTB[d * 66 + t] = f2bf(kv * __expf(R0 - R)); } }
        if (tq == 0) { DLF[(size_t)(c * GH + h) * 128 + d] = __expf(F63); if (c >= 1) DLB[(size_t)((c - 1) * GH + h) * 128 + d] = __expf(R0); }
        __syncthreads();
#pragma unroll
        for (int q = 0; q < 4; ++q) { const int idx = tid + 512 * q, t = idx >> 5, ch = idx & 31; *(LAS u32x4*)(VS + t * PA_VSS + 8 * ch) = vreg[q]; }
        { GAS unsigned* of = (GAS unsigned*)(KHTF + (size_t)(c * GH + h) * 128 * 64); GAS unsigned* ob = (GAS unsigned*)(KHTB + (size_t)((c > 0 ? c - 1 : 0) * GH + h) * 128 * 64);
#pragma unroll
          for (int q = 0; q < 8; ++q) { const int idx = tid + 512 * q, dd = idx >> 5, dw = idx & 31;
              of[idx] = *(const LAS unsigned*)(KTF + dd * 66 + 2 * dw); if (c >= 1) ob[idx] = *(const LAS unsigned*)(KTB + dd * 66 + 2 * dw); } }
        __syncthreads();
        { const int e = tid & 255, th = tid >> 8; unsigned pv[16];
#pragma unroll
          for (int i = 0; i < 32; i += 2) { const unsigned a = VS[(32 * th + i) * PA_VSS + e], b2 = VS[(32 * th + i + 1) * PA_VSS + e]; pv[i >> 1] = a | (b2 << 16); }
          GAS u32x4* o = (GAS u32x4*)(VT + ((size_t)(c * GH + h) * 256 + e) * 64 + 32 * th);
#pragma unroll
          for (int q = 0; q < 4; ++q) o[q] = (u32x4){pv[4 * q], pv[4 * q + 1], pv[4 * q + 2], pv[4 * q + 3]}; }
    }
}
__device__ __forceinline__ void gla_chain(unsigned char* ws, int bid, int G, int wave, int lane) {
    const bf16* KHTF = (const bf16*)(ws + WS_KHTF); const bf16* KHTB = (const bf16*)(ws + WS_KHTB); const bf16* VT = (const bf16*)(ws + WS_VT);
    const float* DLF = (const float*)(ws + ST_DLF); const float* DLB = (const float*)(ws + ST_DLB); bf16* SNAP = (bf16*)(ws + WS_SNAP);
    const int r32 = lane & 31, hi = lane >> 5;
    for (int wc = bid * 2 + wave; wc < 512; wc += G * 2) {
        const int dir = wc >> 8, h = (wc >> 5) & 7, e0 = 32 * ((wc >> 2) & 7), d0 = 32 * (wc & 3);
        f32x16 S = {};
        bf16* snap = SNAP + (size_t)dir * 128 * GH * 256 * 128 + ((size_t)h * 256 + e0 + r32) * 128 + d0 + 4 * hi;
        const bf16* khb = (dir == 0 ? KHTF : KHTB) + ((size_t)h * 128 + d0 + r32) * 64 + 8 * hi;
        const bf16* vtb = VT + ((size_t)h * 256 + e0 + r32) * 64 + 8 * hi;
        const float* dlb = (dir == 0 ? DLF : DLB) + (size_t)h * 128 + d0 + 4 * hi;
        constexpr int PD = 3;
        bf16x8 A[PD][4], B[PD][4]; f32x4 DV[PD][4];
#define CH_LOAD(slot, s_) do { const int kc_ = dir == 0 ? (s_) : 127 - (s_), vc_ = dir == 0 ? (s_) : 128 - (s_); \
            const bf16* kh_ = khb + (size_t)kc_ * (GH * 128 * 64); const bf16* vt_ = vtb + (size_t)vc_ * (GH * 256 * 64); const float* dl_ = dlb + (size_t)kc_ * (GH * 128); \
            _Pragma("unroll") for (int q_ = 0; q_ < 4; ++q_) { A[slot][q_] = *(const GAS bf16x8*)(kh_ + 16 * q_); B[slot][q_] = *(const GAS bf16x8*)(vt_ + 16 * q_); DV[slot][q_] = *(const GAS f32x4*)(dl_ + 8 * q_); } } while (0)
#define CH_STORE(xc_) do { bf16* sp_ = snap + (size_t)(xc_) * (GH * 256 * 128); \
            _Pragma("unroll") for (int g_ = 0; g_ < 4; ++g_) *(GAS u32x2*)(sp_ + 8 * g_) = (u32x2){cvtpk(S[4 * g_], S[4 * g_ + 1]), cvtpk(S[4 * g_ + 2], S[4 * g_ + 3])}; } while (0)
#pragma unroll
        for (int p = 0; p < PD; ++p) CH_LOAD(p, p);
        if (dir == 1) CH_STORE(127);
        for (int sb = 0; sb < 129; sb += PD) {
#pragma unroll
            for (int p = 0; p < PD; ++p) {
                const int s = sb + p;
                if (s < 128) {
#pragma unroll
                    for (int g = 0; g < 4; ++g) { S[4 * g] *= DV[p][g][0]; S[4 * g + 1] *= DV[p][g][1]; S[4 * g + 2] *= DV[p][g][2]; S[4 * g + 3] *= DV[p][g][3]; }
#pragma unroll
                    for (int q = 0; q < 4; ++q) S = __builtin_amdgcn_mfma_f32_32x32x16_bf16(A[p][q], B[p][q], S, 0, 0, 0);
                    if (s + PD < 128) CH_LOAD(p, s + PD);
                    if (dir == 0) CH_STORE(s); else if (s < 127) CH_STORE(126 - s);
                }
            }
        }
#undef CH_LOAD
#undef CH_STORE
    }
}
__device__ __forceinline__ int crow(int r, int hi) { return (r & 3) + 8 * (r >> 2) + 4 * hi; }
constexpr int PC_OPS = 16384, PC_OPB = 64 * 272, PC_ATT = PC_OPS + 6 * PC_OPB, PC_ATTB = 64 * 144, PC_END = PC_ATT + 2 * PC_ATTB;
constexpr int PC_STK = PC_ATT, PC_STQ = PC_STK + 16384;
constexpr int PC_OT = PC_OPS, PC_OTS = 260;
static_assert(PC_END <= LDS_CTL && PC_STQ + 16384 <= LDS_CTL && PC_OT + 64 * PC_OTS * 4 <= PC_ATT, "pass C LDS");
template <int PV> __device__ __forceinline__ void gla_pass_c(unsigned char* ws, const GlaW& gw, LAS unsigned char* lds, int tid, int G, int bid, bf16* AGout, const float* LG) {
    const bf16* GQ = (const bf16*)(ws + WS_GQ); const bf16* GK = (const bf16*)(ws + WS_GK); const bf16* GOG = (const bf16*)(ws + WS_GOG);
    const bf16* VT = (const bf16*)(ws + WS_VT); const bf16* SNAP = (const bf16*)(ws + WS_SNAP); bf16* AG = AGout;
    const int wave = __builtin_amdgcn_readfirstlane(tid >> 6), lane = tid & 63, r32 = lane & 31, hi = lane >> 5;
#define PC_OP(i) ((LAS bf16*)(lds + PC_OPS + (i) * PC_OPB))
#define PC_AT(i) ((LAS bf16*)(lds + PC_ATT + (i) * PC_ATTB))
    for (int u = bid; u < NXC * GH; u += G) {
        const int xc = u >> 3, h = u & 7, c = xc + 1, e0 = 32 * wave;
        __syncthreads();
        const int d = tid & 127, tq = tid >> 7;
        float lgf[16], lgb[16];
        { const float* lp = LG + (size_t)(64 * xc + 16 * tq) * 1024 + h * 128 + d;
#pragma unroll
          for (int i = 0; i < 16; ++i) { lgf[i] = lp[(size_t)i * 1024]; lgb[i] = lp[(size_t)SEQ * 1024 + (size_t)i * 1024]; } }
        stage_tile((LAS bf16*)(lds + PC_STK), GK, 1024, h * 128, c, tid); stage_tile((LAS bf16*)(lds + PC_STQ), GQ, 1024, h * 128, c, tid);
        LAS float* TOT = (LAS float*)(lds + 8192);
#pragma unroll
        for (int i = 1; i < 16; ++i) lgf[i] += lgf[i - 1];
#pragma unroll
        for (int i = 14; i >= 0; --i) lgb[i] += lgb[i + 1];
        TOT[tq * 128 + d] = lgf[15]; TOT[512 + tq * 128 + d] = lgb[0];
        __syncthreads();
        { float offF = 0.f, offR = 0.f, F63 = 0.f, R0 = 0.f;
#pragma unroll
          for (int q = 0; q < 4; ++q) { const float a = TOT[q * 128 + d], b2 = TOT[512 + q * 128 + d]; F63 += a; R0 += b2; if (q < tq) offF += a; if (q > tq) offR += b2; }
          const LAS bf16* KS = (const LAS bf16*)(lds + PC_STK); const LAS bf16* QS = (const LAS bf16*)(lds + PC_STQ);
          const float dF = __expf(F63), dR = __expf(R0);
#pragma unroll
          for (int i = 0; i < 16; ++i) { const int t = 16 * tq + i; const float F = lgf[i] + offF, R = lgb[i] + offR;
              const float q = bf2f(QS[t * 128 + d]), kv = bf2f(KS[t * 128 + d]);
              const float ef = __expf(F - F63), er = __expf(R - R0), qf = q * ef, qr2 = q * er;
              PC_OP(0)[t * 136 + d] = f2bf(qf); PC_OP(1)[t * 136 + d] = f2bf(kv * __builtin_amdgcn_rcpf(ef)); PC_OP(4)[t * 136 + d] = f2bf(qf * dF);
              PC_OP(2)[t * 136 + d] = f2bf(qr2); PC_OP(3)[t * 136 + d] = f2bf(kv * __builtin_amdgcn_rcpf(er)); PC_OP(5)[t * 136 + d] = f2bf(qr2 * dR); } }
        __syncthreads();
        bf16x8 sfr[2][8], vfr[4];
#pragma unroll
        for (int dir = 0; dir < 2; ++dir) { const bf16* sp = SNAP + (size_t)dir * 128 * GH * 256 * 128 + ((size_t)(xc * GH + h) * 256 + e0 + r32) * 128 + 8 * hi;
#pragma unroll
            for (int ks = 0; ks < 8; ++ks) sfr[dir][ks] = *(const GAS bf16x8*)(sp + 16 * ks); }
        { const bf16* vp = VT + ((size_t)(c * GH + h) * 256 + e0 + r32) * 64 + 8 * hi;
#pragma unroll
          for (int ks = 0; ks < 4; ++ks) vfr[ks] = *(const GAS bf16x8*)(vp + 16 * ks); }
        { const int dirw = wave >> 2, ti = (wave >> 1) & 1, sj = wave & 1;
          f32x16 a = {};
          const bool live = dirw == 0 ? sj <= ti : sj >= ti;
          if (live) {
              const LAS bf16* QH = PC_OP(2 * dirw) + (32 * ti + r32) * 136 + 8 * hi; const LAS bf16* KH = PC_OP(2 * dirw + 1) + (32 * sj + r32) * 136 + 8 * hi;
#pragma unroll
              for (int ks = 0; ks < 8; ++ks) a = __builtin_amdgcn_mfma_f32_32x32x16_bf16(*(const LAS bf16x8*)(QH + 16 * ks), *(const LAS bf16x8*)(KH + 16 * ks), a, 0, 0, 0);
          }
          LAS bf16* AT = PC_AT(dirw);
#pragma unroll
          for (int r = 0; r < 16; ++r) { const int t = 32 * ti + crow(r, hi), s2 = 32 * sj + r32; const bool keep = dirw == 0 ? s2 <= t : s2 >= t; AT[t * 72 + s2] = f2bf(keep ? a[r] : 0.f); } }
        __syncthreads();
        f32x16 o0 = {}, o1 = {};
#pragma unroll
        for (int dir = 0; dir < 2; ++dir) {
            const LAS bf16* QT = PC_OP(4 + dir) + r32 * 136 + 8 * hi;
#pragma unroll
            for (int ks = 0; ks < 8; ++ks) {
                o0 = __builtin_amdgcn_mfma_f32_32x32x16_bf16(*(const LAS bf16x8*)(QT + 16 * ks), sfr[dir][ks], o0, 0, 0, 0);
                o1 = __builtin_amdgcn_mfma_f32_32x32x16_bf16(*(const LAS bf16x8*)(QT + 32 * 136 + 16 * ks), sfr[dir][ks], o1, 0, 0, 0); }
        }
#pragma unroll
        for (int dir = 0; dir < 2; ++dir) { const LAS bf16* AT = PC_AT(dir) + r32 * 72 + 8 * hi;
#pragma unroll
            for (int ks = 0; ks < 4; ++ks) {
                o0 = __builtin_amdgcn_mfma_f32_32x32x16_bf16(*(const LAS bf16x8*)(AT + 16 * ks), vfr[ks], o0, 0, 0, 0);
                o1 = __builtin_amdgcn_mfma_f32_32x32x16_bf16(*(const LAS bf16x8*)(AT + 32 * 72 + 16 * ks), vfr[ks], o1, 0, 0, 0); } }
        __syncthreads();
        { LAS float* OT = (LAS float*)(lds + PC_OT);
#pragma unroll
          for (int r = 0; r < 16; ++r) { OT[crow(r, hi) * PC_OTS + e0 + r32] = o0[r]; OT[(32 + crow(r, hi)) * PC_OTS + e0 + r32] = o1[r]; } }
        __syncthreads();
        { const int t = tid >> 3, j = tid & 7; const LAS float* OT = (const LAS float*)(lds + PC_OT) + t * PC_OTS + 8 * j;
          const size_t ro = (size_t)(64 * xc + t) * 2048 + h * 256 + 8 * j;
          f32x4 v[4][2]; u32x4 gg[4]; float ssq = 0.f;
#pragma unroll
          for (int i = 0; i < 4; ++i) { gg[i] = *(const GAS u32x4*)(GOG + ro + 64 * i); v[i][0] = *(const LAS f32x4*)(OT + 64 * i); v[i][1] = *(const LAS f32x4*)(OT + 64 * i + 4); ssq += dot4(v[i][0]) + dot4(v[i][1]); }
          ssq += __shfl_xor(ssq, 1); ssq += __shfl_xor(ssq, 2); ssq += __shfl_xor(ssq, 4);
          const float rn = 1.f / sqrtf(ssq * (1.f / GDV) + EPS);
#pragma unroll
          for (int i = 0; i < 4; ++i) { const f32x4 g0 = *(const GAS f32x4*)(gw.gnorm + 8 * j + 64 * i), g1 = *(const GAS f32x4*)(gw.gnorm + 8 * j + 64 * i + 4); const u32x4 q = gg[i];
              const f32x4 a0 = (f32x4){bflo(q.x), bfhi(q.x), bflo(q.y), bfhi(q.y)}, a1 = (f32x4){bflo(q.z), bfhi(q.z), bflo(q.w), bfhi(q.w)};
              st_bf8(AG + ro + 64 * i, v[i][0] * rn * g0 * a0, v[i][1] * rn * g1 * a1); } }
    }
#undef PC_OP
#undef PC_AT
}
namespace att {
constexpr int NW = 8, QBLK = 32, KVBLK = 64, NT = 129, LDQ = 3072, LDK = 3072, LDV = 2048, LDO = 2048;
constexpr float THR = 11.5f;
constexpr int SHM_V = KVBLK * 128 * 2, SHM_KN = KVBLK * 128 * 2, SHM_KR = KVBLK * 64 * 2;
constexpr int NBUF = 3, OFF_V = 0, OFF_KN = NBUF * SHM_V, OFF_KR = OFF_KN + NBUF * SHM_KN, OFF_WS = OFF_KR + NBUF * SHM_KR, SHM_ATTN = OFF_WS + NW * 64 * 4;
#define KSWZ(row, colB) ((row) * 256 + ((colB) ^ (((row) & 15) << 4)))
#define KRSWZ(row, chunk) ((row) * 128 + ((((chunk) ^ (((row) >> 1) & 7))) << 4))
constexpr float NEG = -1e30f;
__device__ __forceinline__ void partialSM(f32x16& p0, f32x16& p1, float& m_reg, float& mn, float& alpha) {
    float pmax = p0[0];
#pragma unroll
    for (int r = 1; r < 16; ++r) pmax = fmaxf(pmax, p0[r]);
#pragma unroll
    for (int r = 0; r < 16; ++r) pmax = fmaxf(pmax, p1[r]);
    { auto rr = __builtin_amdgcn_permlane32_swap(__float_as_uint(pmax), __float_as_uint(pmax), false, false);
      pmax = fmaxf(__uint_as_float(rr[0]), __uint_as_float(rr[1])); }
    { const bool keep = __all(pmax - m_reg <= THR);
      const float mx = fmaxf(m_reg, pmax); mn = keep ? m_reg : mx; alpha = keep ? 1.f : __builtin_amdgcn_exp2f(m_reg - mx); m_reg = mn; }
#pragma unroll
    for (int r = 0; r < 16; ++r) p0[r] = p0[r] - mn;
#pragma unroll
    for (int r = 0; r < 16; ++r) p1[r] = p1[r] - mn;
#pragma unroll
    for (int r = 0; r < 16; ++r) p0[r] = __builtin_amdgcn_exp2f(p0[r]);
}
__device__ __forceinline__ void finishSM(f32x16& p0, f32x16& p1, float alpha, float& l_reg, bf16x8& pa0, bf16x8& pa1, bf16x8& pa2, bf16x8& pa3) {
#pragma unroll
    for (int r = 0; r < 16; ++r) p1[r] = __builtin_amdgcn_exp2f(p1[r]);
    float ps = 0;
#pragma unroll
    for (int r = 0; r < 16; ++r) ps += p0[r];
#pragma unroll
    for (int r = 0; r < 16; ++r) ps += p1[r];
    { auto rr = __builtin_amdgcn_permlane32_swap(__float_as_uint(ps), __float_as_uint(ps), false, false);
      ps = __uint_as_float(rr[0]) + __uint_as_float(rr[1]); }
    l_reg = l_reg * alpha + ps;
#define PK4(P, BASE, OUT) do { u32x4 w = {cvtpk(P[BASE + 0], P[BASE + 1]), cvtpk(P[BASE + 2], P[BASE + 3]), cvtpk(P[BASE + 4], P[BASE + 5]), cvtpk(P[BASE + 6], P[BASE + 7])}; \
    OUT = *reinterpret_cast<bf16x8*>(&w); } while (0)
    PK4(p0, 0, pa0); PK4(p0, 8, pa1); PK4(p1, 0, pa2); PK4(p1, 8, pa3);
#undef PK4
}
__device__ __forceinline__ void qkt(f32x16& p0, f32x16& p1, const LAS char* Kn, const LAS char* Kr, const bf16x8* qr, int r32, int hi) {
    p0 = f32x16{}; p1 = f32x16{};
#pragma unroll
    for (int d0 = 0; d0 < 8; ++d0) { const int cb = (d0 * 16 + hi * 8) * 2;
        const bf16x8 b0 = *(const LAS bf16x8*)(Kn + KSWZ(r32, cb)), b1 = *(const LAS bf16x8*)(Kn + KSWZ(32 + r32, cb));
        p0 = __builtin_amdgcn_mfma_f32_32x32x16_bf16(b0, qr[d0], p0, 0, 0, 0);
        p1 = __builtin_amdgcn_mfma_f32_32x32x16_bf16(b1, qr[d0], p1, 0, 0, 0); }
#pragma unroll
    for (int d0 = 0; d0 < 4; ++d0) { const int ch = d0 * 2 + hi;
        const bf16x8 b0 = *(const LAS bf16x8*)(Kr + KRSWZ(r32, ch)), b1 = *(const LAS bf16x8*)(Kr + KRSWZ(32 + r32, ch));
        p0 = __builtin_amdgcn_mfma_f32_32x32x16_bf16(b0, qr[8 + d0], p0, 0, 0, 0);
        p1 = __builtin_amdgcn_mfma_f32_32x32x16_bf16(b1, qr[8 + d0], p1, 0, 0, 0); }
}
template <int MODE> __device__ __forceinline__ void maskp(f32x16& p0, f32x16& p1) {
    if (MODE == 1) {
#pragma unroll
        for (int r = 8; r < 16; ++r) p0[r] = NEG;
    } else {
#pragma unroll
        for (int r = 0; r < 16; ++r) p0[r] = NEG;
    }
#pragma unroll
    for (int r = 0; r < 16; ++r) p1[r] = NEG;
}
__device__ __forceinline__ int v_st(int k, int c) { const int kk = (k & ~0xC) | ((k & 4) << 1) | ((k & 8) >> 1); return ((kk >> 3) * 4 + (c >> 5)) * 512 + ((kk & 7) * 32 + (c & 31)) * 2; }
__device__ __forceinline__ int v_rd_base(int lane) { return ((lane & 3) << 3) | (((lane >> 2) & 3) << 6) | (((lane >> 4) & 1) << 5) | (((lane >> 5) & 1) << 8); }
constexpr int v_rd_off(int d0, int ks, int half) { return d0 * 512 + ks * 4096 + half * 2048; }
template <int OFF> __device__ __forceinline__ s16x4 tr_read(int vb) {
    return __builtin_amdgcn_ds_read_tr16_b64_v4i16((LAS s16x4*)(uintptr_t)(unsigned)(vb + OFF));
}
template <int D0> __device__ __forceinline__ void pv_one(f32x16& od, int vb, bf16x8 pa0, bf16x8 pa1, bf16x8 pa2, bf16x8 pa3) {
    const s16x4 l0 = tr_read<v_rd_off(D0, 0, 0)>(vb), h0 = tr_read<v_rd_off(D0, 0, 1)>(vb), l1 = tr_read<v_rd_off(D0, 1, 0)>(vb), h1 = tr_read<v_rd_off(D0, 1, 1)>(vb);
    const s16x4 l2 = tr_read<v_rd_off(D0, 2, 0)>(vb), h2 = tr_read<v_rd_off(D0, 2, 1)>(vb), l3 = tr_read<v_rd_off(D0, 3, 0)>(vb), h3 = tr_read<v_rd_off(D0, 3, 1)>(vb);
#define PK(L, H) (bf16x8){L[0], L[1], L[2], L[3], H[0], H[1], H[2], H[3]}
    od = __builtin_amdgcn_mfma_f32_32x32x16_bf16(pa0, PK(l0, h0), od, 0, 0, 0);
    od = __builtin_amdgcn_mfma_f32_32x32x16_bf16(pa1, PK(l1, h1), od, 0, 0, 0);
    od = __builtin_amdgcn_mfma_f32_32x32x16_bf16(pa2, PK(l2, h2), od, 0, 0, 0);
    od = __builtin_amdgcn_mfma_f32_32x32x16_bf16(pa3, PK(l3, h3), od, 0, 0, 0);
#undef PK
}
__device__ __forceinline__ void pv_d0(f32x16* o, int vb, bf16x8 pa0, bf16x8 pa1, bf16x8 pa2, bf16x8 pa3) {
    pv_one<0>(o[0], vb, pa0, pa1, pa2, pa3); pv_one<1>(o[1], vb, pa0, pa1, pa2, pa3); pv_one<2>(o[2], vb, pa0, pa1, pa2, pa3); pv_one<3>(o[3], vb, pa0, pa1, pa2, pa3);
}
#define PINV(x) asm volatile("" : "+v"(x))
struct KFrag { bf16x8 b0, b1; };
template <int P> __device__ __forceinline__ void kfrag(KFrag& f, const LAS char* Kn, const LAS char* Kr, int r32, int hi) {
    if (P < 8) { const int cb = (P * 16 + hi * 8) * 2; f.b0 = *(const LAS bf16x8*)(Kn + KSWZ(r32, cb)); f.b1 = *(const LAS bf16x8*)(Kn + KSWZ(32 + r32, cb)); }
    else { const int ch = (P - 8) * 2 + hi; f.b0 = *(const LAS bf16x8*)(Kr + KRSWZ(r32, ch)); f.b1 = *(const LAS bf16x8*)(Kr + KRSWZ(32 + r32, ch)); }
}
struct VFrag { s16x4 l0, h0, l1, h1, l2, h2, l3, h3; };
template <int D0> __device__ __forceinline__ void vfrag_lo(VFrag& f, int vb) { f.l0 = tr_read<v_rd_off(D0, 0, 0)>(vb); f.h0 = tr_read<v_rd_off(D0, 0, 1)>(vb); f.l1 = tr_read<v_rd_off(D0, 1, 0)>(vb); f.h1 = tr_read<v_rd_off(D0, 1, 1)>(vb); }
template <int D0> __device__ __forceinline__ void vfrag_hi(VFrag& f, int vb) { f.l2 = tr_read<v_rd_off(D0, 2, 0)>(vb); f.h2 = tr_read<v_rd_off(D0, 2, 1)>(vb); f.l3 = tr_read<v_rd_off(D0, 3, 0)>(vb); f.h3 = tr_read<v_rd_off(D0, 3, 1)>(vb); }
__device__ __forceinline__ void pv4(f32x16& od, const VFrag& f, bf16x8 pa0, bf16x8 pa1, bf16x8 pa2, bf16x8 pa3) {
#define PK(L, H) (bf16x8){L[0], L[1], L[2], L[3], H[0], H[1], H[2], H[3]}
    od = __builtin_amdgcn_mfma_f32_32x32x16_bf16(pa0, PK(f.l0, f.h0), od, 0, 0, 0);
    od = __builtin_amdgcn_mfma_f32_32x32x16_bf16(pa1, PK(f.l1, f.h1), od, 0, 0, 0);
    od = __builtin_amdgcn_mfma_f32_32x32x16_bf16(pa2, PK(f.l2, f.h2), od, 0, 0, 0);
    od = __builtin_amdgcn_mfma_f32_32x32x16_bf16(pa3, PK(f.l3, f.h3), od, 0, 0, 0);
#undef PK
}
__device__ __forceinline__ bf16x8 pk4(const f32x16& P, int base) {
    u32x4 w = {cvtpk(P[base + 0], P[base + 1]), cvtpk(P[base + 2], P[base + 3]), cvtpk(P[base + 4], P[base + 5]), cvtpk(P[base + 6], P[base + 7])};
    PINV(w); return *reinterpret_cast<bf16x8*>(&w);
}
template <int P> __device__ __forceinline__ void fill_a(f32x16& Y0, f32x16& Y1, float alY, float& ps, float& l_reg, bf16x8& pa0, bf16x8& pa1, bf16x8& pa2, bf16x8& pa3, VFrag& va, int vbY) {
    if constexpr (P == 0) { ps = Y0[0] + Y0[1];
#pragma unroll
        for (int r = 2; r < 8; ++r) ps += Y0[r];
        PINV(ps); pa0 = pk4(Y0, 0); }
    else if constexpr (P == 1) {
#pragma unroll
        for (int r = 8; r < 16; ++r) ps += Y0[r];
        PINV(ps); pa1 = pk4(Y0, 8); }
    else if constexpr (P < 10) { constexpr int i = 2 * (P - 2);
        float e0 = __builtin_amdgcn_exp2f(Y1[i]), e1 = __builtin_amdgcn_exp2f(Y1[i + 1]); PINV(e0); PINV(e1); Y1[i] = e0; Y1[i + 1] = e1;
        if constexpr (P > 2) { ps += Y1[i - 2]; ps += Y1[i - 1]; PINV(ps); }
        if constexpr (P == 6) pa2 = pk4(Y1, 0); }
    else if constexpr (P == 10) { ps += Y1[14]; ps += Y1[15]; pa3 = pk4(Y1, 8);
        auto rr = __builtin_amdgcn_permlane32_swap(__float_as_uint(ps), __float_as_uint(ps), false, false);
        l_reg = l_reg * alY + (__uint_as_float(rr[0]) + __uint_as_float(rr[1])); PINV(l_reg); vfrag_lo<0>(va, vbY); }
    else vfrag_hi<0>(va, vbY);
}
#ifndef DMA_IN_A
#define DMA_IN_A 0
#endif
__device__ __forceinline__ void dma16(const char* base, unsigned voff, LAS char* dst) {
    asm volatile("s_mov_b32 m0, %2\n\ts_nop 0\n\tglobal_load_lds_dwordx4 %0, %1" :: "v"(voff), "s"(base), "s"((unsigned)(uintptr_t)dst) : "memory", "m0");
}
struct DmaCtx { const char* kt; const char* vt; unsigned voKn0, voKn1, voKr, voV0, voV1; LAS char* lKn; LAS char* lKr; LAS char* lV; };
template <int I> __device__ __forceinline__ void dma_piece(const DmaCtx& c) {
    if (I == 0) dma16(c.kt, c.voKn0, c.lKn);
    if (I == 1) dma16(c.kt, c.voKn1, c.lKn + 1024);
    if (I == 2) dma16(c.kt, c.voKr, c.lKr);
    if (I == 3) dma16(c.vt, c.voV0, c.lV);
    if (I == 4) dma16(c.vt, c.voV1, c.lV + 1024);
}
template <int AV, bool DK, bool DV> __device__ __forceinline__ void phase_a(const DmaCtx& dc, const f32x16& negm, f32x16& X0, f32x16& X1, f32x16& Y0, f32x16& Y1, float alY, float& l_reg, bf16x8& pa0, bf16x8& pa1, bf16x8& pa2, bf16x8& pa3, VFrag& va,
                                        const LAS char* Kn, const LAS char* Kr, const bf16x8* qr, int vbY, int r32, int hi) {
    KFrag k; float ps = 0.f;
    kfrag<0>(k, Kn, Kr, r32, hi); if (AV != 2) fill_a<0>(Y0, Y1, alY, ps, l_reg, pa0, pa1, pa2, pa3, va, vbY); SBAR();
#define QKP(P) do { if (AV != 8) { X0 = __builtin_amdgcn_mfma_f32_32x32x16_bf16(k.b0, qr[P], P == 0 ? negm : X0, 0, 0, 0); X1 = __builtin_amdgcn_mfma_f32_32x32x16_bf16(k.b1, qr[P], P == 0 ? negm : X1, 0, 0, 0); } \
        else asm volatile("" :: "v"(k.b0), "v"(k.b1)); \
        if (AV != 5 && DMA_IN_A) { if (DK && P == 1) dma_piece<0>(dc); if (DK && P == 3) dma_piece<1>(dc); if (DK && P == 5) dma_piece<2>(dc); if (DV && P == 7) dma_piece<3>(dc); if (DV && P == 9) dma_piece<4>(dc); } \
        if (P < 11) { if (AV != 7) kfrag<(P < 11 ? P + 1 : 0)>(k, Kn, Kr, r32, hi); if (AV != 2 || P >= 9) fill_a<(P < 11 ? P + 1 : 1)>(Y0, Y1, alY, ps, l_reg, pa0, pa1, pa2, pa3, va, vbY); } SBAR(); } while (0)
    QKP(0); QKP(1); QKP(2); QKP(3); QKP(4); QKP(5); QKP(6); QKP(7); QKP(8); QKP(9); QKP(10); QKP(11);
#undef QKP
}
template <int S> __device__ __forceinline__ void fill_b(f32x16& X0) {
    constexpr int lo = S == 0 ? 0 : S == 1 ? 5 : 10, hi_ = S == 0 ? 5 : S == 1 ? 10 : 16;
#pragma unroll
    for (int r = lo; r < hi_; ++r) { float e = __builtin_amdgcn_exp2f(X0[r]); PINV(e); X0[r] = e; }
}
template <bool MASK, int AV> __device__ __forceinline__ void phase_b(f32x16* o, f32x16& negm, f32x16& X0, f32x16& X1, float& m_reg, float& alpha, bf16x8 pa0, bf16x8 pa1, bf16x8 pa2, bf16x8 pa3, VFrag& va, int vbY) {
#define PV4(D) do { if (AV != 8) pv4(o[D], va, pa0, pa1, pa2, pa3); else asm volatile("" :: "v"(va.l0), "v"(va.h0), "v"(va.l1), "v"(va.h1), "v"(va.l2), "v"(va.h2), "v"(va.l3), "v"(va.h3)); } while (0)
    PV4(0); if (AV != 7) { vfrag_lo<1>(va, vbY); vfrag_hi<1>(va, vbY); }
    bool keep = true;
    if (AV != 2) { if (MASK) maskp<1>(X0, X1);
      float m0 = X0[0], m1 = X1[0];
#pragma unroll
      for (int r = 1; r < 16; ++r) { m0 = fmaxf(m0, X0[r]); m1 = fmaxf(m1, X1[r]); }
      float pmax = fmaxf(m0, m1);
      { auto rr = __builtin_amdgcn_permlane32_swap(__float_as_uint(pmax), __float_as_uint(pmax), false, false); pmax = fmaxf(__uint_as_float(rr[0]), __uint_as_float(rr[1])); }
      PINV(pmax);
      keep = __all(pmax <= THR); alpha = 1.f;
      SBAR();
      if (__builtin_expect(!keep, 0)) {
          const float dlt = fmaxf(pmax, 0.f); alpha = __builtin_amdgcn_exp2f(-dlt); m_reg += dlt;
#pragma unroll
          for (int r = 0; r < 16; ++r) { X0[r] -= dlt; X1[r] -= dlt; negm[r] = -m_reg; } }
    }
    else { float t0 = X0[0], t1 = X1[0]; PINV(t0); PINV(t1); }
    SBAR();
    PV4(1); if (AV != 7) { vfrag_lo<2>(va, vbY); vfrag_hi<2>(va, vbY); } if (AV != 2) fill_b<0>(X0); SBAR();
    PV4(2); if (AV != 7) { vfrag_lo<3>(va, vbY); vfrag_hi<3>(va, vbY); } if (AV != 2) fill_b<1>(X0); SBAR();
    PV4(3); if (AV != 2) fill_b<2>(X0); SBAR();
#undef PV4
}
template <int AV> __device__ __forceinline__ void attn_body(const bf16* __restrict__ Qb, const bf16* __restrict__ Kh, const bf16* __restrict__ Vh, bf16* __restrict__ Ob, LAS char* lds) {
    int tid = threadIdx.x; asm volatile("" : "+v"(tid)); const int wid = __builtin_amdgcn_readfirstlane(tid >> 6), lane = tid & 63, r32 = lane & 31, hi = lane >> 5;
    LAS char* V_lds = lds + OFF_V; LAS char* Kn_lds = lds + OFF_KN; LAS char* Kr_lds = lds + OFF_KR;
    LAS float* wsf = (LAS float*)(lds + OFF_WS) + wid * 64; LAS float* li_l = wsf; LAS float* al_l = wsf + 32;
    float m_reg = -1e30f, l_reg = 0; f32x16 o[4] = {}; bf16x8 qr[12];
    const bf16* Qw = Qb + (long)(wid * QBLK + r32) * LDQ + hi * 8;
#pragma unroll
    for (int d0 = 0; d0 < 12; ++d0) qr[d0] = *(const GAS bf16x8*)(Qw + d0 * 16);
    unsigned voKn[2], voV[2], voKr;
#pragma unroll
    for (int i = 0; i < 2; ++i) { const int ch = 2 * wid + i;
        { const int row = 4 * ch + (lane >> 4), lc = (lane & 15) ^ (row & 15); voKn[i] = (unsigned)(row * LDK + lc * 8) * 2u; }
        { const int P = ch * 64 + lane, sub = P >> 5, k = (sub >> 2) * 8 + ((P >> 2) & 7), c = (sub & 3) * 32 + (P & 3) * 8; voV[i] = (unsigned)(k * LDV + c) * 2u; } }
    { const int row = 8 * wid + (lane >> 3), lc = (lane & 7) ^ ((row >> 1) & 7); voKr = (unsigned)(row * LDK + 128 + lc * 8) * 2u; }
    const int vb0 = (int)(uintptr_t)V_lds + v_rd_base(lane);
#define DMA_K(t, b) do { const char* kt_ = (const char*)Kh + (size_t)(t) * (KVBLK * LDK * 2); \
    dma16(kt_, voKn[0], Kn_lds + (b) * SHM_KN + (2 * wid) * 1024); dma16(kt_, voKn[1], Kn_lds + (b) * SHM_KN + (2 * wid + 1) * 1024); dma16(kt_, voKr, Kr_lds + (b) * SHM_KR + wid * 1024); } while (0)
#define DMA_V(t, b) do { const char* vt_ = (const char*)Vh + (size_t)(t) * (KVBLK * LDV * 2); \
    dma16(vt_, voV[0], V_lds + (b) * SHM_V + (2 * wid) * 1024); dma16(vt_, voV[1], V_lds + (b) * SHM_V + (2 * wid + 1) * 1024); } while (0)
#define RESC(a) do { if (__any((a) < 1.f)) { if (hi == 0) al_l[r32] = (a); asm volatile("s_waitcnt lgkmcnt(0)" ::: "memory"); \
    _Pragma("unroll") for (int d = 0; d < 4; ++d) _Pragma("unroll") for (int r = 0; r < 16; ++r) o[d][r] *= al_l[crow(r, hi)]; } } while (0)
#define WBAR(N) do { asm volatile("s_waitcnt vmcnt(" #N ") lgkmcnt(0)" ::: "memory"); __builtin_amdgcn_s_barrier(); asm volatile("" ::: "memory"); } while (0)
    f32x16 pA0, pA1, pB0, pB1; float mnA, mnB, alA, alB; bf16x8 pa0, pa1, pa2, pa3;
    DMA_K(0, 0); DMA_K(1, 1); DMA_V(0, 0);
    WBAR(0);
    DMA_K(2, 2); DMA_V(1, 1);
    qkt(pA0, pA1, Kn_lds, Kr_lds, qr, r32, hi); partialSM(pA0, pA1, m_reg, mnA, alA); RESC(alA);
    WBAR(5);
    f32x16 negm;
#pragma unroll
    for (int r = 0; r < 16; ++r) negm[r] = -m_reg;
    int bc = 1;
#define STEP(j, X0, X1, mnX, alX, Y0, Y1, alY, MASK, DK, DV) do { const int bp_ = bc == 0 ? 2 : bc - 1, bn_ = bc == 2 ? 0 : bc + 1; \
        const DmaCtx dc_{(const char*)Kh + (size_t)((j) + 2) * (KVBLK * LDK * 2), (const char*)Vh + (size_t)((j) + 1) * (KVBLK * LDV * 2), voKn[0], voKn[1], voKr, voV[0], voV[1], \
                         Kn_lds + bp_ * SHM_KN + (2 * wid) * 1024, Kr_lds + bp_ * SHM_KR + wid * 1024, V_lds + bn_ * SHM_V + (2 * wid) * 1024}; \
        phase_a<AV, DK, DV>(dc_, negm, X0, X1, Y0, Y1, alY, l_reg, pa0, pa1, pa2, pa3, vfa, Kn_lds + bc * SHM_KN, Kr_lds + bc * SHM_KR, qr, vb0 + bp_ * SHM_V, r32, hi); \
        phase_b<MASK, AV>(o, negm, X0, X1, m_reg, alX, pa0, pa1, pa2, pa3, vfa, vb0 + bp_ * SHM_V); \
        if (AV != 2) RESC(alX); \
        if (AV != 5 && !DMA_IN_A) { SBAR(); if (DK) { dma_piece<0>(dc_); dma_piece<1>(dc_); dma_piece<2>(dc_); } if (DV) { dma_piece<3>(dc_); dma_piece<4>(dc_); } } \
        if (DK && AV != 5) WBAR(5); else if (DV && AV != 5 && !DMA_IN_A) WBAR(2); else WBAR(0); \
        bc = bn_; } while (0)
    VFrag vfa;
    for (int j = 1; j + 3 < NT; j += 2) {
        STEP(j, pB0, pB1, mnB, alB, pA0, pA1, alA, false, true, true);
        STEP(j + 1, pA0, pA1, mnA, alA, pB0, pB1, alB, false, true, true);
    }
    STEP(NT - 2, pB0, pB1, mnB, alB, pA0, pA1, alA, false, false, true);
    STEP(NT - 1, pA0, pA1, mnA, alA, pB0, pB1, alB, true, false, false);
#undef STEP
    finishSM(pA0, pA1, alA, l_reg, pa0, pa1, pa2, pa3); SBAR();
    pv_d0(o, vb0 + ((NT - 1) % 3) * SHM_V, pa0, pa1, pa2, pa3);
    if (hi == 0) li_l[r32] = l_reg; LDS_WAIT();
    float rli[16];
#pragma unroll
    for (int r = 0; r < 16; ++r) rli[r] = __builtin_amdgcn_rcpf(li_l[crow(r, hi)]);
    bf16* Ow = Ob + (long)(wid * QBLK) * LDO;
    if (AV != 0) { float s = 0.f;
#pragma unroll
        for (int d0 = 0; d0 < 4; ++d0) _Pragma("unroll") for (int r = 0; r < 16; ++r) s += o[d0][r];
        if (s != 1234567.125f) return; }
#pragma unroll
    for (int r = 0; r < 16; ++r) { const int orow = crow(r, hi);
#pragma unroll
        for (int d0 = 0; d0 < 4; ++d0) Ow[(long)orow * LDO + d0 * 32 + r32] = f2bf(o[d0][r] * rli[r]); }
#undef DMA_K
#undef DMA_V
#undef WBAR
#undef RESC
}
__device__ __forceinline__ void attn_phase(unsigned char* ws, LAS unsigned char* lds, int G, int bid, bf16* exp_out, bf16* AO) {
    const bf16* QM = (const bf16*)(ws + WS_QM); const bf16* KF = (const bf16*)(ws + WS_KF); const bf16* VB = (const bf16*)(ws + WS_VB);
    for (int u = bid; u < MH * (SEQ / 256); u += G) {
        const int b = u & 255, r = u >> 8, h = 2 * (b & 7) + r, qb = b >> 3;
        __syncthreads();
        attn_body<0>(QM + (size_t)(256 * qb) * 3072 + h * 192, KF + h * 192, VB + h * 128, AO + (size_t)(256 * qb) * 2048 + h * 128, (LAS char*)lds);
    }
#if defined(EXP_ATT)
    for (int u = bid; u < MH * (SEQ / 256); u += G) {
        const int b = u & 255, r = u >> 8, h = 2 * (b & 7) + r, qb = b >> 3;
        __syncthreads();
        attn_body<EXP_ATT>(QM + (size_t)(256 * qb) * 3072 + h * 192, KF + h * 192, VB + h * 128, (EXP_ATT == 0 ? AO : exp_out) + (size_t)(256 * qb) * 2048 + h * 128, (LAS char*)lds);
    }
#endif
}
}
__device__ __forceinline__ void kpe_pass(unsigned char* ws, int gw, int NGW, int lane) {
    const float* SMALL = (const float*)(ws + ST_SMALL); const float* COS = (const float*)(ws + ST_COS); const float* SIN = (const float*)(ws + ST_SIN); bf16* KF = (bf16*)(ws + WS_KF);
    const int l = lane & 31, p = 2 * l, gp = p >> 5, fq = (p >> 3) & 3, nn = (p >> 2) & 1, j = p & 3, f = 16 * gp + 4 * fq + j;
    for (int row = 2 * gw + (lane >> 5); row < LP; row += 2 * NGW) {
        float v0 = 0.f, v1 = 0.f;
        if (row < LTOK) {
            const int pos = row < SEQ ? row + NMETA : row - SEQ;
            const float a0 = SMALL[(size_t)row * 96 + f], a1 = SMALL[(size_t)row * 96 + f + 1], b0 = SMALL[(size_t)row * 96 + 32 + f], b1 = SMALL[(size_t)row * 96 + 32 + f + 1];
            const float c0 = COS[pos * 32 + f], c1 = COS[pos * 32 + f + 1], s0 = SIN[pos * 32 + f], s1 = SIN[pos * 32 + f + 1];
            v0 = nn == 0 ? a0 * c0 - b0 * s0 : a0 * s0 + b0 * c0; v1 = nn == 0 ? a1 * c1 - b1 * s1 : a1 * s1 + b1 * c1;
        }
        const unsigned w = cvtpk(v0, v1);
#pragma unroll
        for (int h = 0; h < MH; ++h) *(GAS unsigned*)(KF + (size_t)row * 3072 + h * 192 + 128 + p) = w;
    }
}
__device__ __forceinline__ void final_norm(unsigned char* ws, float* out, const float* g, int gw, int NGW, int lane) {
    const float* SS = (const float*)(ws + ST_H2SS); const bf16* H2 = (const bf16*)(ws + WS_H1B);
    for (int row = gw; row < SEQ; row += NGW) {
        const float s = wave_sum(SS[(size_t)row * 64 + lane]);
        const float rs = 1.f / sqrtf(s * (1.f / DM) + EPS);
        const GAS u32x4* hp = (const GAS u32x4*)(H2 + (size_t)row * DM) + lane;
        GAS f32x4* o = (GAS f32x4*)(out + (size_t)row * DM) + 2 * lane; const GAS f32x4* gp = (const GAS f32x4*)g + 2 * lane;
        u32x4 w[8];
#pragma unroll
        for (int j = 0; j < 8; ++j) w[j] = hp[64 * j];
#pragma unroll
        for (int j = 0; j < 8; ++j) { const f32x4 a = (f32x4){bflo(w[j].x), bfhi(w[j].x), bflo(w[j].y), bfhi(w[j].y)}, b = (f32x4){bflo(w[j].z), bfhi(w[j].z), bflo(w[j].w), bfhi(w[j].w)};
            o[128 * j] = a * rs * gp[128 * j]; o[128 * j + 1] = b * rs * gp[128 * j + 1]; }
    }
}

#ifndef PG_SP2
#define PG_SP2 true
#endif
#ifndef PG_ALIGN
#define PG_ALIGN true
#endif
struct Args { const float* in[20]; float* out; unsigned char* ws; int ph_lo, ph_hi; };
constexpr int NPHASE = 10;
__global__ void __launch_bounds__(NTHR, 2) mega_fwd(Args args) {
    extern __shared__ __attribute__((aligned(16))) unsigned char lds_raw[];
    LAS unsigned char* lds = (LAS unsigned char*)lds_raw;
#define FRESH_IDS() int tid = threadIdx.x; asm volatile("" : "+v"(tid)); const int lane = tid & 63, wave = __builtin_amdgcn_readfirstlane(tid >> 6), gw = bid * NWAVES + wave; (void)lane; (void)gw
    const int G = gridDim.x, bid = blockIdx.x, NGW = G * NWAVES;
    unsigned char* ws = args.ws;
    volatile LAS unsigned* MISC = (volatile LAS unsigned*)(lds + LDS_CTL);
    if (threadIdx.x < 64) MISC[threadIdx.x] = 0u;
    __syncthreads();
    XcdBarrier bar = xcd_barrier_post((unsigned*)(ws + WS_CTL) + CW_BAR, MISC + 8);
    const int lo = args.ph_lo, hi = args.ph_hi;
#ifndef PH_MASK
#define PH_MASK 0x3ff
#endif
#define IN(k) ((((PH_MASK) >> (k)) & 1) && lo <= (k) && (k) < hi)
#define SEAM(k) do { if (IN(k) && IN((k) + 1)) xcd_barrier(bar); } while (0)
#ifndef DUP_PHASE
#define DUP_PHASE -1
#endif
#define REP(k) for (int rep_ = 0; rep_ < (DUP_PHASE == (k) ? 2 : 1); ++rep_, (DUP_PHASE == (k) && rep_ == 1 ? xcd_barrier(bar) : (void)0))
    GlaW glw{args.in[4], args.in[5], args.in[6], args.in[7], args.in[8]};
#if defined(DBG_TIME)
    volatile LAS unsigned long long* TS = (volatile LAS unsigned long long*)(lds + LDS_CTL + 64);
#define STAMP(k) do { if (bid == 0 && threadIdx.x == 0) TS[k] = __builtin_amdgcn_s_memrealtime(); } while (0)
#else
#define STAMP(k) do {} while (0)
#endif
    STAMP(0);

    REP(0) if (IN(0)) {
        P0Args a{args.in[0], args.in[1], args.in[2], args.in[3], args.in[9], args.in[10], args.in[11], args.in[12], args.in[13], args.in[14], args.in[15], args.in[16], args.in[17], args.in[18], ws};
        FRESH_IDS(); p0_prologue(a, lds, gw, NGW, wave, lane);
    }
    SEAM(0); STAMP(1);
    REP(1) if (IN(1)) {
        pg8::Gemm g{(const bf16*)(ws + WS_H0B), (const bf16*)(ws + WS_WINT), LP, NPROJ, DM}; ProjOrder S; S.init(G, bid); EpiProj E{ws};
#if defined(EXP_NULLEPI1)
        if (rep_ == 1) { EpiNull EN{ws}; pg8::gemm_phase<EpiNull, ProjOrder, PG_ALIGN, PG_SP2>(lds, g, S, EN); } else
#endif
        pg8::gemm_phase<EpiProj, ProjOrder, PG_ALIGN, PG_SP2>(lds, g, S, E);
    }
    SEAM(1); STAMP(2);
    REP(2) if (IN(2)) {
#ifndef NO_QUP
        { pg8::Gemm g{(const bf16*)(ws + WS_CQ), (const bf16*)(ws + WS_WUQT), SEQ, 3072, QRANK}; pg8::StaticOrder S; S.init(SEQ, 3072, G, (bid + G / 2) % G); EpiQ E{ws};
          pg8::gemm_phase<EpiQ, pg8::StaticOrder, PG_ALIGN, PG_SP2>(lds, g, S, E); }
#endif
        STAMP(11);
#ifndef NO_KVUP
        { pg8::Gemm g{(const bf16*)(ws + WS_CKV), (const bf16*)(ws + WS_WUKVT), LP, 4096, KVRANK}; pg8::StaticOrder S; S.init(LP, 4096, G, bid); EpiKV E{ws};
          pg8::gemm_phase<EpiKV, pg8::StaticOrder, PG_ALIGN, PG_SP2>(lds, g, S, E); }
#endif
        STAMP(12);
        { FRESH_IDS(); kpe_pass(ws, gw, NGW, lane); }
        STAMP(13);
        { FRESH_IDS(); gla_pass_a(ws, glw, lds, tid, G, bid, args.out); }
#if defined(DUP_PA)
        { FRESH_IDS(); gla_pass_a(ws, glw, lds, tid, G, bid, args.out); }
#endif
#if defined(DUP_KPE)
        { FRESH_IDS(); kpe_pass(ws, gw, NGW, lane); }
#endif
    }
    SEAM(2); STAMP(3);
    REP(3) if (IN(3)) {
#ifndef NO_CHAIN
        { FRESH_IDS();
          if (wave < 2) gla_chain(ws, bid, G, wave, lane);
          else { P0Args a{args.in[0], args.in[1], args.in[2], args.in[3], args.in[9], args.in[10], args.in[11], args.in[12], args.in[13], args.in[14], args.in[15], args.in[16], args.in[17], args.in[18], ws};
                 p0_weights_late(a, lds, bid * 6 + (wave - 2), G * 6, wave, lane); } }
#if defined(DUP_CHAIN)
        { FRESH_IDS();
          if (wave < 2) { if (DUP_CHAIN != 3) gla_chain(ws, bid, G, wave, lane); }
          else if (DUP_CHAIN != 2) { P0Args a{args.in[0], args.in[1], args.in[2], args.in[3], args.in[9], args.in[10], args.in[11], args.in[12], args.in[13], args.in[14], args.in[15], args.in[16], args.in[17], args.in[18], ws};
                 p0_weights_late(a, lds, bid * 6 + (wave - 2), G * 6, wave, lane); } }
#endif
#endif
        STAMP(14);
#ifndef NO_ATT
        att::attn_phase(ws, lds, G, bid, (bf16*)args.out, (bf16*)args.out + (size_t)32 * 1024 * 1024);
#endif
    }
    SEAM(3); STAMP(4);
    REP(4) if (IN(4)) { FRESH_IDS(); gla_pass_c<0>(ws, glw, lds, tid, G, bid, (bf16*)args.out + (size_t)48 * 1024 * 1024, args.out);
    }
    SEAM(4); STAMP(5);
    REP(5) if (IN(5)) {
        pg8::Gemm g{(const bf16*)args.out + (size_t)48 * 1024 * 1024, (const bf16*)(ws + WS_WGT), SEQ, DM, 2048, (const bf16*)args.out + (size_t)32 * 1024 * 1024, (const bf16*)(ws + WS_WMT)}; PairOrder S; S.init(SEQ, DM, G, bid); EpiMerged E{ws};
        pg8::gemm_phase<EpiMerged, PairOrder, PG_ALIGN, PG_SP2>(lds, g, S, E);
    }
    SEAM(5); STAMP(6);
    REP(6) if (IN(6)) {
        pg8::Gemm g{(const bf16*)(ws + WS_MERGED), (const bf16*)(ws + WS_WOT), SEQ, DM, DM}; pg8::StaticOrder S; S.init(SEQ, DM, G, bid); EpiWo E{ws, args.in[0], args.out};
        pg8::gemm_phase<EpiWo, pg8::StaticOrder, PG_ALIGN, PG_SP2>(lds, g, S, E);
    }
    SEAM(6); STAMP(7);
#if defined(EXTRA_BAR)
    for (int eb_ = 0; eb_ < EXTRA_BAR; ++eb_) xcd_barrier(bar);
#endif
    REP(7) if (IN(7)) {
        pg8::Gemm g{(const bf16*)(ws + WS_H1B), (const bf16*)(ws + WS_W1T), SEQ, DFF, DM}; pg8::StaticOrder S; S.init(SEQ, DFF, G, bid); pg8::Unit u0; u0.pm = 0; u0.pn = 0; S.next(0, u0); { FRESH_IDS(); ff1_rs_table(ws, lds, u0.pm, tid); } EpiFF1 E{ws, lds, u0.pm};
#if defined(EXP_BURN)
        if (rep_ == 1) {
            f32x4 bacc[32]; bf16x8 ba, bb;
#pragma unroll
            for (int q = 0; q < 32; ++q) bacc[q] = (f32x4){0.f, 0.f, 0.f, 0.f};
#pragma unroll
            for (int q = 0; q < 8; ++q) { ba[q] = (short)(0x3f80 + (threadIdx.x & 7)); bb[q] = (short)(0x3c00 + (threadIdx.x & 3)); }
            for (int it = 0; it < 512; ++it) {
#pragma unroll
                for (int k2 = 0; k2 < 64; ++k2) bacc[k2 & 31] = __builtin_amdgcn_mfma_f32_16x16x32_bf16(ba, bb, bacc[k2 & 31], 0, 0, 0);
            }
            float sm = 0.f;
#pragma unroll
            for (int q = 0; q < 32; ++q) sm += bacc[q][0] + bacc[q][1] + bacc[q][2] + bacc[q][3];
            if (sm == 1234567.125f) ((float*)(ws + ST_H2SS))[0] = sm;
        } else
#endif
#if defined(EXP_NULLEPI)
        if (rep_ == 1) { EpiNull EN{ws};
#if EXP_NULLEPI == 2
            pg8::Gemm g2{(const bf16*)(ws + WS_H1B), (const bf16*)(ws + WS_W1T), 256, 256, DM}; pg8::StaticOrder S2; S2.init(256, 256, 1, 0); S2.nwg = 8; S2.nN = 1; S2.nM = 1;
            struct HotOrder { __device__ bool next(int i, pg8::Unit& u) const { u.pm = 0; u.pn = 0; return i < 8; } __device__ __forceinline__ void a_ready(const pg8::Unit&) const {} __device__ __forceinline__ void done(const pg8::Unit&) const {} } HS;
            pg8::gemm_phase<EpiNull, HotOrder, true, true>(lds, g2, HS, EN);
#else
            pg8::gemm_phase<EpiNull, pg8::StaticOrder, true, true>(lds, g, S, EN);
#endif
        } else
#endif
        pg8::gemm_phase<EpiFF1, pg8::StaticOrder, PG_ALIGN, PG_SP2>(lds, g, S, E);
    }
    SEAM(7); STAMP(8);
    REP(8) if (IN(8)) {
        pg8::Gemm g{(const bf16*)(ws + WS_U), (const bf16*)(ws + WS_W2T), SEQ, DM, DFF, nullptr, nullptr, LDU, 0}; pg8::StaticOrder S; S.init(SEQ, DM, G, bid); EpiFF2 E{ws, args.out};
        pg8::gemm_phase<EpiFF2, pg8::StaticOrder, PG_ALIGN, PG_SP2>(lds, g, S, E);
#if defined(EXP_NULLEPI8)
        xcd_barrier(bar); { EpiNull EN{ws}; pg8::gemm_phase<EpiNull, pg8::StaticOrder, PG_ALIGN, PG_SP2>(lds, g, S, EN); }
#endif
    }
    SEAM(8); STAMP(9);
    REP(9) if (IN(9)) { FRESH_IDS(); final_norm(ws, args.out, args.in[19], gw, NGW, lane); }
#undef IN
#undef SEAM
}

#if defined(DBG_BISECT)
__global__ void __launch_bounds__(256) dbg_cksum(const unsigned* p, size_t nwords, unsigned* slot) {
    unsigned s = 0;
    for (size_t i = (size_t)blockIdx.x * 256 + threadIdx.x; i < nwords; i += (size_t)gridDim.x * 256) { const unsigned w = p[i]; s += w * 2654435761u + (unsigned)(i & 0xffff) * (w >> 7); }
    for (int o = 1; o < 64; o <<= 1) s += __shfl_xor(s, o);
    if ((threadIdx.x & 63) == 0) atomicAdd(slot, s);
}
__global__ void dbg_report(const unsigned* tab, int nbuf, float* out, size_t nout) {
    int first = 0;
    for (int i = 0; i < nbuf; ++i) if (tab[i] != tab[64 + i]) { first = i + 1; break; }
    for (size_t i = (size_t)blockIdx.x * blockDim.x + threadIdx.x; i < nout; i += (size_t)gridDim.x * blockDim.x) out[i] = (float)first * 1000.f;
}
struct DbgBuf { size_t off, bytes; int phase; int where; };
static const DbgBuf DBG_BUFS[] = {
    {WS_WINT, (size_t)NPROJ * DM * 2, 0, 0}, {WS_W1T, (size_t)DFF * DM * 2, 0, 0}, {WS_W2T, (size_t)DFF * DM * 2, 0, 0}, {WS_WOT, (size_t)DM * DM * 2, 0, 0},
    {WS_WGT, (size_t)DM * 2048 * 2, 0, 0}, {WS_WMT, (size_t)DM * 2048 * 2, 0, 0}, {WS_WUQT, (size_t)3072 * 1024 * 2, 0, 0}, {WS_WUKVT, (size_t)4096 * 512 * 2, 0, 0},
    {WS_H0B, (size_t)LP * DM * 2, 0, 0}, {ST_RS1, (size_t)LP * 4, 0, 0}, {ST_COS, (size_t)LTOK * 32 * 4, 0, 0}, {ST_SIN, (size_t)LTOK * 32 * 4, 0, 0},
    {WS_GQ, (size_t)SEQ * 1024 * 2, 1, 0}, {WS_GK, (size_t)LP * 1024 * 2, 1, 0}, {WS_GV, (size_t)LP * 2048 * 2, 1, 0}, {WS_GOG, (size_t)SEQ * 2048 * 2, 1, 0},
    {WS_CQ, (size_t)SEQ * 1024 * 2, 1, 0}, {WS_CKV, (size_t)LP * 512 * 2, 1, 0}, {WS_GA, (size_t)SEQ * DM * 2, 1, 0}, {WS_GB, (size_t)SEQ * DM * 2, 1, 0},
    {ST_SMALL, (size_t)LP * 96 * 4, 1, 0}, {ST_CQSS, (size_t)SEQ * 16 * 4, 1, 0}, {ST_CKVSS, (size_t)LP * 8 * 4, 1, 0},
    {WS_QM, (size_t)SEQ * 3072 * 2, 2, 0}, {WS_KF, (size_t)LP * 3072 * 2, 2, 0}, {WS_VB, (size_t)LP * 2048 * 2, 2, 0},
    {WS_KHTF, (size_t)129 * 8 * 128 * 64 * 2, 2, 0}, {WS_KHTB, (size_t)128 * 8 * 128 * 64 * 2, 2, 0}, {WS_VT, (size_t)129 * 8 * 256 * 64 * 2, 2, 0},
    {ST_DLF, (size_t)129 * 8 * 128 * 4, 2, 0}, {ST_DLB, (size_t)128 * 8 * 128 * 4, 2, 0},
    {WS_SNAP, (size_t)2 * 128 * 8 * 256 * 128 * 2, 3, 0}, {WS_AO, (size_t)SEQ * 2048 * 2, 3, 0},
    {WS_AG, (size_t)SEQ * 2048 * 2, 4, 0},
    {WS_MERGED, (size_t)SEQ * DM * 2, 5, 0},
    {0, (size_t)SEQ * DM * 4, 6, 1}, {WS_H1B, (size_t)SEQ * DM * 2, 6, 0}, {ST_H1SS, (size_t)SEQ * 64 * 4, 6, 0},
    {WS_U, (size_t)SEQ * DFF * 2, 7, 0},
    {0, (size_t)SEQ * DM * 4, 8, 1}, {ST_H2SS, (size_t)SEQ * 64 * 4, 8, 0},
    {0, (size_t)SEQ * DM * 4, 9, 1},
};
static void dbg_launch(Args a, int grid, void* d_out, void* d_ws, hipStream_t stream) {
    const int nbuf = (int)(sizeof(DBG_BUFS) / sizeof(DBG_BUFS[0]));
    unsigned* tab = (unsigned*)((char*)d_ws + WS_CTL + 65536);
    for (int run = 0; run < 2; ++run)
        for (int p = 0; p < NPHASE; ++p) {
            a.ph_lo = p; a.ph_hi = p + 1; hipLaunchKernelGGL(mega_fwd, dim3(grid), dim3(NTHR), LDS_BYTES, stream, a);
            for (int i = 0; i < nbuf; ++i) if (DBG_BUFS[i].phase == p) {
                const char* base = DBG_BUFS[i].where ? (const char*)d_out : (const char*)d_ws + DBG_BUFS[i].off;
                hipLaunchKernelGGL(dbg_cksum, dim3(1024), dim3(256), 0, stream, (const unsigned*)base, DBG_BUFS[i].bytes / 4, tab + run * 64 + i);
            }
        }
    hipLaunchKernelGGL(dbg_report, dim3(1024), dim3(256), 0, stream, (const unsigned*)tab, nbuf, (float*)d_out, (size_t)SEQ * DM);
}

#endif
#ifndef MK_N_LAUNCHES
#define MK_N_LAUNCHES 1
#endif
extern "C" void kernel_launch(void* const* d_in, const int* in_sizes, int n_in, void* d_out, int out_size, void* d_ws, size_t ws_size, hipStream_t stream) {
    static int grid = 0;
    if (grid == 0) {
        if (n_in != 20 || out_size != SEQ * DM || ws_size < WS_END) { fprintf(stderr, "kernel_launch: unexpected shapes: n_in %d out %d ws %zu (need %zu)\n", n_in, out_size, ws_size, (size_t)WS_END); grid = -1; return; }
        int dev = 0, cus = 0, per_cu = 0;
        if (hipGetDevice(&dev) != hipSuccess || hipDeviceGetAttribute(&cus, hipDeviceAttributeMultiprocessorCount, dev) != hipSuccess) { grid = -1; return; }
        if (hipFuncSetAttribute((const void*)mega_fwd, hipFuncAttributeMaxDynamicSharedMemorySize, LDS_BYTES) != hipSuccess) { fprintf(stderr, "kernel_launch: hipFuncSetAttribute failed\n"); grid = -1; return; }
        if (hipOccupancyMaxActiveBlocksPerMultiprocessor(&per_cu, (const void*)mega_fwd, NTHR, LDS_BYTES) != hipSuccess || per_cu < 1) fprintf(stderr, "kernel_launch: occupancy query says %d\n", per_cu);
        (void)hipGetLastError();
        grid = cus;
    }
    if (grid < 0) return;
    if (hipMemsetAsync((char*)d_ws + WS_CTL, 0, CTL_BYTES, stream) != hipSuccess) return;
    Args a{};
    for (int i = 0; i < 20; ++i) a.in[i] = (const float*)d_in[i];
    a.out = (float*)d_out; a.ws = (unsigned char*)d_ws;
#if defined(DBG_BISECT)
    dbg_launch(a, grid, d_out, d_ws, stream);
#elif MK_N_LAUNCHES == 1
    a.ph_lo = 0; a.ph_hi = NPHASE;
    hipLaunchKernelGGL(mega_fwd, dim3(grid), dim3(NTHR), LDS_BYTES, stream, a);
#else
    for (int p = 0; p < NPHASE; ++p) { a.ph_lo = p; a.ph_hi = p + 1; hipLaunchKernelGGL(mega_fwd, dim3(grid), dim3(NTHR), LDS_BYTES, stream, a); }
#endif
    const hipError_t le = hipPeekAtLastError();
    if (le != hipSuccess) fprintf(stderr, "kernel_launch: launch failed: %s\n", hipGetErrorName(le));
}
```

```cpp
#include <hip/hip_runtime.h>
#include <cstdio>
#include <cstdint>
namespace pg8 {
#define PG8_LAS __attribute__((address_space(3)))
typedef unsigned short bf16_t;
typedef short bf16x8 __attribute__((ext_vector_type(8)));
typedef float f32x4 __attribute__((ext_vector_type(4)));
typedef unsigned u32x4 __attribute__((ext_vector_type(4)));
constexpr int BM = 256, BK = 64, HALF = 128, HTB = HALF * BK * 2  , STAGE_BYTES = 8 * HTB, NXCD = 8, WGM = 8;

__host__ __device__ __forceinline__ int lds_byte(int r, int c) { const int st = (r >> 4) * 2 + (c >> 5), rr = r & 15, cc = c & 31, ob = rr * 64 + cc * 2; return st * 1024 + (ob ^ (((ob >> 9) & 1) << 5)); }
__host__ __device__ __forceinline__ void stage_rc(int b, int& R, int& C) { const int st = b / 1024, sb = b % 1024, swz = sb ^ (((sb >> 9) & 1) << 5); R = (st >> 1) * 16 + swz / 64; C = (st & 1) * 32 + (swz % 64) / 2; }
__host__ __device__ __forceinline__ int perm32(int rho) { const int n = rho >> 4, i = rho & 15; return 8 * (i >> 2) + 4 * n + (i & 3); }

struct Unit { int pm, pn, sel; };
struct Gemm { const bf16_t* A; const bf16_t* Bt; int M, N, K; const bf16_t* A2; const bf16_t* Bt2; int lda, ldb; };

struct StaticOrder {
    int nM, nN, nwg, G, c;
    __host__ __device__ void init(int M, int N, int G_, int c_) { nM = M / BM; nN = N / BM; nwg = nM * nN; G = G_; c = c_; }
    __host__ __device__ __forceinline__ bool next(int i, Unit& u) const {
        const long L = (long)i * G + c; if (L >= nwg) return false;
        int wgid = (int)L; { const int q = nwg / NXCD, r = nwg % NXCD, xcd = wgid % NXCD, off = wgid / NXCD; wgid = (xcd < r ? xcd * (q + 1) : r * (q + 1) + (xcd - r) * q) + off; }
        const int nig = WGM * nN, gid = wgid / nig, fm = gid * WGM, gsz = (nM - fm) < WGM ? (nM - fm) : WGM;
        u.pm = fm + ((wgid % nig) % gsz); u.pn = (wgid % nig) / gsz; return true;
    }
    __device__ __forceinline__ void a_ready(const Unit&) const {}
    __device__ __forceinline__ void done(const Unit&) const {}
};

template <class Epi, class Sched, bool ALIGN_EPI = false, bool SP2 = false>
__device__ __forceinline__ void gemm_phase(PG8_LAS unsigned char* lds, const Gemm g, const Sched& S, const Epi& E) {
    int tid = threadIdx.x; asm volatile("" : "+v"(tid)); const int wid = __builtin_amdgcn_readfirstlane(tid >> 6), lane = tid & 63, wr = wid >> 2, wc = wid & 3, fr = lane & 15, fq = lane >> 4;
    const int K = g.K, nt = K / BK, lda = g.lda ? g.lda : K, ldb = g.ldb ? g.ldb : K;
    unsigned voffA[2], voffB[2];
#pragma unroll
    for (int i = 0; i < 2; ++i) { int R, C; stage_rc(tid * 16 + i * 8192, R, C); const int Rb = Epi::PERM ? ((R & ~31) + perm32(R & 31)) : R;
        voffA[i] = (unsigned)(R * lda + C) * 2u; voffB[i] = (unsigned)(Rb * ldb + C) * 2u; }
    const size_t kstep = (size_t)(BK * 2);
    const size_t hstepA = (size_t)HALF * lda * 2, hstepB = (size_t)HALF * ldb * 2;
    const size_t tstepA = 2 * hstepA, tstepB = 2 * hstepB;
    const unsigned ldsw = (unsigned)wid * 1024u;
    const int aoff = lds_byte(wr * 64 + fr, fq * 8), boff = lds_byte(wc * 32 + fr, fq * 8);
#define PG8_SA(b, h) (((b) * 2 + (h)) * HTB)
#define PG8_SB(b, h) ((4 + (b) * 2 + (h)) * HTB)
#define PG8_STAGE(bufoff, gbase, voff) do { _Pragma("unroll") for (int _i = 0; _i < 2; ++_i) \
        asm volatile("s_mov_b32 m0, %2\n\ts_nop 0\n\tglobal_load_lds_dwordx4 %0, %1" :: "v"((voff)[_i]), "s"((const char*)(gbase)), "s"((unsigned)(uintptr_t)(lds + (bufoff) + ldsw + _i * 8192)) : "memory", "m0"); } while (0)
#define PG8_LDA(dst, b, h) do { _Pragma("unroll") for (int m = 0; m < 4; ++m) _Pragma("unroll") for (int k = 0; k < 2; ++k) dst[m][k] = *(const PG8_LAS bf16x8*)(lds + PG8_SA(b, h) + aoff + m * 2048 + k * 1024); } while (0)
#define PG8_LDB(dst, b, h) do { _Pragma("unroll") for (int n = 0; n < 2; ++n) _Pragma("unroll") for (int k = 0; k < 2; ++k) dst[n][k] = *(const PG8_LAS bf16x8*)(lds + PG8_SB(b, h) + boff + n * 2048 + k * 1024); } while (0)
#define PG8_MMA(ai, bj, At, Bt) do { __builtin_amdgcn_s_setprio(1); _Pragma("unroll") for (int m = 0; m < 4; ++m) _Pragma("unroll") for (int n = 0; n < 2; ++n) _Pragma("unroll") for (int k = 0; k < 2; ++k) \
        acc[ai][bj][m][n] = __builtin_amdgcn_mfma_f32_16x16x32_bf16(Bt[n][k], At[m][k], acc[ai][bj][m][n], 0, 0, 0); __builtin_amdgcn_s_setprio(0); } while (0)
#define PG8_WAIT_V(n) asm volatile("s_waitcnt vmcnt(" #n ")" ::: "memory")
#define PG8_WAIT_L(n) asm volatile("s_waitcnt lgkmcnt(" #n ")" ::: "memory")
#define PG8_BAR __builtin_amdgcn_s_barrier()
#define PG8_SCHED __builtin_amdgcn_sched_barrier(0)
    Unit cur, nxt; int ui = 0;
    if (!S.next(0, cur)) return;
    f32x4 acc[2][2][4][2];
#pragma unroll
    for (int a = 0; a < 2; ++a)
#pragma unroll
        for (int b = 0; b < 2; ++b)
#pragma unroll
            for (int m = 0; m < 4; ++m)
#pragma unroll
                for (int n = 0; n < 2; ++n) acc[a][b][m][n] = (f32x4){0.f, 0.f, 0.f, 0.f};
    bf16x8 At[4][2], B0[2][2], B1[2][2];
    const char* cA = (const char*)((Epi::PAIRED && cur.sel) ? g.A2 : g.A) + (size_t)cur.pm * tstepA; const char* cB = (const char*)((Epi::PAIRED && cur.sel) ? g.Bt2 : g.Bt) + (size_t)cur.pn * tstepB;
    S.a_ready(cur);
    if constexpr (SP2) {
        PG8_STAGE(PG8_SB(0, 0), cB, voffB); PG8_STAGE(PG8_SB(0, 1), cB + hstepB, voffB); PG8_STAGE(PG8_SA(0, 0), cA, voffA); PG8_STAGE(PG8_SA(0, 1), cA + hstepA, voffA);
        if (wr == 1) PG8_BAR;
        PG8_WAIT_V(2); PG8_BAR;
        PG8_STAGE(PG8_SB(1, 0), cB + kstep, voffB); PG8_STAGE(PG8_SA(1, 0), cA + kstep, voffA); PG8_STAGE(PG8_SB(1, 1), cB + hstepB + kstep, voffB);
        PG8_WAIT_V(6); PG8_BAR;
    } else {
        PG8_STAGE(PG8_SB(0, 0), cB, voffB); PG8_STAGE(PG8_SA(0, 0), cA, voffA); PG8_STAGE(PG8_SB(0, 1), cB + hstepB, voffB); PG8_STAGE(PG8_SA(0, 1), cA + hstepA, voffA);
        if (wr == 1) PG8_BAR;
        PG8_WAIT_V(4); PG8_BAR;
        PG8_STAGE(PG8_SB(1, 0), cB + kstep, voffB); PG8_STAGE(PG8_SA(1, 0), cA + kstep, voffA); PG8_STAGE(PG8_SB(1, 1), cB + hstepB + kstep, voffB);
        PG8_WAIT_V(6); PG8_BAR;
    }
    for (;;) {
        const bool has_next = S.next(ui + 1, nxt);
        const char* nA = has_next ? (const char*)((Epi::PAIRED && nxt.sel) ? g.A2 : g.A) + (size_t)nxt.pm * tstepA : cA; const char* nB = has_next ? (const char*)((Epi::PAIRED && nxt.sel) ? g.Bt2 : g.Bt) + (size_t)nxt.pn * tstepB : cB;
        for (int t = 0; t < nt; t += 2) {
            const bool last = (t == nt - 2);
            const char* a1 = cA + (size_t)(t + 1) * kstep;
            const char* a2 = last ? nA : cA + (size_t)(t + 2) * kstep; const char* b2 = last ? nB : cB + (size_t)(t + 2) * kstep;
            const char* a3 = a2 + kstep; const char* b3 = b2 + kstep;
            if (last && has_next) S.a_ready(nxt);
            if constexpr (SP2) {
            PG8_LDB(B0, 0, 0); PG8_LDB(B1, 0, 1); PG8_SCHED; PG8_LDA(At, 0, 0); PG8_STAGE(PG8_SA(1, 1), a1 + hstepA, voffA);
            PG8_WAIT_V(8); PG8_WAIT_L(0); PG8_BAR; PG8_MMA(0, 0, At, B0); PG8_MMA(0, 1, At, B1); PG8_BAR; PG8_SCHED;
            PG8_LDA(At, 0, 1); PG8_STAGE(PG8_SB(0, 0), b2, voffB); PG8_STAGE(PG8_SB(0, 1), b2 + hstepB, voffB); PG8_STAGE(PG8_SA(0, 0), a2, voffA);
            PG8_WAIT_V(8); PG8_WAIT_L(0); PG8_BAR; PG8_MMA(1, 0, At, B0); PG8_MMA(1, 1, At, B1); PG8_BAR; PG8_SCHED;
            PG8_LDB(B0, 1, 0); PG8_LDB(B1, 1, 1); PG8_SCHED; PG8_LDA(At, 1, 0); PG8_STAGE(PG8_SA(0, 1), a2 + hstepA, voffA);
            PG8_WAIT_V(8); PG8_WAIT_L(0); PG8_BAR; PG8_MMA(0, 0, At, B0); PG8_MMA(0, 1, At, B1); PG8_BAR; PG8_SCHED;
            PG8_LDA(At, 1, 1); PG8_STAGE(PG8_SB(1, 0), b3, voffB); PG8_STAGE(PG8_SB(1, 1), b3 + hstepB, voffB); PG8_STAGE(PG8_SA(1, 0), a3, voffA);
            PG8_WAIT_V(8); PG8_WAIT_L(0); PG8_BAR; PG8_MMA(1, 0, At, B0); PG8_MMA(1, 1, At, B1); PG8_BAR; PG8_SCHED;
            } else {
            PG8_LDB(B0, 0, 0); PG8_SCHED; PG8_LDA(At, 0, 0); PG8_STAGE(PG8_SA(1, 1), a1 + hstepA, voffA);
            PG8_WAIT_L(8); PG8_BAR; PG8_WAIT_L(0); PG8_MMA(0, 0, At, B0); PG8_BAR; PG8_SCHED;
            PG8_LDB(B1, 0, 1); PG8_STAGE(PG8_SB(0, 0), b2, voffB);
            PG8_BAR; PG8_WAIT_L(0); PG8_MMA(0, 1, At, B1); PG8_BAR;
            PG8_LDA(At, 0, 1); PG8_STAGE(PG8_SA(0, 0), a2, voffA);
            PG8_BAR; PG8_WAIT_L(0); PG8_MMA(1, 0, At, B0); PG8_BAR; PG8_SCHED;
            PG8_STAGE(PG8_SB(0, 1), b2 + hstepB, voffB);
            PG8_WAIT_V(6); PG8_BAR; PG8_MMA(1, 1, At, B1); PG8_BAR;
            PG8_LDB(B0, 1, 0); PG8_SCHED; PG8_LDA(At, 1, 0); PG8_STAGE(PG8_SA(0, 1), a2 + hstepA, voffA);
            PG8_WAIT_L(8); PG8_BAR; PG8_WAIT_L(0); PG8_MMA(0, 0, At, B0); PG8_BAR; PG8_SCHED;
            PG8_LDB(B1, 1, 1); PG8_STAGE(PG8_SB(1, 0), b3, voffB);
            PG8_BAR; PG8_WAIT_L(0); PG8_MMA(0, 1, At, B1); PG8_BAR;
            PG8_LDA(At, 1, 1); PG8_STAGE(PG8_SA(1, 0), a3, voffA);
            PG8_BAR; PG8_WAIT_L(0); PG8_MMA(1, 0, At, B0); PG8_BAR; PG8_SCHED;
            PG8_STAGE(PG8_SB(1, 1), b3 + hstepB, voffB);
            PG8_WAIT_V(6); PG8_BAR; PG8_MMA(1, 1, At, B1); PG8_BAR;
            }
        }
        if constexpr (ALIGN_EPI) { if (wr == 0) PG8_BAR; }
        bool keep_acc = false;
        if constexpr (Epi::PAIRED) { if (cur.sel == 0) { E.mid(acc, cur, wr, wc, fr, fq); keep_acc = true; } else { E(acc, cur, wr, wc, fr, fq); S.done(cur); } }
        else if constexpr (!Epi::AFTER_DRAIN) { E(acc, cur, wr, wc, fr, fq); S.done(cur); }
        if (!has_next) break;
        if (!keep_acc)
#pragma unroll
        for (int a = 0; a < 2; ++a)
#pragma unroll
            for (int b = 0; b < 2; ++b)
#pragma unroll
                for (int m = 0; m < 4; ++m)
#pragma unroll
                    for (int n = 0; n < 2; ++n) acc[a][b][m][n] = (f32x4){0.f, 0.f, 0.f, 0.f};
        cur = nxt; cA = nA; cB = nB; ++ui;
        if constexpr (ALIGN_EPI) { if (wr == 1) PG8_BAR; }
    }
    PG8_WAIT_V(0);
    if constexpr (!ALIGN_EPI) { if (wr == 0) PG8_BAR; }
    PG8_BAR;
    if constexpr (Epi::AFTER_DRAIN) { E.fused(acc, cur, wr, wc, fr, fq, lds, wid, lane); S.done(cur); }
#undef PG8_SA
#undef PG8_SB
#undef PG8_STAGE
#undef PG8_LDA
#undef PG8_LDB
#undef PG8_MMA
#undef PG8_WAIT_V
#undef PG8_WAIT_L
#undef PG8_BAR
#undef PG8_SCHED
}
}
#define LAS __attribute__((address_space(3)))
#define XB_TMO      128
#define XB_XCNT(j)  (256  + 64 * (j))
#define XB_XSUB(j)  (1280 + 64 * (j))
#define XB_XGEN(j)  (2304 + 64 * (j))
#define XB_TOP      3328
#define XB_TOPGEN   3392
#define XCD_BAR_WORDS 3456
#define XB_SPIN_CAP (1u << 18)

__device__ __forceinline__ unsigned xb_ld(unsigned* p)              { return __hip_atomic_load(p, __ATOMIC_RELAXED, __HIP_MEMORY_SCOPE_AGENT); }
__device__ __forceinline__ unsigned xb_add(unsigned* p, unsigned v) { return __hip_atomic_fetch_add(p, v, __ATOMIC_RELAXED, __HIP_MEMORY_SCOPE_AGENT); }
__device__ __forceinline__ unsigned xb_xcc_id() { return (unsigned)__builtin_amdgcn_s_getreg((3 << 11) | 20) & 0xFu; }
#define XB_SPIN(cond, bar) do { unsigned _sp = 0; while (cond) { __builtin_amdgcn_s_sleep(1); \
    if ((++_sp & 255u) == 0u) { if (xb_ld(&(bar)[XB_TMO])) break; if (_sp > XB_SPIN_CAP) { atomicAdd(&(bar)[XB_TMO], 1u); break; } } } } while (0)

struct XcdBarrier {
    unsigned* bar; unsigned x;
    volatile LAS unsigned* st;
};

__device__ __forceinline__ XcdBarrier xcd_barrier_post(unsigned* bar, volatile LAS unsigned* st) {
    XcdBarrier b; b.bar = bar; b.x = xb_xcc_id(); b.st = st;
    if (threadIdx.x == 0) (void)xb_add(&bar[XB_XCNT(b.x)], 1u);
    return b;
}
__device__ __forceinline__ void xcd_barrier_complete(unsigned* bar, unsigned x, unsigned& nloc, unsigned& nx) {
    const unsigned G = gridDim.x * gridDim.y * gridDim.z;
    unsigned sum, cnt, mine, sp = 0u;
    for (;;) {
        sum = 0u; cnt = 0u; mine = 0u;
#pragma unroll
        for (unsigned j = 0; j < 16; ++j) { const unsigned c = xb_ld(&bar[XB_XCNT(j)]); sum += c; cnt += (c > 0u) ? 1u : 0u; mine = (j == x) ? c : mine; }
        if (sum == G) break;
        __builtin_amdgcn_s_sleep(1);
        if ((++sp & 255u) == 0u) { if (xb_ld(&bar[XB_TMO])) break; if (sp > XB_SPIN_CAP) { atomicAdd(&bar[XB_TMO], 1u); break; } }
    }
    nloc = mine > 0u ? mine : 1u; nx = cnt > 0u ? cnt : 1u;
}

__device__ __forceinline__ void xcd_barrier(const XcdBarrier& b) {
    asm volatile("s_waitcnt vmcnt(0)" ::: "memory");
    __syncthreads();
    if (threadIdx.x == 0) {
        unsigned* bar = b.bar;
        __builtin_amdgcn_s_waitcnt(0);
        unsigned nloc = b.st[0], nx = b.st[1];
        if (nloc == 0u) { xcd_barrier_complete(bar, b.x, nloc, nx); b.st[0] = nloc; b.st[1] = nx; }
        const unsigned old = xb_add(&bar[XB_XSUB(b.x)], 1u);
        const unsigned gen = old / nloc;
        if (old + 1u == (gen + 1u) * nloc) {
            __builtin_amdgcn_fence(__ATOMIC_RELEASE, "agent");
            asm volatile("s_waitcnt vmcnt(0)" ::: "memory");
            const unsigned og = xb_add(&bar[XB_TOP], 1u);
            const unsigned tg = og / nx;
            if (og + 1u == (tg + 1u) * nx) xb_add(&bar[XB_TOPGEN], 1u);
            else XB_SPIN(xb_ld(&bar[XB_TOPGEN]) == tg, bar);
            __builtin_amdgcn_fence(__ATOMIC_ACQUIRE, "agent");
            xb_add(&bar[XB_XGEN(b.x)], 1u);
            asm volatile("s_waitcnt vmcnt(0)" ::: "memory");
        } else {
            XB_SPIN(xb_ld(&bar[XB_XGEN(b.x)]) == gen, bar);
            __builtin_amdgcn_fence(__ATOMIC_ACQUIRE, "agent");
            asm volatile("s_waitcnt vmcnt(0)" ::: "memory");
        }
    }
    __syncthreads();
}
constexpr int NWAVES = 8, NTHR = 512;
constexpr int DM = 4096, SEQ = 8192, NMETA = 16, LTOK = SEQ + NMETA  , LP = 8448  ;
constexpr int NPROJ = 16128;
constexpr int DFF = 16384;
constexpr int GH = 8, GDK = 128, GDV = 256, GCH = 64, NXC = SEQ / GCH  ;
constexpr int MH = 16, MQK = 192, MNOPE = 128, MROPE = 64, MV = 128, QRANK = 1024, KVRANK = 512;
constexpr float EPS = 1e-6f;
constexpr float GLA_QSCALE = 0.08838834764831845f;
constexpr float MLA_QSCALE = 0.07216878364870323f * 1.4426950408889634f;
constexpr size_t KiB = 1024, MiB = 1024 * 1024;
constexpr size_t WS_CTL = 0, CTL_BYTES = 1 * MiB;
constexpr size_t WS_W1T = WS_CTL + CTL_BYTES;
constexpr size_t WS_W2T = WS_W1T + (size_t)DFF * DM * 2;
constexpr size_t WS_WOT = WS_W2T + (size_t)DFF * DM * 2;
constexpr size_t WS_WGT = WS_WOT + (size_t)DM * DM * 2;
constexpr size_t WS_WMT = WS_WGT + (size_t)DM * 2048 * 2;
constexpr size_t WS_WUQT = WS_WMT + (size_t)DM * 2048 * 2;
constexpr size_t WS_WUKVT = WS_WUQT + (size_t)3072 * 1024 * 2;
constexpr size_t WS_STATS = WS_WUKVT + (size_t)4096 * 512 * 2;
constexpr size_t ST_RS1 = WS_STATS;
constexpr size_t ST_CQSS = ST_RS1 + (size_t)LP * 4;
constexpr size_t ST_CKVSS = ST_CQSS + (size_t)SEQ * 16 * 4;
constexpr size_t ST_H1SS = ST_CKVSS + (size_t)LP * 8 * 4;
constexpr size_t ST_H2SS = ST_H1SS + (size_t)SEQ * 64 * 4;
constexpr size_t ST_COS = ST_H2SS + (size_t)SEQ * 64 * 4;
constexpr size_t ST_SIN = ST_COS + (size_t)LTOK * 32 * 4;
constexpr size_t ST_DLF = ST_SIN + (size_t)LTOK * 32 * 4;
constexpr size_t ST_DLB = ST_DLF + (size_t)129 * 8 * 128 * 4;
constexpr size_t ST_SMALL = ST_DLB + (size_t)128 * 8 * 128 * 4;
constexpr size_t WS_R1 = (ST_SMALL + (size_t)LP * 96 * 4 + 4095) / 4096 * 4096;
constexpr size_t WS_WINT = WS_R1;
constexpr size_t WS_QM = WS_R1;
constexpr size_t WS_KF = WS_QM + (size_t)SEQ * 3072 * 2;
constexpr size_t WS_R2 = WS_R1 + (size_t)NPROJ * DM * 2;
static_assert(WS_KF + (size_t)LP * 3072 * 2 <= WS_R2, "R1 overlay");
constexpr size_t WS_H0B = WS_R2;
constexpr size_t WS_AO = WS_R2;
constexpr size_t WS_AG = WS_AO + (size_t)SEQ * 2048 * 2;
constexpr size_t WS_P = WS_R2 + (size_t)LP * DM * 2;
static_assert(WS_AG + (size_t)SEQ * 2048 * 2 <= WS_P, "R2 overlay");
constexpr size_t WS_GQ = WS_P;
constexpr size_t WS_GK = WS_GQ + (size_t)SEQ * 1024 * 2;
constexpr size_t WS_GV = WS_GK + (size_t)LP * 1024 * 2;
constexpr size_t WS_GOG = WS_GV + (size_t)LP * 2048 * 2;
constexpr size_t WS_MERGED = WS_P;
static_assert(WS_MERGED + (size_t)SEQ * DM * 2 <= WS_GOG, "merged overlay");
constexpr size_t WS_CQ = WS_GOG + (size_t)SEQ * 2048 * 2;
constexpr size_t WS_CKV = WS_CQ + (size_t)SEQ * 1024 * 2;
constexpr size_t WS_GA = WS_CKV + (size_t)LP * 512 * 2;
constexpr size_t WS_GB = WS_GA + (size_t)SEQ * DM * 2;
constexpr size_t WS_U = WS_R1;
constexpr size_t WS_VB = WS_GB + (size_t)SEQ * DM * 2;
constexpr int LDU = DFF;
static_assert(WS_U + (size_t)SEQ * LDU * 2 <= WS_VB, "U overlay");
constexpr size_t WS_KHTF = WS_VB + (size_t)LP * 2048 * 2;
constexpr size_t WS_KHTB = WS_KHTF + (size_t)129 * 8 * 128 * 64 * 2;
constexpr size_t WS_VT = WS_KHTB + (size_t)128 * 8 * 128 * 64 * 2;
constexpr size_t WS_SNAP = WS_VT + (size_t)129 * 8 * 256 * 64 * 2;
constexpr size_t WS_H1B = WS_SNAP;
constexpr size_t WS_END = WS_SNAP + (size_t)2 * 128 * 8 * 256 * 128 * 2;
static_assert(WS_END <= (size_t)1024 * MiB, "d_ws budget: 4 x largest tensor = 1 GiB");
constexpr int CW_BAR = 4096;
constexpr int LDS_BYTES = 163840;
constexpr int LDS_CTL = LDS_BYTES - 256;

#define GAS __attribute__((address_space(1)))
typedef unsigned short bf16;
typedef float f32x4 __attribute__((ext_vector_type(4)));
typedef float f32x16 __attribute__((ext_vector_type(16)));
typedef short bf16x8 __attribute__((ext_vector_type(8)));
typedef short s16x4 __attribute__((ext_vector_type(4)));
typedef unsigned u32x4 __attribute__((ext_vector_type(4)));
typedef unsigned u32x2 __attribute__((ext_vector_type(2)));
#define LDS_WAIT() asm volatile("s_waitcnt lgkmcnt(0)" ::: "memory")
#define VM_WAIT() asm volatile("s_waitcnt vmcnt(0)" ::: "memory")
#define SBAR() __builtin_amdgcn_sched_barrier(0)
typedef float f32x2_ __attribute__((ext_vector_type(2)));
typedef __bf16 bf16x2_ __attribute__((ext_vector_type(2)));
__device__ __forceinline__ unsigned cvtpk(float lo, float hi) { const f32x2_ v = {lo, hi}; return __builtin_bit_cast(unsigned, __builtin_convertvector(v, bf16x2_)); }
__device__ __forceinline__ float bf2f(unsigned short b) { return __uint_as_float(((unsigned)b) << 16); }
__device__ __forceinline__ float bflo(unsigned w) { return __uint_as_float(w << 16); }
__device__ __forceinline__ float bfhi(unsigned w) { return __uint_as_float(w & 0xffff0000u); }
__device__ __forceinline__ unsigned short f2bf(float f) { return (unsigned short)(cvtpk(f, 0.f) & 0xffffu); }
__device__ __forceinline__ float wave_sum(float v) {
#pragma unroll
    for (int o = 1; o < 64; o <<= 1) v += __shfl_xor(v, o);
    return v;
}
__device__ __forceinline__ float sigmoidf_(float x) { return __builtin_amdgcn_rcpf(1.f + __expf(-x)); }
__device__ __forceinline__ float logsig16(float z) { return (fminf(z, 0.f) - __logf(1.f + __expf(-fabsf(z)))) * 0.0625f; }
template <int KIND> __device__ __forceinline__ int srccol(int n) {
    if (KIND == 1) {
        if (n < 6144) return n;
        if (n < 7168) return 6176 + (n - 6144);
        if (n < 7680) return 7200 + (n - 7168);
        if (n < 15872) return 7776 + (n - 7680);
        if (n < 15936) return 7712 + (n - 15872);
        if (n < 15968) return 6144 + (n - 15936);
        return -1;
    } else if (KIND == 2) {
        const int h = n / 192, w = n - h * 192;
        if (w < 128) return n;
        const int p = w - 128, gp = p >> 5, fq = (p >> 3) & 3, nn = (p >> 2) & 1, j = p & 3;
        return h * 192 + 128 + 32 * nn + 16 * gp + 4 * fq + j;
    }
    return n;
}
constexpr int P0_SCR = 64 * 65 * 4;
struct P0Item { const float* W; const float* gain; bf16* WT; int K, N, kind, k0, n0; };
template <int KIND> __device__ __forceinline__ void p0_load_k(const P0Item& d, f32x4 (&v)[16], int lane) {
    const int sc = srccol<KIND>(d.n0 + 4 * (lane & 15)), kr = lane >> 4;
#pragma unroll
    for (int i = 0; i < 16; ++i) v[i] = sc >= 0 ? *(const GAS f32x4*)(d.W + (size_t)(d.k0 + 4 * i + kr) * d.N + sc) : (f32x4){0.f, 0.f, 0.f, 0.f};
}
__device__ __forceinline__ void p0_load(const P0Item& d, f32x4 (&v)[16], int lane) {
    if (d.kind == 1) p0_load_k<1>(d, v, lane); else if (d.kind == 2) p0_load_k<2>(d, v, lane); else p0_load_k<0>(d, v, lane);
}
__device__ __forceinline__ void p0_finish(const P0Item& d, const f32x4 (&v)[16], LAS float* scr, int lane) {
    const int kr = lane >> 4, c4 = 4 * (lane & 15), c = lane & 7;
    f32x4 g0 = (f32x4){1.f, 1.f, 1.f, 1.f}, g1 = g0;
    if (d.gain) { g0 = *(const GAS f32x4*)(d.gain + d.k0 + 8 * c); g1 = *(const GAS f32x4*)(d.gain + d.k0 + 8 * c + 4); }
#pragma unroll
    for (int i = 0; i < 16; ++i) { LAS float* w = scr + (4 * i + kr) * 65 + c4; w[0] = v[i][0]; w[1] = v[i][1]; w[2] = v[i][2]; w[3] = v[i][3]; }
    LDS_WAIT(); asm volatile("" ::: "memory");
#pragma unroll
    for (int j = 0; j < 8; ++j) { const int n = (lane >> 3) + 8 * j; const LAS float* s = scr + (8 * c) * 65 + n;
        u32x4 o; o.x = cvtpk(s[0 * 65] * g0[0], s[1 * 65] * g0[1]); o.y = cvtpk(s[2 * 65] * g0[2], s[3 * 65] * g0[3]); o.z = cvtpk(s[4 * 65] * g1[0], s[5 * 65] * g1[1]); o.w = cvtpk(s[6 * 65] * g1[2], s[7 * 65] * g1[3]);
        *(GAS u32x4*)(d.WT + (size_t)(d.n0 + n) * d.K + d.k0 + 8 * c) = o; }
    LDS_WAIT(); asm volatile("" ::: "memory");
}
__device__ __forceinline__ void p0_mk(P0Item& d, const float* W, int K, int N, const float* gain, bf16* WT, int kind, int item, int nblk) {
    const int kb = item / nblk, nb = item - kb * nblk; d.W = W; d.gain = gain; d.WT = WT; d.K = K; d.N = N; d.kind = kind; d.k0 = 64 * kb; d.n0 = 64 * nb;
}
__device__ const double ROPE_INVF[32] = {
1.00000000000000000e+00, 7.49894209332455874e-01, 5.62341325190349073e-01, 4.21696503428582226e-01, 3.16227766016837941e-01, 2.37137370566165517e-01, 1.77827941003892293e-01, 1.33352143216332403e-01,
1.00000000000000006e-01, 7.49894209332455791e-02, 5.62341325190349114e-02, 4.21696503428582239e-02, 3.16227766016837913e-02, 2.37137370566165538e-02, 1.77827941003892293e-02, 1.33352143216332406e-02,
1.00000000000000002e-02, 7.49894209332455791e-03, 5.62341325190349097e-03, 4.21696503428582292e-03, 3.16227766016837939e-03, 2.37137370566165538e-03, 1.77827941003892275e-03, 1.33352143216332406e-03,
1.00000000000000002e-03, 7.49894209332455856e-04, 5.62341325190349097e-04, 4.21696503428582237e-04, 3.16227766016837939e-04, 2.37137370566165538e-04, 1.77827941003892270e-04, 1.33352143216332395e-04 };
__device__ __forceinline__ void rope_cs(int pos, int i, float& c, float& s) {
    const double x = (double)pos * ROPE_INVF[i];
    const double k = __builtin_rint(x * 0.15915494309189534561);
    double r = __builtin_fma(-k, 6.283185307179586, x); r = __builtin_fma(-k, 2.4492935982947064e-16, r);
    const double r2 = r * r;
    double ss = 1.0, cc = 1.0;
#pragma unroll
    for (int n = 14; n >= 1; --n) { ss = 1.0 - ss * r2 * (1.0 / (double)((2 * n) * (2 * n + 1))); cc = 1.0 - cc * r2 * (1.0 / (double)((2 * n - 1) * (2 * n))); }
    s = (float)(r * ss); c = (float)cc;
}
struct P0Args { const float *x, *meta, *ln1, *w_in, *q_norm, *w_uq, *kv_norm, *w_ukv, *w_gla_out, *w_mla_out, *w_o, *ln2, *w_ff1, *w_ff2; unsigned char* ws; };
__device__ __forceinline__ bool p0_item_early(const P0Args& a, int it, P0Item& d) {
    constexpr int I_IN = (DM / 64) * (NPROJ / 64), I_UQ = (QRANK / 64) * (3072 / 64), I_UKV = (KVRANK / 64) * (4096 / 64), NITEMS = I_IN + I_UQ + I_UKV;
    if (it >= NITEMS) return false;
    unsigned char* ws = a.ws; int r = it;
    if (r < I_IN) { p0_mk(d, a.w_in, DM, 15968, a.ln1, (bf16*)(ws + WS_WINT), 1, r, NPROJ / 64); return true; } r -= I_IN;
    if (r < I_UQ) { p0_mk(d, a.w_uq, QRANK, 3072, a.q_norm, (bf16*)(ws + WS_WUQT), 2, r, 3072 / 64); return true; } r -= I_UQ;
    p0_mk(d, a.w_ukv, KVRANK, 4096, a.kv_norm, (bf16*)(ws + WS_WUKVT), 0, r, 4096 / 64); return true;
}
__device__ __forceinline__ bool p0_item_late(const P0Args& a, int it, P0Item& d) {
    constexpr int I_F1 = (DM / 64) * (DFF / 64), I_F2 = (DFF / 64) * (DM / 64), I_O = (DM / 64) * (DM / 64), I_G = (2048 / 64) * (DM / 64), I_M = I_G, NITEMS = I_F1 + I_F2 + I_O + I_G + I_M;
    if (it >= NITEMS) return false;
    unsigned char* ws = a.ws; int r = it;
    if (r < I_G) { p0_mk(d, a.w_gla_out, 2048, DM, nullptr, (bf16*)(ws + WS_WGT), 0, r, DM / 64); return true; } r -= I_G;
    if (r < I_M) { p0_mk(d, a.w_mla_out, 2048, DM, nullptr, (bf16*)(ws + WS_WMT), 0, r, DM / 64); return true; } r -= I_M;
    if (r < I_O) { p0_mk(d, a.w_o, DM, DM, nullptr, (bf16*)(ws + WS_WOT), 0, r, DM / 64); return true; } r -= I_O;
    if (r < I_F1) { p0_mk(d, a.w_ff1, DM, DFF, a.ln2, (bf16*)(ws + WS_W1T), 0, r, DFF / 64); return true; } r -= I_F1;
    p0_mk(d, a.w_ff2, DFF, DM, nullptr, (bf16*)(ws + WS_W2T), 0, r, DM / 64); return true;
}
template <bool LATE> __device__ __forceinline__ void p0_weights(const P0Args& a, LAS unsigned char* lds, int gw, int NGW, int wave, int lane) {
    LAS float* scr = (LAS float*)(lds + wave * P0_SCR);
    P0Item cur, nxt; f32x4 va[16], vb[16];
    bool have = LATE ? p0_item_late(a, gw, cur) : p0_item_early(a, gw, cur);
    if (have) p0_load(cur, va, lane);
    for (int it = gw; have; it += 2 * NGW) {
        const bool h1 = LATE ? p0_item_late(a, it + NGW, nxt) : p0_item_early(a, it + NGW, nxt);
        if (h1) p0_load(nxt, vb, lane);
        p0_finish(cur, va, scr, lane);
        if (!h1) break;
        have = LATE ? p0_item_late(a, it + 2 * NGW, cur) : p0_item_early(a, it + 2 * NGW, cur);
        if (have) p0_load(cur, va, lane);
        p0_finish(nxt, vb, scr, lane);
    }
}
__device__ __forceinline__ void p0_weights_early(const P0Args& a, LAS unsigned char* lds, int gw, int NGW, int wave, int lane) { p0_weights<false>(a, lds, gw, NGW, wave, lane); }
__device__ __forceinline__ void p0_weights_late(const P0Args& a, LAS unsigned char* lds, int gw, int NGW, int wave, int lane) { p0_weights<true>(a, lds, gw, NGW, wave, lane); }
__device__ __forceinline__ void p0_prologue(const P0Args& a, LAS unsigned char* lds, int gw, int NGW, int wave, int lane) {
    { const int ngw_w = NGW >= 252 ? (NGW / 252) * 252 : NGW; if (gw < ngw_w) p0_weights_early(a, lds, gw, ngw_w, wave, lane); }
    unsigned char* ws = a.ws;
    bf16* H0B = (bf16*)(ws + WS_H0B); float* RS1 = (float*)(ws + ST_RS1);
    for (int m = gw; m < LP; m += NGW) {
        GAS u32x2* o8 = (GAS u32x2*)(H0B + (size_t)m * DM) + lane;
        if (m >= LTOK) {
#pragma unroll
            for (int j = 0; j < 16; ++j) o8[64 * j] = (u32x2){0u, 0u};
            if (lane == 0) RS1[m] = 0.f;
            continue;
        }
        const float* src = m < SEQ ? a.x + (size_t)m * DM : a.meta + (size_t)(m - SEQ) * DM;
        const GAS f32x4* xr = (const GAS f32x4*)src + lane;
        f32x4 v[16]; float s = 0.f;
#pragma unroll
        for (int j = 0; j < 16; ++j) { v[j] = xr[64 * j]; s += (v[j].x * v[j].x + v[j].y * v[j].y) + (v[j].z * v[j].z + v[j].w * v[j].w); }
        s = wave_sum(s);
        if (lane == 0) RS1[m] = 1.f / sqrtf(s * (1.f / DM) + EPS);
#pragma unroll
        for (int j = 0; j < 16; ++j) o8[64 * j] = (u32x2){cvtpk(v[j].x, v[j].y), cvtpk(v[j].z, v[j].w)};
    }
    float* COS = (float*)(ws + ST_COS); float* SIN = (float*)(ws + ST_SIN);
    for (int i = gw * 64 + lane; i < LTOK * 32; i += NGW * 64) { float c, s; rope_cs(i >> 5, i & 31, c, s); COS[i] = c; SIN[i] = s; }
}
__device__ __forceinline__ void st_bf8(bf16* p, f32x4 v0, f32x4 v1) { u32x4 w; w.x = cvtpk(v0[0], v0[1]); w.y = cvtpk(v0[2], v0[3]); w.z = cvtpk(v1[0], v1[1]); w.w = cvtpk(v1[2], v1[3]); *(GAS u32x4*)p = w; }
__device__ __forceinline__ void st_bf8_nt(bf16* p, f32x4 v0, f32x4 v1) { u32x4 w; w.x = cvtpk(v0[0], v0[1]); w.y = cvtpk(v0[2], v0[3]); w.z = cvtpk(v1[0], v1[1]); w.w = cvtpk(v1[2], v1[3]); __builtin_nontemporal_store(w, (GAS u32x4*)p); }
__device__ __forceinline__ void ld_bf8(const bf16* p, f32x4& a, f32x4& b) { const u32x4 w = *(const GAS u32x4*)p; a = (f32x4){bflo(w.x), bfhi(w.x), bflo(w.y), bfhi(w.y)}; b = (f32x4){bflo(w.z), bfhi(w.z), bflo(w.w), bfhi(w.w)}; }
__device__ __forceinline__ float dot4(f32x4 a) { return (a[0] * a[0] + a[1] * a[1]) + (a[2] * a[2] + a[3] * a[3]); }
#define EPI_ROWS(ai, m) _Pragma("unroll") for (int ai = 0; ai < 2; ++ai) _Pragma("unroll") for (int m = 0; m < 4; ++m)

struct ProjOrder {
    pg8::StaticOrder so; int G, c;
    __device__ void init(int G_, int c_) { so.init(SEQ, NPROJ, G_, c_); G = G_; c = c_; }
    __device__ bool next(int i, pg8::Unit& u) const {
        const int L = i * G + c;
        if (L < 32 * 63) { const bool ok = so.next(i, u); const int p2 = 2 * u.pn; u.pn = p2 < 63 ? p2 : p2 - 63; return ok; }
        const int e = L - 32 * 63; if (e >= 15) return false;
        u.pm = 32; u.pn = e < 12 ? 4 + e : (e == 12 ? 28 : (e == 13 ? 29 : 62)); return true;
    }
    __device__ __forceinline__ void a_ready(const pg8::Unit&) const {}
    __device__ __forceinline__ void done(const pg8::Unit&) const {}
};
struct EpiProj {
    static constexpr bool PERM = true, AFTER_DRAIN = false, PAIRED = false;
    unsigned char* ws;
    template <int MODE> __device__ __forceinline__ void body(const f32x4 (&acc)[2][2][4][2], bf16* base, int ld, int ct, float* ss, int ssld, int row0, int cl, int wc, int fq) const {
        const float* RS1 = (const float*)(ws + ST_RS1); float* SMALL = (float*)(ws + ST_SMALL);
        float rsv[2][4];
        EPI_ROWS(ai, m) rsv[ai][m] = RS1[row0 + ai * 128 + m * 16];
        EPI_ROWS(ai, m) {
            const int row = row0 + ai * 128 + m * 16; const float rs = rsv[ai][m]; float ssum = 0.f;
#pragma unroll
            for (int bj = 0; bj < 2; ++bj) {
                f32x4 v0 = acc[ai][bj][m][0] * rs, v1 = acc[ai][bj][m][1] * rs;
                if constexpr (MODE == 5) { if (bj == 0 && wc < 3) { GAS f32x4* d = (GAS f32x4*)(SMALL + (size_t)row * 96 + cl); d[0] = v0; d[1] = v1; } }
                else {
                    if constexpr (MODE == 1) { v0 = v0 * GLA_QSCALE; v1 = v1 * GLA_QSCALE; }
                    if constexpr (MODE == 2 || MODE == 3) {
                        f32x4 e0 = v0 * (-1.4426950408889634f), e1 = v1 * (-1.4426950408889634f);
#pragma unroll
                        for (int j = 0; j < 4; ++j) { e0[j] = __builtin_amdgcn_exp2f(e0[j]); e1[j] = __builtin_amdgcn_exp2f(e1[j]); }
                        asm volatile("" : "+v"(e0), "+v"(e1));
                        e0 = e0 + 1.f; e1 = e1 + 1.f;
#pragma unroll
                        for (int j = 0; j < 4; ++j) { e0[j] = __builtin_amdgcn_rcpf(e0[j]); e1[j] = __builtin_amdgcn_rcpf(e1[j]); }
                        asm volatile("" : "+v"(e0), "+v"(e1));
                        if constexpr (MODE == 2) { v0 = v0 * e0; v1 = v1 * e1; } else { v0 = e0; v1 = e1; } }
                    if constexpr (MODE == 4) ssum += dot4(v0) + dot4(v1);
                    st_bf8(base + (size_t)row * ld + ct * 256 + bj * 128 + cl, v0, v1);
                }
            }
            if constexpr (MODE == 4) { ssum += __shfl_xor(ssum, 16); ssum += __shfl_xor(ssum, 32); if (fq == 0) ss[(size_t)row * ssld + ct * 4 + wc] = ssum; }
        }
    }
    __device__ __forceinline__ void operator()(const f32x4 (&acc)[2][2][4][2], const pg8::Unit& u, int wr, int wc, int fr, int fq) const {
        const int pn = u.pn, row0 = u.pm * 256 + wr * 64 + fr, cl = wc * 32 + 8 * fq;
        int mode, ld, ct, ssld = 0; bf16* base = nullptr; float* ss = nullptr; bool xonly = true;
        if (pn < 4) { mode = 1; base = (bf16*)(ws + WS_GQ); ld = 1024; ct = pn; }
        else if (pn < 8) { mode = 0; base = (bf16*)(ws + WS_GK); ld = 1024; ct = pn - 4; xonly = false; }
        else if (pn < 16) { mode = 0; base = (bf16*)(ws + WS_GV); ld = 2048; ct = pn - 8; xonly = false; }
        else if (pn < 24) { mode = 2; base = (bf16*)(ws + WS_GOG); ld = 2048; ct = pn - 16; }
        else if (pn < 28) { mode = 4; base = (bf16*)(ws + WS_CQ); ld = 1024; ct = pn - 24; ss = (float*)(ws + ST_CQSS); ssld = 16; }
        else if (pn < 30) { mode = 4; base = (bf16*)(ws + WS_CKV); ld = 512; ct = pn - 28; ss = (float*)(ws + ST_CKVSS); ssld = 8; xonly = false; }
        else if (pn < 46) { mode = 3; base = (bf16*)(ws + WS_GA); ld = 4096; ct = pn - 30; }
        else if (pn < 62) { mode = 3; base = (bf16*)(ws + WS_GB); ld = 4096; ct = pn - 46; }
        else { mode = 5; ld = 96; ct = 0; xonly = false; }
        if (xonly && u.pm >= 32) return;
        if (mode == 3) body<3>(acc, base, ld, ct, ss, ssld, row0, cl, wc, fq);
        else if (mode == 2) body<2>(acc, base, ld, ct, ss, ssld, row0, cl, wc, fq);
        else if (mode == 0) body<0>(acc, base, ld, ct, ss, ssld, row0, cl, wc, fq);
        else if (mode == 1) body<1>(acc, base, ld, ct, ss, ssld, row0, cl, wc, fq);
        else if (mode == 4) body<4>(acc, base, ld, ct, ss, ssld, row0, cl, wc, fq);
        else body<5>(acc, base, ld, ct, ss, ssld, row0, cl, wc, fq);
    }
};
struct EpiQ {
    static constexpr bool PERM = true, AFTER_DRAIN = false, PAIRED = false;
    unsigned char* ws;
    template <bool R0, bool R1> __device__ __forceinline__ void body(const f32x4 (&acc)[2][2][4][2], int row0, int g0, int g1, int fq) const {
        const float* SS = (const float*)(ws + ST_CQSS); const float* COS = (const float*)(ws + ST_COS); const float* SIN = (const float*)(ws + ST_SIN); bf16* QM = (bf16*)(ws + WS_QM);
        const int f0 = (R0 || R1) ? 16 * ((R0 ? g0 : g1) % 6 - 4) + 4 * fq : 4 * fq;
        const int head0 = g0 / 6, gi0 = g0 - 6 * head0, head1 = g1 / 6, gi1 = g1 - 6 * head1;
#pragma unroll
        for (int ai = 0; ai < 2; ++ai) {
            f32x4 ssv[4], cv[4], sv[4];
#pragma unroll
            for (int m = 0; m < 4; ++m) { const int row = row0 + ai * 128 + m * 16; ssv[m] = *(const GAS f32x4*)(SS + (size_t)row * 16 + 4 * fq);
                if (R0 || R1) { cv[m] = *(const GAS f32x4*)(COS + (size_t)(row + NMETA) * 32 + f0); sv[m] = *(const GAS f32x4*)(SIN + (size_t)(row + NMETA) * 32 + f0); } }
            SBAR();
#pragma unroll
            for (int m = 0; m < 4; ++m) {
                const int row = row0 + ai * 128 + m * 16;
                float s = (ssv[m][0] + ssv[m][1]) + (ssv[m][2] + ssv[m][3]);
                s += __shfl_xor(s, 16); s += __shfl_xor(s, 32);
                const float rs = MLA_QSCALE / sqrtf(s * (1.f / QRANK) + EPS);
#pragma unroll
                for (int bj = 0; bj < 2; ++bj) {
                    f32x4 v0 = acc[ai][bj][m][0], v1 = acc[ai][bj][m][1];
                    if ((bj == 0 && R0) || (bj == 1 && R1)) { const f32x4 o1 = v0 * cv[m] - v1 * sv[m], o2 = v0 * sv[m] + v1 * cv[m]; v0 = o1; v1 = o2; }
                    st_bf8(QM + (size_t)row * 3072 + (bj ? head1 : head0) * 192 + (bj ? gi1 : gi0) * 32 + 8 * fq, v0 * rs, v1 * rs);
                }
            }
        }
    }
    __device__ __forceinline__ void operator()(const f32x4 (&acc)[2][2][4][2], const pg8::Unit& u, int wr, int wc, int fr, int fq) const {
        const int row0 = u.pm * 256 + wr * 64 + fr;
        const int g0 = 8 * u.pn + wc, g1 = g0 + 4;
        const bool rope0 = (g0 % 6) >= 4, rope1 = (g1 % 6) >= 4;
        if (rope0) body<true, false>(acc, row0, g0, g1, fq); else if (rope1) body<false, true>(acc, row0, g0, g1, fq); else body<false, false>(acc, row0, g0, g1, fq);
    }
};
struct EpiKV {
    static constexpr bool PERM = true, AFTER_DRAIN = false, PAIRED = false;
    unsigned char* ws;
    __device__ __forceinline__ void operator()(const f32x4 (&acc)[2][2][4][2], const pg8::Unit& u, int wr, int wc, int fr, int fq) const {
        const float* SS = (const float*)(ws + ST_CKVSS); bf16* KF = (bf16*)(ws + WS_KF); bf16* VB = (bf16*)(ws + WS_VB);
        const int row0 = u.pm * 256 + wr * 64 + fr, cl = wc * 32 + 8 * fq;
        f32x4 t0[2][4], t1[2][4];
        EPI_ROWS(ai, m) { const int row = row0 + ai * 128 + m * 16; t0[ai][m] = *(const GAS f32x4*)(SS + (size_t)row * 8); t1[ai][m] = *(const GAS f32x4*)(SS + (size_t)row * 8 + 4); }
        EPI_ROWS(ai, m) {
            const int row = row0 + ai * 128 + m * 16;
            const float s = ((t0[ai][m][0] + t0[ai][m][1]) + (t0[ai][m][2] + t0[ai][m][3])) + ((t1[ai][m][0] + t1[ai][m][1]) + (t1[ai][m][2] + t1[ai][m][3]));
            const float rs = 1.f / sqrtf(s * (1.f / KVRANK) + EPS);
            st_bf8(KF + (size_t)row * 3072 + u.pn * 192 + cl, acc[ai][0][m][0] * rs, acc[ai][0][m][1] * rs);
            st_bf8(VB + (size_t)row * 2048 + u.pn * 128 + cl, acc[ai][1][m][0] * rs, acc[ai][1][m][1] * rs);
        }
    }
};
struct EpiGla {
    static constexpr bool PERM = true, AFTER_DRAIN = false, PAIRED = false;
    unsigned char* ws;
    __device__ __forceinline__ void operator()(const f32x4 (&acc)[2][2][4][2], const pg8::Unit& u, int wr, int wc, int fr, int fq) const {
        const bf16* GA = (const bf16*)(ws + WS_GA); bf16* MG = (bf16*)(ws + WS_MERGED);
        const int row0 = u.pm * 256 + wr * 64 + fr, col0 = u.pn * 256 + wc * 32 + 8 * fq;
        u32x4 gv[2][4][2];
        EPI_ROWS(ai, m) { const size_t ro = (size_t)(row0 + ai * 128 + m * 16) * DM + col0; gv[ai][m][0] = *(const GAS u32x4*)(GA + ro); gv[ai][m][1] = *(const GAS u32x4*)(GA + ro + 128); }
        EPI_ROWS(ai, m) {
            const size_t ro = (size_t)(row0 + ai * 128 + m * 16) * DM + col0;
#pragma unroll
            for (int bj = 0; bj < 2; ++bj) { const u32x4 w = gv[ai][m][bj];
                const f32x4 g0 = (f32x4){bflo(w.x), bfhi(w.x), bflo(w.y), bfhi(w.y)}, g1 = (f32x4){bflo(w.z), bfhi(w.z), bflo(w.w), bfhi(w.w)};
                st_bf8(MG + ro + bj * 128, acc[ai][bj][m][0] * g0, acc[ai][bj][m][1] * g1); }
        }
    }
};
struct EpiMla {
    static constexpr bool PERM = true, AFTER_DRAIN = false, PAIRED = false;
    unsigned char* ws;
    __device__ __forceinline__ void operator()(const f32x4 (&acc)[2][2][4][2], const pg8::Unit& u, int wr, int wc, int fr, int fq) const {
        const bf16* GB = (const bf16*)(ws + WS_GB); bf16* MG = (bf16*)(ws + WS_MERGED);
        const int row0 = u.pm * 256 + wr * 64 + fr, col0 = u.pn * 256 + wc * 32 + 8 * fq;
#pragma unroll
        for (int ai = 0; ai < 2; ++ai) {
            u32x4 gv[4][2], pv[4][2];
#pragma unroll
            for (int m = 0; m < 4; ++m) { const size_t ro = (size_t)(row0 + ai * 128 + m * 16) * DM + col0;
                gv[m][0] = *(const GAS u32x4*)(GB + ro); gv[m][1] = *(const GAS u32x4*)(GB + ro + 128); pv[m][0] = *(const GAS u32x4*)(MG + ro); pv[m][1] = *(const GAS u32x4*)(MG + ro + 128); }
#pragma unroll
            for (int m = 0; m < 4; ++m) { const size_t ro = (size_t)(row0 + ai * 128 + m * 16) * DM + col0;
#pragma unroll
                for (int bj = 0; bj < 2; ++bj) { const u32x4 w = gv[m][bj], q = pv[m][bj];
                    const f32x4 g0 = (f32x4){bflo(w.x), bfhi(w.x), bflo(w.y), bfhi(w.y)}, g1 = (f32x4){bflo(w.z), bfhi(w.z), bflo(w.w), bfhi(w.w)};
                    const f32x4 p0 = (f32x4){bflo(q.x), bfhi(q.x), bflo(q.y), bfhi(q.y)}, p1 = (f32x4){bflo(q.z), bfhi(q.z), bflo(q.w), bfhi(q.w)};
                    st_bf8(MG + ro + bj * 128, p0 + acc[ai][bj][m][0] * g0, p1 + acc[ai][bj][m][1] * g1); } }
        }
    }
};
struct EpiWo {
    static constexpr bool PERM = true, AFTER_DRAIN = false, PAIRED = false;
    unsigned char* ws; const float* x; float* out;
    __device__ __forceinline__ void operator()(const f32x4 (&acc)[2][2][4][2], const pg8::Unit& u, int wr, int wc, int fr, int fq) const {
        bf16* H1B = (bf16*)(ws + WS_H1B); float* SS = (float*)(ws + ST_H1SS); const bf16* XB = (const bf16*)(ws + WS_H0B);
        const int row0 = u.pm * 256 + wr * 64 + fr, col0 = u.pn * 256 + wc * 32 + 8 * fq;
        u32x4 xv[2][4][2];
        EPI_ROWS(ai, m) { const size_t ro = (size_t)(row0 + ai * 128 + m * 16) * DM + col0; xv[ai][m][0] = *(const GAS u32x4*)(XB + ro); xv[ai][m][1] = *(const GAS u32x4*)(XB + ro + 128); }
        EPI_ROWS(ai, m) { const int row = row0 + ai * 128 + m * 16; const size_t ro = (size_t)row * DM + col0; float ssum = 0.f;
#pragma unroll
            for (int bj = 0; bj < 2; ++bj) { const u32x4 w = xv[ai][m][bj];
                const f32x4 x0 = (f32x4){bflo(w.x), bfhi(w.x), bflo(w.y), bfhi(w.y)}, x1 = (f32x4){bflo(w.z), bfhi(w.z), bflo(w.w), bfhi(w.w)};
                const f32x4 v0 = x0 + acc[ai][bj][m][0], v1 = x1 + acc[ai][bj][m][1];
                st_bf8(H1B + ro + bj * 128, v0, v1); ssum += dot4(v0) + dot4(v1);
            }
            ssum += __shfl_xor(ssum, 16); ssum += __shfl_xor(ssum, 32); if (fq == 0) SS[(size_t)row * 64 + u.pn * 4 + wc] = ssum; }
    }
};
constexpr int LDS_RSTAB = 131072;
struct EpiFF1 {
    static constexpr bool PERM = true, AFTER_DRAIN = false, PAIRED = false;
    unsigned char* ws; LAS unsigned char* lds; int pm0;
    __device__ __forceinline__ void operator()(const f32x4 (&acc)[2][2][4][2], const pg8::Unit& u, int wr, int wc, int fr, int fq) const {
        const float* SS = (const float*)(ws + ST_H1SS); bf16* U = (bf16*)(ws + WS_U);
        const int row0 = u.pm * 256 + wr * 64 + fr, col0 = u.pn * 256 + wc * 32 + 8 * fq;
        float rsv[2][4];
        if (u.pm == pm0) { const LAS float* T = (const LAS float*)(lds + LDS_RSTAB) + wr * 64 + fr; EPI_ROWS(ai, m) rsv[ai][m] = T[ai * 128 + m * 16]; }
        else {
            EPI_ROWS(ai, m) { const float* p = SS + (size_t)(row0 + ai * 128 + m * 16) * 64 + 16 * fq;
                const f32x4 a = *(const GAS f32x4*)p, b = *(const GAS f32x4*)(p + 4), c = *(const GAS f32x4*)(p + 8), d = *(const GAS f32x4*)(p + 12);
                float s = (((a[0] + a[1]) + (a[2] + a[3])) + ((b[0] + b[1]) + (b[2] + b[3]))) + (((c[0] + c[1]) + (c[2] + c[3])) + ((d[0] + d[1]) + (d[2] + d[3])));
                s += __shfl_xor(s, 16); s += __shfl_xor(s, 32); rsv[ai][m] = 1.f / sqrtf(s * (1.f / DM) + EPS); }
        }
        EPI_ROWS(ai, m) {
            const int row = row0 + ai * 128 + m * 16; const float rs = rsv[ai][m];
#pragma unroll
            for (int bj = 0; bj < 2; ++bj) { f32x4 v0 = acc[ai][bj][m][0] * rs, v1 = acc[ai][bj][m][1] * rs;
#pragma unroll
                for (int j = 0; j < 4; ++j) { const float a = fmaxf(v0[j], 0.f), b = fmaxf(v1[j], 0.f); v0[j] = a * a; v1[j] = b * b; }
                st_bf8(U + (size_t)row * LDU + col0 + bj * 128, v0, v1); }
        }
    }
};
__device__ __forceinline__ void ff1_rs_table(const unsigned char* ws, LAS unsigned char* lds, int pm0, int tid) {
    const float* SS = (const float*)(ws + ST_H1SS) + (size_t)(pm0 * 256 + (tid >> 1)) * 64 + 32 * (tid & 1);
    float s = 0.f;
#pragma unroll
    for (int q = 0; q < 8; ++q) { const f32x4 a = *(const GAS f32x4*)(SS + 4 * q); s += (a[0] + a[1]) + (a[2] + a[3]); }
    s += __shfl_xor(s, 1);
    if ((tid & 1) == 0) ((LAS float*)(lds + LDS_RSTAB))[tid >> 1] = 1.f / sqrtf(s * (1.f / DM) + EPS);
    __syncthreads();
}
struct EpiFF2 {
    static constexpr bool PERM = true, AFTER_DRAIN = false, PAIRED = false;
    unsigned char* ws; float* out;
    __device__ __forceinline__ void operator()(const f32x4 (&acc)[2][2][4][2], const pg8::Unit& u, int wr, int wc, int fr, int fq) const {
        float* SS = (float*)(ws + ST_H2SS); const bf16* H1B = (const bf16*)(ws + WS_H1B);
        const int row0 = u.pm * 256 + wr * 64 + fr, col0 = u.pn * 256 + wc * 32 + 8 * fq;
        u32x4 hv[2][4][2];
        EPI_ROWS(ai, m) { const size_t ro = (size_t)(row0 + ai * 128 + m * 16) * DM + col0; hv[ai][m][0] = *(const GAS u32x4*)(H1B + ro); hv[ai][m][1] = *(const GAS u32x4*)(H1B + ro + 128); }
        EPI_ROWS(ai, m) {
            const int row = row0 + ai * 128 + m * 16; const size_t ro = (size_t)row * DM + col0; float ssum = 0.f;
#pragma unroll
            for (int bj = 0; bj < 2; ++bj) { const u32x4 w = hv[ai][m][bj];
                const f32x4 h0 = (f32x4){bflo(w.x), bfhi(w.x), bflo(w.y), bfhi(w.y)}, h1 = (f32x4){bflo(w.z), bfhi(w.z), bflo(w.w), bfhi(w.w)};
                const f32x4 v0 = h0 + acc[ai][bj][m][0], v1 = h1 + acc[ai][bj][m][1];
                st_bf8((bf16*)(ws + WS_H1B) + ro + bj * 128, v0, v1); ssum += dot4(v0) + dot4(v1);
            }
            ssum += __shfl_xor(ssum, 16); ssum += __shfl_xor(ssum, 32); if (fq == 0) SS[(size_t)row * 64 + u.pn * 4 + wc] = ssum;
        }
    }
};
struct EpiNull {
    static constexpr bool PERM = true, AFTER_DRAIN = false, PAIRED = false;
    unsigned char* ws;
    __device__ __forceinline__ void operator()(const f32x4 (&acc)[2][2][4][2], const pg8::Unit& u, int wr, int wc, int fr, int fq) const {
        float s = 0.f;
        EPI_ROWS(ai, m) {
#pragma unroll
            for (int bj = 0; bj < 2; ++bj) s += dot4(acc[ai][bj][m][0]) + dot4(acc[ai][bj][m][1]); }
        if (s == 1234567.125f) ((float*)(ws + ST_H2SS))[0] = s;
    }
};

struct PairOrder {
    pg8::StaticOrder so;
    __device__ void init(int M, int N, int G_, int c_) { so.init(M, N, G_, c_); }
    __device__ __forceinline__ bool next(int i, pg8::Unit& u) const { const bool ok = so.next(i >> 1, u); u.sel = i & 1; return ok; }
    __device__ __forceinline__ void a_ready(const pg8::Unit&) const {}
    __device__ __forceinline__ void done(const pg8::Unit&) const {}
};
struct EpiMerged {
    static constexpr bool PERM = true, AFTER_DRAIN = false, PAIRED = true;
    unsigned char* ws;
    static __device__ __forceinline__ void unpack(const u32x4 w, f32x4& a, f32x4& b) { a = (f32x4){bflo(w.x), bfhi(w.x), bflo(w.y), bfhi(w.y)}; b = (f32x4){bflo(w.z), bfhi(w.z), bflo(w.w), bfhi(w.w)}; }
    __device__ __forceinline__ void mid(f32x4 (&acc)[2][2][4][2], const pg8::Unit& u, int wr, int wc, int fr, int fq) const {
        const bf16* GA = (const bf16*)(ws + WS_GA); const bf16* GB = (const bf16*)(ws + WS_GB);
        const int row0 = u.pm * 256 + wr * 64 + fr, col0 = u.pn * 256 + wc * 32 + 8 * fq;
#pragma unroll
        for (int ai = 0; ai < 2; ++ai) {
            u32x4 av[4][2], bv[4][2];
#pragma unroll
            for (int m = 0; m < 4; ++m) { const size_t ro = (size_t)(row0 + ai * 128 + m * 16) * DM + col0;
                av[m][0] = *(const GAS u32x4*)(GA + ro); av[m][1] = *(const GAS u32x4*)(GA + ro + 128); bv[m][0] = *(const GAS u32x4*)(GB + ro); bv[m][1] = *(const GAS u32x4*)(GB + ro + 128); }
#pragma unroll
            for (int m = 0; m < 4; ++m)
#pragma unroll
                for (int bj = 0; bj < 2; ++bj) { f32x4 a0, a1, b0, b1; unpack(av[m][bj], a0, a1); unpack(bv[m][bj], b0, b1);
#pragma unroll
                    for (int j = 0; j < 4; ++j) { acc[ai][bj][m][0][j] *= a0[j] * __builtin_amdgcn_rcpf(fmaxf(b0[j], 1e-6f)); acc[ai][bj][m][1][j] *= a1[j] * __builtin_amdgcn_rcpf(fmaxf(b1[j], 1e-6f)); } }
        }
    }
    __device__ __forceinline__ void operator()(const f32x4 (&acc)[2][2][4][2], const pg8::Unit& u, int wr, int wc, int fr, int fq) const {
        const bf16* GB = (const bf16*)(ws + WS_GB); bf16* MG = (bf16*)(ws + WS_MERGED);
        const int row0 = u.pm * 256 + wr * 64 + fr, col0 = u.pn * 256 + wc * 32 + 8 * fq;
        u32x4 bv[2][4][2];
        EPI_ROWS(ai, m) { const size_t ro = (size_t)(row0 + ai * 128 + m * 16) * DM + col0; bv[ai][m][0] = *(const GAS u32x4*)(GB + ro); bv[ai][m][1] = *(const GAS u32x4*)(GB + ro + 128); }
        EPI_ROWS(ai, m) { const size_t ro = (size_t)(row0 + ai * 128 + m * 16) * DM + col0;
#pragma unroll
            for (int bj = 0; bj < 2; ++bj) { f32x4 b0, b1; unpack(bv[ai][m][bj], b0, b1);
#pragma unroll
                for (int j = 0; j < 4; ++j) { b0[j] = fmaxf(b0[j], 1e-6f); b1[j] = fmaxf(b1[j], 1e-6f); }
                st_bf8(MG + ro + bj * 128, acc[ai][bj][m][0] * b0, acc[ai][bj][m][1] * b1); } }
    }
};
__device__ __forceinline__ int gla_row(int c, int t) { return c == 0 ? (t < 48 ? -1 : SEQ + (t - 48)) : 64 * (c - 1) + t; }

struct GateW { float Wf[16], Wb[16], biasf, biasb; };
__device__ __forceinline__ void gate_lg(const GateW& w, const LAS float* GL, int t, bool valid, float& lgf, float& lgb) {
    float zf = w.biasf, zb = w.biasb;
#pragma unroll
    for (int q = 0; q < 4; ++q) { const f32x4 gf = *(const LAS f32x4*)(GL + t * 32 + 4 * q), gb = *(const LAS f32x4*)(GL + t * 32 + 16 + 4 * q);
#pragma unroll
        for (int j = 0; j < 4; ++j) { zf = fmaf(gf[j], w.Wf[4 * q + j], zf); zb = fmaf(gb[j], w.Wb[4 * q + j], zb); } }
    lgf = valid ? logsig16(zf) : 0.f; lgb = valid ? logsig16(zb) : 0.f;
}
struct GateTot { float offF, F63, sumB, offR, R0; };
__device__ __forceinline__ void gates_begin(GateW& w, GateTot& T, const unsigned char* ws, const float* wf, const float* bfv, const float* wb, const float* bbv, int c, int h, LAS unsigned char* lds, int tid) {
    const float* SMALL = (const float*)(ws + ST_SMALL);
    LAS float* GL = (LAS float*)lds; LAS float* TOT = (LAS float*)(lds + 8192);
    { const int t = tid >> 3, part = tid & 7, row = gla_row(c, t);
      f32x4 v = (f32x4){0.f, 0.f, 0.f, 0.f}; if (row >= 0) v = *(const GAS f32x4*)(SMALL + (size_t)row * 96 + 64 + 4 * part);
      *(LAS f32x4*)(GL + t * 32 + 4 * part) = v; }
    const int d = tid & 127, tq = tid >> 7, col = h * 128 + d;
#pragma unroll
    for (int r = 0; r < 16; ++r) { w.Wf[r] = wf[r * 1024 + col]; w.Wb[r] = wb[r * 1024 + col]; }
    w.biasf = bfv[col]; w.biasb = bbv[col];
    __syncthreads();
    float sF = 0.f, sB = 0.f;
#pragma unroll 2
    for (int i = 0; i < 16; ++i) { const int t = 16 * tq + i; float lf, lb; gate_lg(w, GL, t, gla_row(c, t) >= 0, lf, lb); sF += lf; sB += lb; }
    TOT[tq * 128 + d] = sF; TOT[512 + tq * 128 + d] = sB;
    __syncthreads();
    float offF = 0.f, offR = 0.f, totF = 0.f, totR = 0.f;
#pragma unroll
    for (int q = 0; q < 4; ++q) { const float a = TOT[q * 128 + d], b = TOT[512 + q * 128 + d]; totF += a; totR += b; if (q < tq) offF += a; if (q > tq) offR += b; }
    T.offF = offF; T.F63 = totF; T.sumB = sB; T.offR = offR; T.R0 = totR;
}
struct GlaW { const float *wf, *bf, *wb, *bb, *gnorm; };
__device__ __forceinline__ void stage_tile(LAS bf16* dst, const bf16* src, int ld, int col0, int c, int tid) {
#pragma unroll
    for (int k = 0; k < 2; ++k) { const int idx = tid + 512 * k, t = idx >> 4, ch = idx & 15, row = gla_row(c, t);
        u32x4 v = (u32x4){0u, 0u, 0u, 0u}; if (row >= 0) v = *(const GAS u32x4*)(src + (size_t)row * ld + col0 + 8 * ch);
        *(LAS u32x4*)(dst + t * 128 + 8 * ch) = v; }
}
constexpr int PA_K = 16384, PA_KTF = 32768, PA_KTB = PA_KTF + 128 * 132, PA_LG = PA_KTB + 128 * 132, PA_VS = PA_LG, PA_VSS = 264;
static_assert(PA_LG + 2 * 64 * 128 * 4 <= LDS_CTL && PA_VS + 64 * PA_VSS * 2 <= LDS_CTL, "pass A LDS");
__device__ __forceinline__ void gla_pass_a(unsigned char* ws, const GlaW& gw, LAS unsigned char* lds, int tid, int G, int bid, float* LG) {
    const bf16* GK = (const bf16*)(ws + WS_GK); const bf16* GV = (const bf16*)(ws + WS_GV); const float* SMALL = (const float*)(ws + ST_SMALL);
    bf16* KHTF = (bf16*)(ws + WS_KHTF); bf16* KHTB = (bf16*)(ws + WS_KHTB); bf16* VT = (bf16*)(ws + WS_VT);
    float* DLF = (float*)(ws + ST_DLF); float* DLB = (float*)(ws + ST_DLB);
    LAS float* GL = (LAS float*)lds; LAS float* TOT = (LAS float*)(lds + 8192); LAS bf16* KS = (LAS bf16*)(lds + PA_K); LAS bf16* KTF = (LAS bf16*)(lds + PA_KTF); LAS bf16* KTB = (LAS bf16*)(lds + PA_KTB);
    LAS float* LGC = (LAS float*)(lds + PA_LG); LAS bf16* VS = (LAS bf16*)(lds + PA_VS);
    const int nmine = (NXC * GH - bid + G - 1) / G + ((bid >= 16 && bid < 16 + GH) ? 1 : 0);
    for (int k = 0; k < nmine; ++k) {
        const int u = bid + k * G; const bool meta = u >= NXC * GH;
        const int c = meta ? 0 : 1 + (u >> 3), h = meta ? bid - 16 : (u & 7);
        const int d = tid & 127, tq = tid >> 7, col = h * 128 + d;
        __syncthreads();
        u32x4 vreg[4];
#pragma unroll
        for (int q = 0; q < 4; ++q) { const int idx = tid + 512 * q, t = idx >> 5, ch = idx & 31, row = gla_row(c, t);
            vreg[q] = (u32x4){0u, 0u, 0u, 0u}; if (row >= 0) vreg[q] = *(const GAS u32x4*)(GV + (size_t)row * 2048 + h * 256 + 8 * ch); }
        stage_tile(KS, GK, 1024, h * 128, c, tid);
        { const int t = tid >> 3, part = tid & 7, row = gla_row(c, t);
          f32x4 v = (f32x4){0.f, 0.f, 0.f, 0.f}; if (row >= 0) v = *(const GAS f32x4*)(SMALL + (size_t)row * 96 + 64 + 4 * part);
          *(LAS f32x4*)(GL + t * 32 + 4 * part) = v; }
        GateW w;
#pragma unroll
        for (int r = 0; r < 16; ++r) { w.Wf[r] = gw.wf[r * 1024 + col]; w.Wb[r] = gw.wb[r * 1024 + col]; }
        w.biasf = gw.bf[col]; w.biasb = gw.bb[col];
        __syncthreads();
        float sF = 0.f, sB = 0.f;
#pragma unroll 2
        for (int i = 0; i < 16; ++i) { const int t = 16 * tq + i, row = gla_row(c, t); float lf, lb; gate_lg(w, GL, t, row >= 0, lf, lb); sF += lf; sB += lb;
            LGC[t * 128 + d] = lf; LGC[8192 + t * 128 + d] = lb;
            if (c >= 1) { LG[(size_t)row * 1024 + col] = lf; LG[(size_t)SEQ * 1024 + (size_t)row * 1024 + col] = lb; } }
        TOT[tq * 128 + d] = sF; TOT[512 + tq * 128 + d] = sB;
        __syncthreads();
        float offF = 0.f, offR = 0.f, F63 = 0.f, R0 = 0.f;
#pragma unroll
        for (int q = 0; q < 4; ++q) { const float a = TOT[q * 128 + d], b2 = TOT[512 + q * 128 + d]; F63 += a; R0 += b2; if (q < tq) offF += a; if (q > tq) offR += b2; }
        { float runF = offF, runB = 0.f;
#pragma unroll 4
          for (int i = 0; i < 16; ++i) { const int t = 16 * tq + i; const float lf = LGC[t * 128 + d], lb = LGC[8192 + t * 128 + d];
              runF += lf; const float R = offR + (sB - runB); runB += lb;
              const float kv = bf2f(KS[t * 128 + d]);
              KTF[d * 66 + t] = f2bf(kv * __expf(F63 - runF)); KTB[d * 66 + t] = f2bf(kv * __expf(R0 - R)); } }
        if (tq == 0) { DLF[(size_t)(c * GH + h) * 128 + d] = __expf(F63); if (c >= 1) DLB[(size_t)((c - 1) * GH + h) * 128 + d] = __expf(R0); }
        __syncthreads();
#pragma unroll
        for (int q = 0; q < 4; ++q) { const int idx = tid + 512 * q, t = idx >> 5, ch = idx & 31; *(LAS u32x4*)(VS + t * PA_VSS + 8 * ch) = vreg[q]; }
        { GAS unsigned* of = (GAS unsigned*)(KHTF + (size_t)(c * GH + h) * 128 * 64); GAS unsigned* ob = (GAS unsigned*)(KHTB + (size_t)((c > 0 ? c - 1 : 0) * GH + h) * 128 * 64);
#pragma unroll
          for (int q = 0; q < 8; ++q) { const int idx = tid + 512 * q, dd = idx >> 5, dw = idx & 31;
              of[idx] = *(const LAS unsigned*)(KTF + dd * 66 + 2 * dw); if (c >= 1) ob[idx] = *(const LAS unsigned*)(KTB + dd * 66 + 2 * dw); } }
        __syncthreads();
        { const int e = tid & 255, th = tid >> 8; unsigned pv[16];
#pragma unroll
          for (int i = 0; i < 32; i += 2) { const unsigned a = VS[(32 * th + i) * PA_VSS + e], b2 = VS[(32 * th + i + 1) * PA_VSS + e]; pv[i >> 1] = a | (b2 << 16); }
          GAS u32x4* o = (GAS u32x4*)(VT + ((size_t)(c * GH + h) * 256 + e) * 64 + 32 * th);
#pragma unroll
          for (int q = 0; q < 4; ++q) o[q] = (u32x4){pv[4 * q], pv[4 * q + 1], pv[4 * q + 2], pv[4 * q + 3]}; }
    }
}
__device__ __forceinline__ void gla_chain(unsigned char* ws, int bid, int G, int wave, int lane) {
    const bf16* KHTF = (const bf16*)(ws + WS_KHTF); const bf16* KHTB = (const bf16*)(ws + WS_KHTB); const bf16* VT = (const bf16*)(ws + WS_VT);
    const float* DLF = (const float*)(ws + ST_DLF); const float* DLB = (const float*)(ws + ST_DLB); bf16* SNAP = (bf16*)(ws + WS_SNAP);
    const int r32 = lane & 31, hi = lane >> 5;
    for (int wc = bid * 2 + wave; wc < 512; wc += G * 2) {
        const int dir = wc >> 8, h = (wc >> 5) & 7, e0 = 32 * ((wc >> 2) & 7), d0 = 32 * (wc & 3);
        f32x16 S = {};
        bf16* snap = SNAP + (size_t)dir * 128 * GH * 256 * 128 + ((size_t)h * 256 + e0 + r32) * 128 + d0 + 4 * hi;
        const bf16* khb = (dir == 0 ? KHTF : KHTB) + ((size_t)h * 128 + d0 + r32) * 64 + 8 * hi;
        const bf16* vtb = VT + ((size_t)h * 256 + e0 + r32) * 64 + 8 * hi;
        const float* dlb = (dir == 0 ? DLF : DLB) + (size_t)h * 128 + d0 + 4 * hi;
        constexpr int PD = 3;
        bf16x8 A[PD][4], B[PD][4]; f32x4 DV[PD][4];
#define CH_LOAD(slot, s_) do { const int kc_ = dir == 0 ? (s_) : 127 - (s_), vc_ = dir == 0 ? (s_) : 128 - (s_); \
            const bf16* kh_ = khb + (size_t)kc_ * (GH * 128 * 64); const bf16* vt_ = vtb + (size_t)vc_ * (GH * 256 * 64); const float* dl_ = dlb + (size_t)kc_ * (GH * 128); \
            _Pragma("unroll") for (int q_ = 0; q_ < 4; ++q_) { A[slot][q_] = *(const GAS bf16x8*)(kh_ + 16 * q_); B[slot][q_] = *(const GAS bf16x8*)(vt_ + 16 * q_); DV[slot][q_] = *(const GAS f32x4*)(dl_ + 8 * q_); } } while (0)
#define CH_STORE(xc_) do { bf16* sp_ = snap + (size_t)(xc_) * (GH * 256 * 128); \
            _Pragma("unroll") for (int g_ = 0; g_ < 4; ++g_) *(GAS u32x2*)(sp_ + 8 * g_) = (u32x2){cvtpk(S[4 * g_], S[4 * g_ + 1]), cvtpk(S[4 * g_ + 2], S[4 * g_ + 3])}; } while (0)
#pragma unroll
        for (int p = 0; p < PD; ++p) CH_LOAD(p, p);
        if (dir == 1) CH_STORE(127);
        for (int sb = 0; sb < 129; sb += PD) {
#pragma unroll
            for (int p = 0; p < PD; ++p) {
                const int s = sb + p;
                if (s < 128) {
#pragma unroll
                    for (int g = 0; g < 4; ++g) { S[4 * g] *= DV[p][g][0]; S[4 * g + 1] *= DV[p][g][1]; S[4 * g + 2] *= DV[p][g][2]; S[4 * g + 3] *= DV[p][g][3]; }
#pragma unroll
                    for (int q = 0; q < 4; ++q) S = __builtin_amdgcn_mfma_f32_32x32x16_bf16(A[p][q], B[p][q], S, 0, 0, 0);
                    if (s + PD < 128) CH_LOAD(p, s + PD);
                    if (dir == 0) CH_STORE(s); else if (s < 127) CH_STORE(126 - s);
                }
            }
        }
#undef CH_LOAD
#undef CH_STORE
    }
}
__device__ __forceinline__ int crow(int r, int hi) { return (r & 3) + 8 * (r >> 2) + 4 * hi; }
constexpr int PC_OPS = 16384, PC_OPB = 64 * 272, PC_ATT = PC_OPS + 6 * PC_OPB, PC_ATTB = 64 * 144, PC_END = PC_ATT + 2 * PC_ATTB;
constexpr int PC_STK = PC_ATT, PC_STQ = PC_STK + 16384;
constexpr int PC_OT = PC_OPS, PC_OTS = 260;
static_assert(PC_END <= LDS_CTL && PC_STQ + 16384 <= LDS_CTL && PC_OT + 64 * PC_OTS * 4 <= PC_ATT, "pass C LDS");
template <int PV> __device__ __forceinline__ void gla_pass_c(unsigned char* ws, const GlaW& gw, LAS unsigned char* lds, int tid, int G, int bid, bf16* AGout, const float* LG) {
    const bf16* GQ = (const bf16*)(ws + WS_GQ); const bf16* GK = (const bf16*)(ws + WS_GK); const bf16* GOG = (const bf16*)(ws + WS_GOG);
    const bf16* VT = (const bf16*)(ws + WS_VT); const bf16* SNAP = (const bf16*)(ws + WS_SNAP); bf16* AG = AGout;
    const int wave = __builtin_amdgcn_readfirstlane(tid >> 6), lane = tid & 63, r32 = lane & 31, hi = lane >> 5;
#define PC_OP(i) ((LAS bf16*)(lds + PC_OPS + (i) * PC_OPB))
#define PC_AT(i) ((LAS bf16*)(lds + PC_ATT + (i) * PC_ATTB))
    for (int u = bid; u < NXC * GH; u += G) {
        const int xc = u >> 3, h = u & 7, c = xc + 1, e0 = 32 * wave;
        __syncthreads();
        const int d = tid & 127, tq = tid >> 7;
        float lgf[16], lgb[16];
        { const float* lp = LG + (size_t)(64 * xc + 16 * tq) * 1024 + h * 128 + d;
#pragma unroll
          for (int i = 0; i < 16; ++i) { lgf[i] = lp[(size_t)i * 1024]; lgb[i] = lp[(size_t)SEQ * 1024 + (size_t)i * 1024]; } }
        stage_tile((LAS bf16*)(lds + PC_STK), GK, 1024, h * 128, c, tid); stage_tile((LAS bf16*)(lds + PC_STQ), GQ, 1024, h * 128, c, tid);
        LAS float* TOT = (LAS float*)(lds + 8192);
#pragma unroll
        for (int i = 1; i < 16; ++i) lgf[i] += lgf[i - 1];
#pragma unroll
        for (int i = 14; i >= 0; --i) lgb[i] += lgb[i + 1];
        TOT[tq * 128 + d] = lgf[15]; TOT[512 + tq * 128 + d] = lgb[0];
        __syncthreads();
        { float offF = 0.f, offR = 0.f, F63 = 0.f, R0 = 0.f;
#pragma unroll
          for (int q = 0; q < 4; ++q) { const float a = TOT[q * 128 + d], b2 = TOT[512 + q * 128 + d]; F63 += a; R0 += b2; if (q < tq) offF += a; if (q > tq) offR += b2; }
          const LAS bf16* KS = (const LAS bf16*)(lds + PC_STK); const LAS bf16* QS = (const LAS bf16*)(lds + PC_STQ);
          const float dF = __expf(F63), dR = __expf(R0);
#pragma unroll
          for (int i = 0; i < 16; ++i) { const int t = 16 * tq + i; const float F = lgf[i] + offF, R = lgb[i] + offR;
              const float q = bf2f(QS[t * 128 + d]), kv = bf2f(KS[t * 128 + d]);
              const float ef = __expf(F - F63), er = __expf(R - R0), qf = q * ef, qr2 = q * er;
              PC_OP(0)[t * 136 + d] = f2bf(qf); PC_OP(1)[t * 136 + d] = f2bf(kv * __builtin_amdgcn_rcpf(ef)); PC_OP(4)[t * 136 + d] = f2bf(qf * dF);
              PC_OP(2)[t * 136 + d] = f2bf(qr2); PC_OP(3)[t * 136 + d] = f2bf(kv * __builtin_amdgcn_rcpf(er)); PC_OP(5)[t * 136 + d] = f2bf(qr2 * dR); } }
        __syncthreads();
        bf16x8 sfr[2][8], vfr[4];
#pragma unroll
        for (int dir = 0; dir < 2; ++dir) { const bf16* sp = SNAP + (size_t)dir * 128 * GH * 256 * 128 + ((size_t)(xc * GH + h) * 256 + e0 + r32) * 128 + 8 * hi;
#pragma unroll
            for (int ks = 0; ks < 8; ++ks) sfr[dir][ks] = *(const GAS bf16x8*)(sp + 16 * ks); }
        { const bf16* vp = VT + ((size_t)(c * GH + h) * 256 + e0 + r32) * 64 + 8 * hi;
#pragma unroll
          for (int ks = 0; ks < 4; ++ks) vfr[ks] = *(const GAS bf16x8*)(vp + 16 * ks); }
        { const int dirw = wave >> 2, ti = (wave >> 1) & 1, sj = wave & 1;
          f32x16 a = {};
          const bool live = dirw == 0 ? sj <= ti : sj >= ti;
          if (live) {
              const LAS bf16* QH = PC_OP(2 * dirw) + (32 * ti + r32) * 136 + 8 * hi; const LAS bf16* KH = PC_OP(2 * dirw + 1) + (32 * sj + r32) * 136 + 8 * hi;
#pragma unroll
              for (int ks = 0; ks < 8; ++ks) a = __builtin_amdgcn_mfma_f32_32x32x16_bf16(*(const LAS bf16x8*)(QH + 16 * ks), *(const LAS bf16x8*)(KH + 16 * ks), a, 0, 0, 0);
          }
          LAS bf16* AT = PC_AT(dirw);
#pragma unroll
          for (int r = 0; r < 16; ++r) { const int t = 32 * ti + crow(r, hi), s2 = 32 * sj + r32; const bool keep = dirw == 0 ? s2 <= t : s2 >= t; AT[t * 72 + s2] = f2bf(keep ? a[r] : 0.f); } }
        __syncthreads();
        f32x16 o0 = {}, o1 = {};
#pragma unroll
        for (int dir = 0; dir < 2; ++dir) {
            const LAS bf16* QT = PC_OP(4 + dir) + r32 * 136 + 8 * hi;
#pragma unroll
            for (int ks = 0; ks < 8; ++ks) {
                o0 = __builtin_amdgcn_mfma_f32_32x32x16_bf16(*(const LAS bf16x8*)(QT + 16 * ks), sfr[dir][ks], o0, 0, 0, 0);
                o1 = __builtin_amdgcn_mfma_f32_32x32x16_bf16(*(const LAS bf16x8*)(QT + 32 * 136 + 16 * ks), sfr[dir][ks], o1, 0, 0, 0); }
        }
#pragma unroll
        for (int dir = 0; dir < 2; ++dir) { const LAS bf16* AT = PC_AT(dir) + r32 * 72 + 8 * hi;
#pragma unroll
            for (int ks = 0; ks < 4; ++ks) {
                o0 = __builtin_amdgcn_mfma_f32_32x32x16_bf16(*(const LAS bf16x8*)(AT + 16 * ks), vfr[ks], o0, 0, 0, 0);
                o1 = __builtin_amdgcn_mfma_f32_32x32x16_bf16(*(const LAS bf16x8*)(AT + 32 * 72 + 16 * ks), vfr[ks], o1, 0, 0, 0); } }
        __syncthreads();
        { LAS float* OT = (LAS float*)(lds + PC_OT);
#pragma unroll
          for (int r = 0; r < 16; ++r) { OT[crow(r, hi) * PC_OTS + e0 + r32] = o0[r]; OT[(32 + crow(r, hi)) * PC_OTS + e0 + r32] = o1[r]; } }
        __syncthreads();
        { const int t = tid >> 3, j = tid & 7; const LAS float* OT = (const LAS float*)(lds + PC_OT) + t * PC_OTS + 8 * j;
          const size_t ro = (size_t)(64 * xc + t) * 2048 + h * 256 + 8 * j;
          f32x4 v[4][2]; u32x4 gg[4]; float ssq = 0.f;
#pragma unroll
          for (int i = 0; i < 4; ++i) { gg[i] = *(const GAS u32x4*)(GOG + ro + 64 * i); v[i][0] = *(const LAS f32x4*)(OT + 64 * i); v[i][1] = *(const LAS f32x4*)(OT + 64 * i + 4); ssq += dot4(v[i][0]) + dot4(v[i][1]); }
          ssq += __shfl_xor(ssq, 1); ssq += __shfl_xor(ssq, 2); ssq += __shfl_xor(ssq, 4);
          const float rn = 1.f / sqrtf(ssq * (1.f / GDV) + EPS);
#pragma unroll
          for (int i = 0; i < 4; ++i) { const f32x4 g0 = *(const GAS f32x4*)(gw.gnorm + 8 * j + 64 * i), g1 = *(const GAS f32x4*)(gw.gnorm + 8 * j + 64 * i + 4); const u32x4 q = gg[i];
              const f32x4 a0 = (f32x4){bflo(q.x), bfhi(q.x), bflo(q.y), bfhi(q.y)}, a1 = (f32x4){bflo(q.z), bfhi(q.z), bflo(q.w), bfhi(q.w)};
              st_bf8(AG + ro + 64 * i, v[i][0] * rn * g0 * a0, v[i][1] * rn * g1 * a1); } }
    }
#undef PC_OP
#undef PC_AT
}
namespace att {
constexpr int NW = 8, QBLK = 32, KVBLK = 64, NT = 129, LDQ = 3072, LDK = 3072, LDV = 2048, LDO = 2048;
constexpr float THR = 11.5f;
constexpr int SHM_V = KVBLK * 128 * 2, SHM_KN = KVBLK * 128 * 2, SHM_KR = KVBLK * 64 * 2;
constexpr int NBUF = 3, OFF_V = 0, OFF_KN = NBUF * SHM_V, OFF_KR = OFF_KN + NBUF * SHM_KN, OFF_WS = OFF_KR + NBUF * SHM_KR, SHM_ATTN = OFF_WS + NW * 64 * 4;
#define KSWZ(row, colB) ((row) * 256 + ((colB) ^ (((row) & 15) << 4)))
#define KRSWZ(row, chunk) ((row) * 128 + ((((chunk) ^ (((row) >> 1) & 7))) << 4))
constexpr float NEG = -1e30f;
__device__ __forceinline__ void partialSM(f32x16& p0, f32x16& p1, float& m_reg, float& mn, float& alpha) {
    float pmax = p0[0];
#pragma unroll
    for (int r = 1; r < 16; ++r) pmax = fmaxf(pmax, p0[r]);
#pragma unroll
    for (int r = 0; r < 16; ++r) pmax = fmaxf(pmax, p1[r]);
    { auto rr = __builtin_amdgcn_permlane32_swap(__float_as_uint(pmax), __float_as_uint(pmax), false, false);
      pmax = fmaxf(__uint_as_float(rr[0]), __uint_as_float(rr[1])); }
    { const bool keep = __all(pmax - m_reg <= THR);
      const float mx = fmaxf(m_reg, pmax); mn = keep ? m_reg : mx; alpha = keep ? 1.f : __builtin_amdgcn_exp2f(m_reg - mx); m_reg = mn; }
#pragma unroll
    for (int r = 0; r < 16; ++r) p0[r] = p0[r] - mn;
#pragma unroll
    for (int r = 0; r < 16; ++r) p1[r] = p1[r] - mn;
#pragma unroll
    for (int r = 0; r < 16; ++r) p0[r] = __builtin_amdgcn_exp2f(p0[r]);
}
__device__ __forceinline__ void finishSM(f32x16& p0, f32x16& p1, float alpha, float& l_reg, bf16x8& pa0, bf16x8& pa1, bf16x8& pa2, bf16x8& pa3) {
#pragma unroll
    for (int r = 0; r < 16; ++r) p1[r] = __builtin_amdgcn_exp2f(p1[r]);
    float ps = 0;
#pragma unroll
    for (int r = 0; r < 16; ++r) ps += p0[r];
#pragma unroll
    for (int r = 0; r < 16; ++r) ps += p1[r];
    { auto rr = __builtin_amdgcn_permlane32_swap(__float_as_uint(ps), __float_as_uint(ps), false, false);
      ps = __uint_as_float(rr[0]) + __uint_as_float(rr[1]); }
    l_reg = l_reg * alpha + ps;
#define PK4(P, BASE, OUT) do { u32x4 w = {cvtpk(P[BASE + 0], P[BASE + 1]), cvtpk(P[BASE + 2], P[BASE + 3]), cvtpk(P[BASE + 4], P[BASE + 5]), cvtpk(P[BASE + 6], P[BASE + 7])}; \
    OUT = *reinterpret_cast<bf16x8*>(&w); } while (0)
    PK4(p0, 0, pa0); PK4(p0, 8, pa1); PK4(p1, 0, pa2); PK4(p1, 8, pa3);
#undef PK4
}
__device__ __forceinline__ void qkt(f32x16& p0, f32x16& p1, const LAS char* Kn, const LAS char* Kr, const bf16x8* qr, int r32, int hi) {
    p0 = f32x16{}; p1 = f32x16{};
#pragma unroll
    for (int d0 = 0; d0 < 8; ++d0) { const int cb = (d0 * 16 + hi * 8) * 2;
        const bf16x8 b0 = *(const LAS bf16x8*)(Kn + KSWZ(r32, cb)), b1 = *(const LAS bf16x8*)(Kn + KSWZ(32 + r32, cb));
        p0 = __builtin_amdgcn_mfma_f32_32x32x16_bf16(b0, qr[d0], p0, 0, 0, 0);
        p1 = __builtin_amdgcn_mfma_f32_32x32x16_bf16(b1, qr[d0], p1, 0, 0, 0); }
#pragma unroll
    for (int d0 = 0; d0 < 4; ++d0) { const int ch = d0 * 2 + hi;
        const bf16x8 b0 = *(const LAS bf16x8*)(Kr + KRSWZ(r32, ch)), b1 = *(const LAS bf16x8*)(Kr + KRSWZ(32 + r32, ch));
        p0 = __builtin_amdgcn_mfma_f32_32x32x16_bf16(b0, qr[8 + d0], p0, 0, 0, 0);
        p1 = __builtin_amdgcn_mfma_f32_32x32x16_bf16(b1, qr[8 + d0], p1, 0, 0, 0); }
}
template <int MODE> __device__ __forceinline__ void maskp(f32x16& p0, f32x16& p1) {
    if (MODE == 1) {
#pragma unroll
        for (int r = 8; r < 16; ++r) p0[r] = NEG;
    } else {
#pragma unroll
        for (int r = 0; r < 16; ++r) p0[r] = NEG;
    }
#pragma unroll
    for (int r = 0; r < 16; ++r) p1[r] = NEG;
}
__device__ __forceinline__ int v_st(int k, int c) { const int kk = (k & ~0xC) | ((k & 4) << 1) | ((k & 8) >> 1); return ((kk >> 3) * 4 + (c >> 5)) * 512 + ((kk & 7) * 32 + (c & 31)) * 2; }
__device__ __forceinline__ int v_rd_base(int lane) { return ((lane & 3) << 3) | (((lane >> 2) & 3) << 6) | (((lane >> 4) & 1) << 5) | (((lane >> 5) & 1) << 8); }
constexpr int v_rd_off(int d0, int ks, int half) { return d0 * 512 + ks * 4096 + half * 2048; }
template <int OFF> __device__ __forceinline__ s16x4 tr_read(int vb) {
    return __builtin_amdgcn_ds_read_tr16_b64_v4i16((LAS s16x4*)(uintptr_t)(unsigned)(vb + OFF));
}
template <int D0> __device__ __forceinline__ void pv_one(f32x16& od, int vb, bf16x8 pa0, bf16x8 pa1, bf16x8 pa2, bf16x8 pa3) {
    const s16x4 l0 = tr_read<v_rd_off(D0, 0, 0)>(vb), h0 = tr_read<v_rd_off(D0, 0, 1)>(vb), l1 = tr_read<v_rd_off(D0, 1, 0)>(vb), h1 = tr_read<v_rd_off(D0, 1, 1)>(vb);
    const s16x4 l2 = tr_read<v_rd_off(D0, 2, 0)>(vb), h2 = tr_read<v_rd_off(D0, 2, 1)>(vb), l3 = tr_read<v_rd_off(D0, 3, 0)>(vb), h3 = tr_read<v_rd_off(D0, 3, 1)>(vb);
#define PK(L, H) (bf16x8){L[0], L[1], L[2], L[3], H[0], H[1], H[2], H[3]}
    od = __builtin_amdgcn_mfma_f32_32x32x16_bf16(pa0, PK(l0, h0), od, 0, 0, 0);
    od = __builtin_amdgcn_mfma_f32_32x32x16_bf16(pa1, PK(l1, h1), od, 0, 0, 0);
    od = __builtin_amdgcn_mfma_f32_32x32x16_bf16(pa2, PK(l2, h2), od, 0, 0, 0);
    od = __builtin_amdgcn_mfma_f32_32x32x16_bf16(pa3, PK(l3, h3), od, 0, 0, 0);
#undef PK
}
__device__ __forceinline__ void pv_d0(f32x16* o, int vb, bf16x8 pa0, bf16x8 pa1, bf16x8 pa2, bf16x8 pa3) {
    pv_one<0>(o[0], vb, pa0, pa1, pa2, pa3); pv_one<1>(o[1], vb, pa0, pa1, pa2, pa3); pv_one<2>(o[2], vb, pa0, pa1, pa2, pa3); pv_one<3>(o[3], vb, pa0, pa1, pa2, pa3);
}
#define PINV(x) asm volatile("" : "+v"(x))
struct KFrag { bf16x8 b0, b1; };
template <int P> __device__ __forceinline__ void kfrag(KFrag& f, const LAS char* Kn, const LAS char* Kr, int r32, int hi) {
    if (P < 8) { const int cb = (P * 16 + hi * 8) * 2; f.b0 = *(const LAS bf16x8*)(Kn + KSWZ(r32, cb)); f.b1 = *(const LAS bf16x8*)(Kn + KSWZ(32 + r32, cb)); }
    else { const int ch = (P - 8) * 2 + hi; f.b0 = *(const LAS bf16x8*)(Kr + KRSWZ(r32, ch)); f.b1 = *(const LAS bf16x8*)(Kr + KRSWZ(32 + r32, ch)); }
}
struct VFrag { s16x4 l0, h0, l1, h1, l2, h2, l3, h3; };
template <int D0> __device__ __forceinline__ void vfrag_lo(VFrag& f, int vb) { f.l0 = tr_read<v_rd_off(D0, 0, 0)>(vb); f.h0 = tr_read<v_rd_off(D0, 0, 1)>(vb); f.l1 = tr_read<v_rd_off(D0, 1, 0)>(vb); f.h1 = tr_read<v_rd_off(D0, 1, 1)>(vb); }
template <int D0> __device__ __forceinline__ void vfrag_hi(VFrag& f, int vb) { f.l2 = tr_read<v_rd_off(D0, 2, 0)>(vb); f.h2 = tr_read<v_rd_off(D0, 2, 1)>(vb); f.l3 = tr_read<v_rd_off(D0, 3, 0)>(vb); f.h3 = tr_read<v_rd_off(D0, 3, 1)>(vb); }
__device__ __forceinline__ void pv4(f32x16& od, const VFrag& f, bf16x8 pa0, bf16x8 pa1, bf16x8 pa2, bf16x8 pa3) {
#define PK(L, H) (bf16x8){L[0], L[1], L[2], L[3], H[0], H[1], H[2], H[3]}
    od = __builtin_amdgcn_mfma_f32_32x32x16_bf16(pa0, PK(f.l0, f.h0), od, 0, 0, 0);
    od = __builtin_amdgcn_mfma_f32_32x32x16_bf16(pa1, PK(f.l1, f.h1), od, 0, 0, 0);
    od = __builtin_amdgcn_mfma_f32_32x32x16_bf16(pa2, PK(f.l2, f.h2), od, 0, 0, 0);
    od = __builtin_amdgcn_mfma_f32_32x32x16_bf16(pa3, PK(f.l3, f.h3), od, 0, 0, 0);
#undef PK
}
__device__ __forceinline__ bf16x8 pk4(const f32x16& P, int base) {
    u32x4 w = {cvtpk(P[base + 0], P[base + 1]), cvtpk(P[base + 2], P[base + 3]), cvtpk(P[base + 4], P[base + 5]), cvtpk(P[base + 6], P[base + 7])};
    PINV(w); return *reinterpret_cast<bf16x8*>(&w);
}
template <int P> __device__ __forceinline__ void fill_a(f32x16& Y0, f32x16& Y1, float alY, float& ps, float& l_reg, bf16x8& pa0, bf16x8& pa1, bf16x8& pa2, bf16x8& pa3, VFrag& va, int vbY) {
    if constexpr (P == 0) { ps = Y0[0] + Y0[1];
#pragma unroll
        for (int r = 2; r < 8; ++r) ps += Y0[r];
        PINV(ps); pa0 = pk4(Y0, 0); }
    else if constexpr (P == 1) {
#pragma unroll
        for (int r = 8; r < 16; ++r) ps += Y0[r];
        PINV(ps); pa1 = pk4(Y0, 8); }
    else if constexpr (P < 10) { constexpr int i = 2 * (P - 2);
        float e0 = __builtin_amdgcn_exp2f(Y1[i]), e1 = __builtin_amdgcn_exp2f(Y1[i + 1]); PINV(e0); PINV(e1); Y1[i] = e0; Y1[i + 1] = e1;
        if constexpr (P > 2) { ps += Y1[i - 2]; ps += Y1[i - 1]; PINV(ps); }
        if constexpr (P == 6) pa2 = pk4(Y1, 0); }
    else if constexpr (P == 10) { ps += Y1[14]; ps += Y1[15]; pa3 = pk4(Y1, 8);
        auto rr = __builtin_amdgcn_permlane32_swap(__float_as_uint(ps), __float_as_uint(ps), false, false);
        l_reg = l_reg * alY + (__uint_as_float(rr[0]) + __uint_as_float(rr[1])); PINV(l_reg); vfrag_lo<0>(va, vbY); }
    else vfrag_hi<0>(va, vbY);
}
#ifndef DMA_IN_A
#define DMA_IN_A 0
#endif
__device__ __forceinline__ void dma16(const char* base, unsigned voff, LAS char* dst) {
    asm volatile("s_mov_b32 m0, %2\n\ts_nop 0\n\tglobal_load_lds_dwordx4 %0, %1" :: "v"(voff), "s"(base), "s"((unsigned)(uintptr_t)dst) : "memory", "m0");
}
struct DmaCtx { const char* kt; const char* vt; unsigned voKn0, voKn1, voKr, voV0, voV1; LAS char* lKn; LAS char* lKr; LAS char* lV; };
template <int I> __device__ __forceinline__ void dma_piece(const DmaCtx& c) {
    if (I == 0) dma16(c.kt, c.voKn0, c.lKn);
    if (I == 1) dma16(c.kt, c.voKn1, c.lKn + 1024);
    if (I == 2) dma16(c.kt, c.voKr, c.lKr);
    if (I == 3) dma16(c.vt, c.voV0, c.lV);
    if (I == 4) dma16(c.vt, c.voV1, c.lV + 1024);
}
template <int AV, bool DK, bool DV> __device__ __forceinline__ void phase_a(const DmaCtx& dc, const f32x16& negm, f32x16& X0, f32x16& X1, f32x16& Y0, f32x16& Y1, float alY, float& l_reg, bf16x8& pa0, bf16x8& pa1, bf16x8& pa2, bf16x8& pa3, VFrag& va,
                                        const LAS char* Kn, const LAS char* Kr, const bf16x8* qr, int vbY, int r32, int hi) {
    KFrag k; float ps = 0.f;
    kfrag<0>(k, Kn, Kr, r32, hi); if (AV != 2) fill_a<0>(Y0, Y1, alY, ps, l_reg, pa0, pa1, pa2, pa3, va, vbY); SBAR();
#define QKP(P) do { if (AV != 8) { X0 = __builtin_amdgcn_mfma_f32_32x32x16_bf16(k.b0, qr[P], P == 0 ? negm : X0, 0, 0, 0); X1 = __builtin_amdgcn_mfma_f32_32x32x16_bf16(k.b1, qr[P], P == 0 ? negm : X1, 0, 0, 0); } \
        else asm volatile("" :: "v"(k.b0), "v"(k.b1)); \
        if (AV != 5 && DMA_IN_A) { if (DK && P == 1) dma_piece<0>(dc); if (DK && P == 3) dma_piece<1>(dc); if (DK && P == 5) dma_piece<2>(dc); if (DV && P == 7) dma_piece<3>(dc); if (DV && P == 9) dma_piece<4>(dc); } \
        if (P < 11) { if (AV != 7) kfrag<(P < 11 ? P + 1 : 0)>(k, Kn, Kr, r32, hi); if (AV != 2 || P >= 9) fill_a<(P < 11 ? P + 1 : 1)>(Y0, Y1, alY, ps, l_reg, pa0, pa1, pa2, pa3, va, vbY); } SBAR(); } while (0)
    QKP(0); QKP(1); QKP(2); QKP(3); QKP(4); QKP(5); QKP(6); QKP(7); QKP(8); QKP(9); QKP(10); QKP(11);
#undef QKP
}
template <int S> __device__ __forceinline__ void fill_b(f32x16& X0) {
    constexpr int lo = S == 0 ? 0 : S == 1 ? 5 : 10, hi_ = S == 0 ? 5 : S == 1 ? 10 : 16;
#pragma unroll
    for (int r = lo; r < hi_; ++r) { float e = __builtin_amdgcn_exp2f(X0[r]); PINV(e); X0[r] = e; }
}
template <bool MASK, int AV> __device__ __forceinline__ void phase_b(f32x16* o, f32x16& negm, f32x16& X0, f32x16& X1, float& m_reg, float& alpha, bf16x8 pa0, bf16x8 pa1, bf16x8 pa2, bf16x8 pa3, VFrag& va, int vbY) {
#define PV4(D) do { if (AV != 8) pv4(o[D], va, pa0, pa1, pa2, pa3); else asm volatile("" :: "v"(va.l0), "v"(va.h0), "v"(va.l1), "v"(va.h1), "v"(va.l2), "v"(va.h2), "v"(va.l3), "v"(va.h3)); } while (0)
    PV4(0); if (AV != 7) { vfrag_lo<1>(va, vbY); vfrag_hi<1>(va, vbY); }
    bool keep = true;
    if (AV != 2) { if (MASK) maskp<1>(X0, X1);
      float m0 = X0[0], m1 = X1[0];
#pragma unroll
      for (int r = 1; r < 16; ++r) { m0 = fmaxf(m0, X0[r]); m1 = fmaxf(m1, X1[r]); }
      float pmax = fmaxf(m0, m1);
      { auto rr = __builtin_amdgcn_permlane32_swap(__float_as_uint(pmax), __float_as_uint(pmax), false, false); pmax = fmaxf(__uint_as_float(rr[0]), __uint_as_float(rr[1])); }
      PINV(pmax);
      keep = __all(pmax <= THR); alpha = 1.f;
      SBAR();
      if (__builtin_expect(!keep, 0)) {
          const float dlt = fmaxf(pmax, 0.f); alpha = __builtin_amdgcn_exp2f(-dlt); m_reg += dlt;
#pragma unroll
          for (int r = 0; r < 16; ++r) { X0[r] -= dlt; X1[r] -= dlt; negm[r] = -m_reg; } }
    }
    else { float t0 = X0[0], t1 = X1[0]; PINV(t0); PINV(t1); }
    SBAR();
    PV4(1); if (AV != 7) { vfrag_lo<2>(va, vbY); vfrag_hi<2>(va, vbY); } if (AV != 2) fill_b<0>(X0); SBAR();
    PV4(2); if (AV != 7) { vfrag_lo<3>(va, vbY); vfrag_hi<3>(va, vbY); } if (AV != 2) fill_b<1>(X0); SBAR();
    PV4(3); if (AV != 2) fill_b<2>(X0); SBAR();
#undef PV4
}
template <int AV> __device__ __forceinline__ void attn_body(const bf16* __restrict__ Qb, const bf16* __restrict__ Kh, const bf16* __restrict__ Vh, bf16* __restrict__ Ob, LAS char* lds) {
    int tid = threadIdx.x; asm volatile("" : "+v"(tid)); const int wid = __builtin_amdgcn_readfirstlane(tid >> 6), lane = tid & 63, r32 = lane & 31, hi = lane >> 5;
    LAS char* V_lds = lds + OFF_V; LAS char* Kn_lds = lds + OFF_KN; LAS char* Kr_lds = lds + OFF_KR;
    LAS float* wsf = (LAS float*)(lds + OFF_WS) + wid * 64; LAS float* li_l = wsf; LAS float* al_l = wsf + 32;
    float m_reg = -1e30f, l_reg = 0; f32x16 o[4] = {}; bf16x8 qr[12];
    const bf16* Qw = Qb + (long)(wid * QBLK + r32) * LDQ + hi * 8;
#pragma unroll
    for (int d0 = 0; d0 < 12; ++d0) qr[d0] = *(const GAS bf16x8*)(Qw + d0 * 16);
    unsigned voKn[2], voV[2], voKr;
#pragma unroll
    for (int i = 0; i < 2; ++i) { const int ch = 2 * wid + i;
        { const int row = 4 * ch + (lane >> 4), lc = (lane & 15) ^ (row & 15); voKn[i] = (unsigned)(row * LDK + lc * 8) * 2u; }
        { const int P = ch * 64 + lane, sub = P >> 5, k = (sub >> 2) * 8 + ((P >> 2) & 7), c = (sub & 3) * 32 + (P & 3) * 8; voV[i] = (unsigned)(k * LDV + c) * 2u; } }
    { const int row = 8 * wid + (lane >> 3), lc = (lane & 7) ^ ((row >> 1) & 7); voKr = (unsigned)(row * LDK + 128 + lc * 8) * 2u; }
    const int vb0 = (int)(uintptr_t)V_lds + v_rd_base(lane);
#define DMA_K(t, b) do { const char* kt_ = (const char*)Kh + (size_t)(t) * (KVBLK * LDK * 2); \
    dma16(kt_, voKn[0], Kn_lds + (b) * SHM_KN + (2 * wid) * 1024); dma16(kt_, voKn[1], Kn_lds + (b) * SHM_KN + (2 * wid + 1) * 1024); dma16(kt_, voKr, Kr_lds + (b) * SHM_KR + wid * 1024); } while (0)
#define DMA_V(t, b) do { const char* vt_ = (const char*)Vh + (size_t)(t) * (KVBLK * LDV * 2); \
    dma16(vt_, voV[0], V_lds + (b) * SHM_V + (2 * wid) * 1024); dma16(vt_, voV[1], V_lds + (b) * SHM_V + (2 * wid + 1) * 1024); } while (0)
#define RESC(a) do { if (__any((a) < 1.f)) { if (hi == 0) al_l[r32] = (a); asm volatile("s_waitcnt lgkmcnt(0)" ::: "memory"); \
    _Pragma("unroll") for (int d = 0; d < 4; ++d) _Pragma("unroll") for (int r = 0; r < 16; ++r) o[d][r] *= al_l[crow(r, hi)]; } } while (0)
#define WBAR(N) do { asm volatile("s_waitcnt vmcnt(" #N ") lgkmcnt(0)" ::: "memory"); __builtin_amdgcn_s_barrier(); asm volatile("" ::: "memory"); } while (0)
    f32x16 pA0, pA1, pB0, pB1; float mnA, mnB, alA, alB; bf16x8 pa0, pa1, pa2, pa3;
    DMA_K(0, 0); DMA_K(1, 1); DMA_V(0, 0);
    WBAR(0);
    DMA_K(2, 2); DMA_V(1, 1);
    qkt(pA0, pA1, Kn_lds, Kr_lds, qr, r32, hi); partialSM(pA0, pA1, m_reg, mnA, alA); RESC(alA);
    WBAR(5);
    f32x16 negm;
#pragma unroll
    for (int r = 0; r < 16; ++r) negm[r] = -m_reg;
    int bc = 1;
#define STEP(j, X0, X1, mnX, alX, Y0, Y1, alY, MASK, DK, DV) do { const int bp_ = bc == 0 ? 2 : bc - 1, bn_ = bc == 2 ? 0 : bc + 1; \
        const DmaCtx dc_{(const char*)Kh + (size_t)((j) + 2) * (KVBLK * LDK * 2), (const char*)Vh + (size_t)((j) + 1) * (KVBLK * LDV * 2), voKn[0], voKn[1], voKr, voV[0], voV[1], \
                         Kn_lds + bp_ * SHM_KN + (2 * wid) * 1024, Kr_lds + bp_ * SHM_KR + wid * 1024, V_lds + bn_ * SHM_V + (2 * wid) * 1024}; \
        phase_a<AV, DK, DV>(dc_, negm, X0, X1, Y0, Y1, alY, l_reg, pa0, pa1, pa2, pa3, vfa, Kn_lds + bc * SHM_KN, Kr_lds + bc * SHM_KR, qr, vb0 + bp_ * SHM_V, r32, hi); \
        phase_b<MASK, AV>(o, negm, X0, X1, m_reg, alX, pa0, pa1, pa2, pa3, vfa, vb0 + bp_ * SHM_V); \
        if (AV != 2) RESC(alX); \
        if (AV != 5 && !DMA_IN_A) { SBAR(); if (DK) { dma_piece<0>(dc_); dma_piece<1>(dc_); dma_piece<2>(dc_); } if (DV) { dma_piece<3>(dc_); dma_piece<4>(dc_); } } \
        if (DK && AV != 5) WBAR(5); else if (DV && AV != 5 && !DMA_IN_A) WBAR(2); else WBAR(0); \
        bc = bn_; } while (0)
    VFrag vfa;
    for (int j = 1; j + 3 < NT; j += 2) {
        STEP(j, pB0, pB1, mnB, alB, pA0, pA1, alA, false, true, true);
        STEP(j + 1, pA0, pA1, mnA, alA, pB0, pB1, alB, false, true, true);
    }
    STEP(NT - 2, pB0, pB1, mnB, alB, pA0, pA1, alA, false, false, true);
    STEP(NT - 1, pA0, pA1, mnA, alA, pB0, pB1, alB, true, false, false);
#undef STEP
    finishSM(pA0, pA1, alA, l_reg, pa0, pa1, pa2, pa3); SBAR();
    pv_d0(o, vb0 + ((NT - 1) % 3) * SHM_V, pa0, pa1, pa2, pa3);
    if (hi == 0) li_l[r32] = l_reg; LDS_WAIT();
    float rli[16];
#pragma unroll
    for (int r = 0; r < 16; ++r) rli[r] = __builtin_amdgcn_rcpf(li_l[crow(r, hi)]);
    bf16* Ow = Ob + (long)(wid * QBLK) * LDO;
    if (AV != 0) { float s = 0.f;
#pragma unroll
        for (int d0 = 0; d0 < 4; ++d0) _Pragma("unroll") for (int r = 0; r < 16; ++r) s += o[d0][r];
        if (s != 1234567.125f) return; }
#pragma unroll
    for (int r = 0; r < 16; ++r) { const int orow = crow(r, hi);
#pragma unroll
        for (int d0 = 0; d0 < 4; ++d0) Ow[(long)orow * LDO + d0 * 32 + r32] = f2bf(o[d0][r] * rli[r]); }
#undef DMA_K
#undef DMA_V
#undef WBAR
#undef RESC
}
__device__ __forceinline__ void attn_phase(unsigned char* ws, LAS unsigned char* lds, int G, int bid, bf16* exp_out, bf16* AO) {
    const bf16* QM = (const bf16*)(ws + WS_QM); const bf16* KF = (const bf16*)(ws + WS_KF); const bf16* VB = (const bf16*)(ws + WS_VB);
    for (int u = bid; u < MH * (SEQ / 256); u += G) {
        const int b = u & 255, r = u >> 8, h = 2 * (b & 7) + r, qb = b >> 3;
        __syncthreads();
        attn_body<0>(QM + (size_t)(256 * qb) * 3072 + h * 192, KF + h * 192, VB + h * 128, AO + (size_t)(256 * qb) * 2048 + h * 128, (LAS char*)lds);
    }
#if defined(EXP_ATT)
    for (int u = bid; u < MH * (SEQ / 256); u += G) {
        const int b = u & 255, r = u >> 8, h = 2 * (b & 7) + r, qb = b >> 3;
        __syncthreads();
        attn_body<EXP_ATT>(QM + (size_t)(256 * qb) * 3072 + h * 192, KF + h * 192, VB + h * 128, (EXP_ATT == 0 ? AO : exp_out) + (size_t)(256 * qb) * 2048 + h * 128, (LAS char*)lds);
    }
#endif
}
}
__device__ __forceinline__ void kpe_pass(unsigned char* ws, int gw, int NGW, int lane) {
    const float* SMALL = (const float*)(ws + ST_SMALL); const float* COS = (const float*)(ws + ST_COS); const float* SIN = (const float*)(ws + ST_SIN); bf16* KF = (bf16*)(ws + WS_KF);
    const int l = lane & 31, p = 2 * l, gp = p >> 5, fq = (p >> 3) & 3, nn = (p >> 2) & 1, j = p & 3, f = 16 * gp + 4 * fq + j;
    for (int row = 2 * gw + (lane >> 5); row < LP; row += 2 * NGW) {
        float v0 = 0.f, v1 = 0.f;
        if (row < LTOK) {
            const int pos = row < SEQ ? row + NMETA : row - SEQ;
            const float a0 = SMALL[(size_t)row * 96 + f], a1 = SMALL[(size_t)row * 96 + f + 1], b0 = SMALL[(size_t)row * 96 + 32 + f], b1 = SMALL[(size_t)row * 96 + 32 + f + 1];
            const float c0 = COS[pos * 32 + f], c1 = COS[pos * 32 + f + 1], s0 = SIN[pos * 32 + f], s1 = SIN[pos * 32 + f + 1];
            v0 = nn == 0 ? a0 * c0 - b0 * s0 : a0 * s0 + b0 * c0; v1 = nn == 0 ? a1 * c1 - b1 * s1 : a1 * s1 + b1 * c1;
        }
        const unsigned w = cvtpk(v0, v1);
#pragma unroll
        for (int h = 0; h < MH; ++h) *(GAS unsigned*)(KF + (size_t)row * 3072 + h * 192 + 128 + p) = w;
    }
}
__device__ __forceinline__ void final_norm(unsigned char* ws, float* out, const float* g, int gw, int NGW, int lane) {
    const float* SS = (const float*)(ws + ST_H2SS); const bf16* H2 = (const bf16*)(ws + WS_H1B);
    for (int row = gw; row < SEQ; row += NGW) {
        const float s = wave_sum(SS[(size_t)row * 64 + lane]);
        const float rs = 1.f / sqrtf(s * (1.f / DM) + EPS);
        const GAS u32x4* hp = (const GAS u32x4*)(H2 + (size_t)row * DM) + lane;
        GAS f32x4* o = (GAS f32x4*)(out + (size_t)row * DM) + 2 * lane; const GAS f32x4* gp = (const GAS f32x4*)g + 2 * lane;
        u32x4 w[8];
#pragma unroll
        for (int j = 0; j < 8; ++j) w[j] = hp[64 * j];
#pragma unroll
        for (int j = 0; j < 8; ++j) { const f32x4 a = (f32x4){bflo(w[j].x), bfhi(w[j].x), bflo(w[j].y), bfhi(w[j].y)}, b = (f32x4){bflo(w[j].z), bfhi(w[j].z), bflo(w[j].w), bfhi(w[j].w)};
            o[128 * j] = a * rs * gp[128 * j]; o[128 * j + 1] = b * rs * gp[128 * j + 1]; }
    }
}

#ifndef PG_SP2
#define PG_SP2 true
#endif
#ifndef PG_ALIGN
#define PG_ALIGN true
#endif
struct Args { const float* in[20]; float* out; unsigned char* ws; int ph_lo, ph_hi; };
constexpr int NPHASE = 10;
__global__ void __launch_bounds__(NTHR, 2) mega_fwd(Args args) {
    extern __shared__ __attribute__((aligned(16))) unsigned char lds_raw[];
    LAS unsigned char* lds = (LAS unsigned char*)lds_raw;
#define FRESH_IDS() int tid = threadIdx.x; asm volatile("" : "+v"(tid)); const int lane = tid & 63, wave = __builtin_amdgcn_readfirstlane(tid >> 6), gw = bid * NWAVES + wave; (void)lane; (void)gw
    const int G = gridDim.x, bid = blockIdx.x, NGW = G * NWAVES;
    unsigned char* ws = args.ws;
    volatile LAS unsigned* MISC = (volatile LAS unsigned*)(lds + LDS_CTL);
    if (threadIdx.x < 64) MISC[threadIdx.x] = 0u;
    __syncthreads();
    XcdBarrier bar = xcd_barrier_post((unsigned*)(ws + WS_CTL) + CW_BAR, MISC + 8);
    const int lo = args.ph_lo, hi = args.ph_hi;
#ifndef PH_MASK
#define PH_MASK 0x3ff
#endif
#define IN(k) ((((PH_MASK) >> (k)) & 1) && lo <= (k) && (k) < hi)
#define SEAM(k) do { if (IN(k) && IN((k) + 1)) xcd_barrier(bar); } while (0)
#ifndef DUP_PHASE
#define DUP_PHASE -1
#endif
#define REP(k) for (int rep_ = 0; rep_ < (DUP_PHASE == (k) ? 2 : 1); ++rep_, (DUP_PHASE == (k) && rep_ == 1 ? xcd_barrier(bar) : (void)0))
    GlaW glw{args.in[4], args.in[5], args.in[6], args.in[7], args.in[8]};
#if defined(DBG_TIME)
    volatile LAS unsigned long long* TS = (volatile LAS unsigned long long*)(lds + LDS_CTL + 64);
#define STAMP(k) do { if (bid == 0 && threadIdx.x == 0) TS[k] = __builtin_amdgcn_s_memrealtime(); } while (0)
#else
#define STAMP(k) do {} while (0)
#endif
    STAMP(0);

    REP(0) if (IN(0)) {
        P0Args a{args.in[0], args.in[1], args.in[2], args.in[3], args.in[9], args.in[10], args.in[11], args.in[12], args.in[13], args.in[14], args.in[15], args.in[16], args.in[17], args.in[18], ws};
        FRESH_IDS(); p0_prologue(a, lds, gw, NGW, wave, lane);
    }
    SEAM(0); STAMP(1);
    REP(1) if (IN(1)) {
        pg8::Gemm g{(const bf16*)(ws + WS_H0B), (const bf16*)(ws + WS_WINT), LP, NPROJ, DM}; ProjOrder S; S.init(G, bid); EpiProj E{ws};
#if defined(EXP_NULLEPI1)
        if (rep_ == 1) { EpiNull EN{ws}; pg8::gemm_phase<EpiNull, ProjOrder, PG_ALIGN, PG_SP2>(lds, g, S, EN); } else
#endif
        pg8::gemm_phase<EpiProj, ProjOrder, PG_ALIGN, PG_SP2>(lds, g, S, E);
    }
    SEAM(1); STAMP(2);
    REP(2) if (IN(2)) {
#ifndef NO_QUP
        { pg8::Gemm g{(const bf16*)(ws + WS_CQ), (const bf16*)(ws + WS_WUQT), SEQ, 3072, QRANK}; pg8::StaticOrder S; S.init(SEQ, 3072, G, (bid + G / 2) % G); EpiQ E{ws};
          pg8::gemm_phase<EpiQ, pg8::StaticOrder, PG_ALIGN, PG_SP2>(lds, g, S, E); }
#endif
        STAMP(11);
#ifndef NO_KVUP
        { pg8::Gemm g{(const bf16*)(ws + WS_CKV), (const bf16*)(ws + WS_WUKVT), LP, 4096, KVRANK}; pg8::StaticOrder S; S.init(LP, 4096, G, bid); EpiKV E{ws};
          pg8::gemm_phase<EpiKV, pg8::StaticOrder, PG_ALIGN, PG_SP2>(lds, g, S, E); }
#endif
        STAMP(12);
        { FRESH_IDS(); kpe_pass(ws, gw, NGW, lane); }
        STAMP(13);
        { FRESH_IDS(); gla_pass_a(ws, glw, lds, tid, G, bid, args.out); }
#if defined(DUP_PA)
        { FRESH_IDS(); gla_pass_a(ws, glw, lds, tid, G, bid, args.out); }
#endif
#if defined(DUP_KPE)
        { FRESH_IDS(); kpe_pass(ws, gw, NGW, lane); }
#endif
    }
    SEAM(2); STAMP(3);
    REP(3) if (IN(3)) {
#ifndef NO_CHAIN
        { FRESH_IDS();
          if (wave < 2) gla_chain(ws, bid, G, wave, lane);
          else { P0Args a{args.in[0], args.in[1], args.in[2], args.in[3], args.in[9], args.in[10], args.in[11], args.in[12], args.in[13], args.in[14], args.in[15], args.in[16], args.in[17], args.in[18], ws};
                 p0_weights_late(a, lds, bid * 6 + (wave - 2), G * 6, wave, lane); } }
#if defined(DUP_CHAIN)
        { FRESH_IDS();
          if (wave < 2) { if (DUP_CHAIN != 3) gla_chain(ws, bid, G, wave, lane); }
          else if (DUP_CHAIN != 2) { P0Args a{args.in[0], args.in[1], args.in[2], args.in[3], args.in[9], args.in[10], args.in[11], args.in[12], args.in[13], args.in[14], args.in[15], args.in[16], args.in[17], args.in[18], ws};
                 p0_weights_late(a, lds, bid * 6 + (wave - 2), G * 6, wave, lane); } }
#endif
#endif
        STAMP(14);
#ifndef NO_ATT
        att::attn_phase(ws, lds, G, bid, (bf16*)args.out, (bf16*)args.out + (size_t)32 * 1024 * 1024);
#endif
    }
    SEAM(3); STAMP(4);
    REP(4) if (IN(4)) { FRESH_IDS(); gla_pass_c<0>(ws, glw, lds, tid, G, bid, (bf16*)args.out + (size_t)48 * 1024 * 1024, args.out);
    }
    SEAM(4); STAMP(5);
    REP(5) if (IN(5)) {
        pg8::Gemm g{(const bf16*)args.out + (size_t)48 * 1024 * 1024, (const bf16*)(ws + WS_WGT), SEQ, DM, 2048, (const bf16*)args.out + (size_t)32 * 1024 * 1024, (const bf16*)(ws + WS_WMT)}; PairOrder S; S.init(SEQ, DM, G, bid); EpiMerged E{ws};
        pg8::gemm_phase<EpiMerged, PairOrder, PG_ALIGN, PG_SP2>(lds, g, S, E);
    }
    SEAM(5); STAMP(6);
    REP(6) if (IN(6)) {
        pg8::Gemm g{(const bf16*)(ws + WS_MERGED), (const bf16*)(ws + WS_WOT), SEQ, DM, DM}; pg8::StaticOrder S; S.init(SEQ, DM, G, bid); EpiWo E{ws, args.in[0], args.out};
        pg8::gemm_phase<EpiWo, pg8::StaticOrder, PG_ALIGN, PG_SP2>(lds, g, S, E);
    }
    SEAM(6); STAMP(7);
#if defined(EXTRA_BAR)
    for (int eb_ = 0; eb_ < EXTRA_BAR; ++eb_) xcd_barrier(bar);
#endif
    REP(7) if (IN(7)) {
        pg8::Gemm g{(const bf16*)(ws + WS_H1B), (const bf16*)(ws + WS_W1T), SEQ, DFF, DM}; pg8::StaticOrder S; S.init(SEQ, DFF, G, bid); pg8::Unit u0; u0.pm = 0; u0.pn = 0; S.next(0, u0); { FRESH_IDS(); ff1_rs_table(ws, lds, u0.pm, tid); } EpiFF1 E{ws, lds, u0.pm};
#if defined(EXP_BURN)
        if (rep_ == 1) {
            f32x4 bacc[32]; bf16x8 ba, bb;
#pragma unroll
            for (int q = 0; q < 32; ++q) bacc[q] = (f32x4){0.f, 0.f, 0.f, 0.f};
#pragma unroll
            for (int q = 0; q < 8; ++q) { ba[q] = (short)(0x3f80 + (threadIdx.x & 7)); bb[q] = (short)(0x3c00 + (threadIdx.x & 3)); }
            for (int it = 0; it < 512; ++it) {
#pragma unroll
                for (int k2 = 0; k2 < 64; ++k2) bacc[k2 & 31] = __builtin_amdgcn_mfma_f32_16x16x32_bf16(ba, bb, bacc[k2 & 31], 0, 0, 0);
            }
            float sm = 0.f;
#pragma unroll
            for (int q = 0; q < 32; ++q) sm += bacc[q][0] + bacc[q][1] + bacc[q][2] + bacc[q][3];
            if (sm == 1234567.125f) ((float*)(ws + ST_H2SS))[0] = sm;
        } else
#endif
#if defined(EXP_NULLEPI)
        if (rep_ == 1) { EpiNull EN{ws};
#if EXP_NULLEPI == 2
            pg8::Gemm g2{(const bf16*)(ws + WS_H1B), (const bf16*)(ws + WS_W1T), 256, 256, DM}; pg8::StaticOrder S2; S2.init(256, 256, 1, 0); S2.nwg = 8; S2.nN = 1; S2.nM = 1;
            struct HotOrder { __device__ bool next(int i, pg8::Unit& u) const { u.pm = 0; u.pn = 0; return i < 8; } __device__ __forceinline__ void a_ready(const pg8::Unit&) const {} __device__ __forceinline__ void done(const pg8::Unit&) const {} } HS;
            pg8::gemm_phase<EpiNull, HotOrder, true, true>(lds, g2, HS, EN);
#else
            pg8::gemm_phase<EpiNull, pg8::StaticOrder, true, true>(lds, g, S, EN);
#endif
        } else
#endif
        pg8::gemm_phase<EpiFF1, pg8::StaticOrder, PG_ALIGN, PG_SP2>(lds, g, S, E);
    }
    SEAM(7); STAMP(8);
    REP(8) if (IN(8)) {
        pg8::Gemm g{(const bf16*)(ws + WS_U), (const bf16*)(ws + WS_W2T), SEQ, DM, DFF, nullptr, nullptr, LDU, 0}; pg8::StaticOrder S; S.init(SEQ, DM, G, bid); EpiFF2 E{ws, args.out};
        pg8::gemm_phase<EpiFF2, pg8::StaticOrder, PG_ALIGN, PG_SP2>(lds, g, S, E);
#if defined(EXP_NULLEPI8)
        xcd_barrier(bar); { EpiNull EN{ws}; pg8::gemm_phase<EpiNull, pg8::StaticOrder, PG_ALIGN, PG_SP2>(lds, g, S, EN); }
#endif
    }
    SEAM(8); STAMP(9);
    REP(9) if (IN(9)) { FRESH_IDS(); final_norm(ws, args.out, args.in[19], gw, NGW, lane); }
#undef IN
#undef SEAM
}

#if defined(DBG_BISECT)
__global__ void __launch_bounds__(256) dbg_cksum(const unsigned* p, size_t nwords, unsigned* slot) {
    unsigned s = 0;
    for (size_t i = (size_t)blockIdx.x * 256 + threadIdx.x; i < nwords; i += (size_t)gridDim.x * 256) { const unsigned w = p[i]; s += w * 2654435761u + (unsigned)(i & 0xffff) * (w >> 7); }
    for (int o = 1; o < 64; o <<= 1) s += __shfl_xor(s, o);
    if ((threadIdx.x & 63) == 0) atomicAdd(slot, s);
}
__global__ void dbg_report(const unsigned* tab, int nbuf, float* out, size_t nout) {
    int first = 0;
    for (int i = 0; i < nbuf; ++i) if (tab[i] != tab[64 + i]) { first = i + 1; break; }
    for (size_t i = (size_t)blockIdx.x * blockDim.x + threadIdx.x; i < nout; i += (size_t)gridDim.x * blockDim.x) out[i] = (float)first * 1000.f;
}
struct DbgBuf { size_t off, bytes; int phase; int where; };
static const DbgBuf DBG_BUFS[] = {
    {WS_WINT, (size_t)NPROJ * DM * 2, 0, 0}, {WS_W1T, (size_t)DFF * DM * 2, 0, 0}, {WS_W2T, (size_t)DFF * DM * 2, 0, 0}, {WS_WOT, (size_t)DM * DM * 2, 0, 0},
    {WS_WGT, (size_t)DM * 2048 * 2, 0, 0}, {WS_WMT, (size_t)DM * 2048 * 2, 0, 0}, {WS_WUQT, (size_t)3072 * 1024 * 2, 0, 0}, {WS_WUKVT, (size_t)4096 * 512 * 2, 0, 0},
    {WS_H0B, (size_t)LP * DM * 2, 0, 0}, {ST_RS1, (size_t)LP * 4, 0, 0}, {ST_COS, (size_t)LTOK * 32 * 4, 0, 0}, {ST_SIN, (size_t)LTOK * 32 * 4, 0, 0},
    {WS_GQ, (size_t)SEQ * 1024 * 2, 1, 0}, {WS_GK, (size_t)LP * 1024 * 2, 1, 0}, {WS_GV, (size_t)LP * 2048 * 2, 1, 0}, {WS_GOG, (size_t)SEQ * 2048 * 2, 1, 0},
    {WS_CQ, (size_t)SEQ * 1024 * 2, 1, 0}, {WS_CKV, (size_t)LP * 512 * 2, 1, 0}, {WS_GA, (size_t)SEQ * DM * 2, 1, 0}, {WS_GB, (size_t)SEQ * DM * 2, 1, 0},
    {ST_SMALL, (size_t)LP * 96 * 4, 1, 0}, {ST_CQSS, (size_t)SEQ * 16 * 4, 1, 0}, {ST_CKVSS, (size_t)LP * 8 * 4, 1, 0},
    {WS_QM, (size_t)SEQ * 3072 * 2, 2, 0}, {WS_KF, (size_t)LP * 3072 * 2, 2, 0}, {WS_VB, (size_t)LP * 2048 * 2, 2, 0},
    {WS_KHTF, (size_t)129 * 8 * 128 * 64 * 2, 2, 0}, {WS_KHTB, (size_t)128 * 8 * 128 * 64 * 2, 2, 0}, {WS_VT, (size_t)129 * 8 * 256 * 64 * 2, 2, 0},
    {ST_DLF, (size_t)129 * 8 * 128 * 4, 2, 0}, {ST_DLB, (size_t)128 * 8 * 128 * 4, 2, 0},
    {WS_SNAP, (size_t)2 * 128 * 8 * 256 * 128 * 2, 3, 0}, {WS_AO, (size_t)SEQ * 2048 * 2, 3, 0},
    {WS_AG, (size_t)SEQ * 2048 * 2, 4, 0},
    {WS_MERGED, (size_t)SEQ * DM * 2, 5, 0},
    {0, (size_t)SEQ * DM * 4, 6, 1}, {WS_H1B, (size_t)SEQ * DM * 2, 6, 0}, {ST_H1SS, (size_t)SEQ * 64 * 4, 6, 0},
    {WS_U, (size_t)SEQ * DFF * 2, 7, 0},
    {0, (size_t)SEQ * DM * 4, 8, 1}, {ST_H2SS, (size_t)SEQ * 64 * 4, 8, 0},
    {0, (size_t)SEQ * DM * 4, 9, 1},
};
static void dbg_launch(Args a, int grid, void* d_out, void* d_ws, hipStream_t stream) {
    const int nbuf = (int)(sizeof(DBG_BUFS) / sizeof(DBG_BUFS[0]));
    unsigned* tab = (unsigned*)((char*)d_ws + WS_CTL + 65536);
    for (int run = 0; run < 2; ++run)
        for (int p = 0; p < NPHASE; ++p) {
            a.ph_lo = p; a.ph_hi = p + 1; hipLaunchKernelGGL(mega_fwd, dim3(grid), dim3(NTHR), LDS_BYTES, stream, a);
            for (int i = 0; i < nbuf; ++i) if (DBG_BUFS[i].phase == p) {
                const char* base = DBG_BUFS[i].where ? (const char*)d_out : (const char*)d_ws + DBG_BUFS[i].off;
                hipLaunchKernelGGL(dbg_cksum, dim3(1024), dim3(256), 0, stream, (const unsigned*)base, DBG_BUFS[i].bytes / 4, tab + run * 64 + i);
            }
        }
    hipLaunchKernelGGL(dbg_report, dim3(1024), dim3(256), 0, stream, (const unsigned*)tab, nbuf, (float*)d_out, (size_t)SEQ * DM);
}

#endif
#ifndef MK_N_LAUNCHES
#define MK_N_LAUNCHES 1
#endif
extern "C" void kernel_launch(void* const* d_in, const int* in_sizes, int n_in, void* d_out, int out_size, void* d_ws, size_t ws_size, hipStream_t stream) {
    static int grid = 0;
    if (grid == 0) {
        if (n_in != 20 || out_size != SEQ * DM || ws_size < WS_END) { fprintf(stderr, "kernel_launch: unexpected shapes: n_in %d out %d ws %zu (need %zu)\n", n_in, out_size, ws_size, (size_t)WS_END); grid = -1; return; }
        int dev = 0, cus = 0, per_cu = 0;
        if (hipGetDevice(&dev) != hipSuccess || hipDeviceGetAttribute(&cus, hipDeviceAttributeMultiprocessorCount, dev) != hipSuccess) { grid = -1; return; }
        if (hipFuncSetAttribute((const void*)mega_fwd, hipFuncAttributeMaxDynamicSharedMemorySize, LDS_BYTES) != hipSuccess) { fprintf(stderr, "kernel_launch: hipFuncSetAttribute failed\n"); grid = -1; return; }
        if (hipOccupancyMaxActiveBlocksPerMultiprocessor(&per_cu, (const void*)mega_fwd, NTHR, LDS_BYTES) != hipSuccess || per_cu < 1) fprintf(stderr, "kernel_launch: occupancy query says %d\n", per_cu);
        (void)hipGetLastError();
        grid = cus;
    }
    if (grid < 0) return;
    if (hipMemsetAsync((char*)d_ws + WS_CTL, 0, CTL_BYTES, stream) != hipSuccess) return;
    Args a{};
    for (int i = 0; i < 20; ++i) a.in[i] = (const float*)d_in[i];
    a.out = (float*)d_out; a.ws = (unsigned char*)d_ws;
#if defined(DBG_BISECT)
    dbg_launch(a, grid, d_out, d_ws, stream);
#elif MK_N_LAUNCHES == 1
    a.ph_lo = 0; a.ph_hi = NPHASE;
    hipLaunchKernelGGL(mega_fwd, dim3(grid), dim3(NTHR), LDS_BYTES, stream, a);
#else
    for (int p = 0; p < NPHASE; ++p) { a.ph_lo = p; a.ph_hi = p + 1; hipLaunchKernelGGL(mega_fwd, dim3(grid), dim3(NTHR), LDS_BYTES, stream, a); }
#endif
    const hipError_t le = hipPeekAtLastError();
    if (le != hipSuccess) fprintf(stderr, "kernel_launch: launch failed: %s\n", hipGetErrorName(le));
}
```

```cpp
#include <hip/hip_runtime.h>
#include <cstdio>
#include <cstdint>
namespace pg8 {
#define PG8_LAS __attribute__((address_space(3)))
typedef unsigned short bf16_t;
typedef short bf16x8 __attribute__((ext_vector_type(8)));
typedef float f32x4 __attribute__((ext_vector_type(4)));
typedef unsigned u32x4 __attribute__((ext_vector_type(4)));
typedef int i32x8 __attribute__((ext_vector_type(8)));
typedef int i32x4 __attribute__((ext_vector_type(4)));
constexpr int BM = 256, BK = 64, HALF = 128, HTB = HALF * BK * 2  , STAGE_BYTES = 8 * HTB, NXCD = 8, WGM = 8;

__host__ __device__ __forceinline__ int lds_byte(int r, int c) { const int st = (r >> 4) * 2 + (c >> 5), rr = r & 15, cc = c & 31, ob = rr * 64 + cc * 2; return st * 1024 + (ob ^ (((ob >> 9) & 1) << 5)); }
__host__ __device__ __forceinline__ void stage_rc(int b, int& R, int& C) { const int st = b / 1024, sb = b % 1024, swz = sb ^ (((sb >> 9) & 1) << 5); R = (st >> 1) * 16 + swz / 64; C = (st & 1) * 32 + (swz % 64) / 2; }
__host__ __device__ __forceinline__ int perm32(int rho) { const int n = rho >> 4, i = rho & 15; return 8 * (i >> 2) + 4 * n + (i & 3); }

struct Unit { int pm, pn, sel; };
struct Gemm { const bf16_t* A; const bf16_t* Bt; int M, N, K; const bf16_t* A2; const bf16_t* Bt2; int lda, ldb; };

struct StaticOrder {
    int nM, nN, nwg, G, c;
    __host__ __device__ void init(int M, int N, int G_, int c_) { nM = M / BM; nN = N / BM; nwg = nM * nN; G = G_; c = c_; }
    __host__ __device__ __forceinline__ bool next(int i, Unit& u) const {
        const long L = (long)i * G + c; if (L >= nwg) return false;
        int wgid = (int)L; { const int q = nwg / NXCD, r = nwg % NXCD, xcd = wgid % NXCD, off = wgid / NXCD; wgid = (xcd < r ? xcd * (q + 1) : r * (q + 1) + (xcd - r) * q) + off; }
        const int nig = WGM * nN, gid = wgid / nig, fm = gid * WGM, gsz = (nM - fm) < WGM ? (nM - fm) : WGM;
        u.pm = fm + ((wgid % nig) % gsz); u.pn = (wgid % nig) / gsz; return true;
    }
    __device__ __forceinline__ void a_ready(const Unit&) const {}
    __device__ __forceinline__ void done(const Unit&) const {}
};

template <class Epi, class Sched, bool ALIGN_EPI = false, bool SP2 = false, bool F8 = false>
__device__ __forceinline__ void gemm_phase(PG8_LAS unsigned char* lds, const Gemm g, const Sched& S, const Epi& E) {
    int tid = threadIdx.x; asm volatile("" : "+v"(tid)); const int wid = __builtin_amdgcn_readfirstlane(tid >> 6), lane = tid & 63, wr = wid >> 2, wc = wid & 3, fr = lane & 15, fq = lane >> 4;
    const int K = g.K, nt = F8 ? K / (2 * BK) : K / BK, lda = g.lda ? g.lda : K, ldb = g.ldb ? g.ldb : K;
    unsigned voffA[2], voffB[2];
#pragma unroll
    for (int i = 0; i < 2; ++i) { int R, C; stage_rc(tid * 16 + i * 8192, R, C); const int Rb = Epi::PERM ? ((R & ~31) + perm32(R & 31)) : R;
        voffA[i] = F8 ? (unsigned)(R * lda + 2 * C) : (unsigned)(R * lda + C) * 2u; voffB[i] = F8 ? (unsigned)(Rb * ldb + 2 * C) : (unsigned)(Rb * ldb + C) * 2u; }
    const size_t kstep = (size_t)(BK * 2);
    const size_t hstepA = (size_t)HALF * lda * (F8 ? 1 : 2), hstepB = (size_t)HALF * ldb * (F8 ? 1 : 2);
    const size_t tstepA = 2 * hstepA, tstepB = 2 * hstepB;
    const unsigned ldsw = (unsigned)wid * 1024u;
    const int aoff = lds_byte(wr * 64 + fr, fq * 8), boff = lds_byte(wc * 32 + fr, fq * 8);
#define PG8_SA(b, h) (((b) * 2 + (h)) * HTB)
#define PG8_SB(b, h) ((4 + (b) * 2 + (h)) * HTB)
#define PG8_STAGE(bufoff, gbase, voff) do { _Pragma("unroll") for (int _i = 0; _i < 2; ++_i) \
        asm volatile("s_mov_b32 m0, %2\n\ts_nop 0\n\tglobal_load_lds_dwordx4 %0, %1" :: "v"((voff)[_i]), "s"((const char*)(gbase)), "s"((unsigned)(uintptr_t)(lds + (bufoff) + ldsw + _i * 8192)) : "memory", "m0"); } while (0)
#define PG8_LDA(dst, b, h) do { _Pragma("unroll") for (int m = 0; m < 4; ++m) _Pragma("unroll") for (int k = 0; k < 2; ++k) dst[m][k] = *(const PG8_LAS bf16x8*)(lds + PG8_SA(b, h) + aoff + m * 2048 + k * 1024); } while (0)
#define PG8_LDB(dst, b, h) do { _Pragma("unroll") for (int n = 0; n < 2; ++n) _Pragma("unroll") for (int k = 0; k < 2; ++k) dst[n][k] = *(const PG8_LAS bf16x8*)(lds + PG8_SB(b, h) + boff + n * 2048 + k * 1024); } while (0)
#define PG8_CAT(F) __builtin_shufflevector(__builtin_bit_cast(i32x4, F[0]), __builtin_bit_cast(i32x4, F[1]), 0, 1, 2, 3, 4, 5, 6, 7)
#define PG8_MMA(ai, bj, At, Bt) do { __builtin_amdgcn_s_setprio(1); \
        if constexpr (F8) { _Pragma("unroll") for (int m = 0; m < 4; ++m) _Pragma("unroll") for (int n = 0; n < 2; ++n) \
            acc[ai][bj][m][n] = __builtin_amdgcn_mfma_scale_f32_16x16x128_f8f6f4(PG8_CAT(Bt[n]), PG8_CAT(At[m]), acc[ai][bj][m][n], 0, 0, 0, 0, 0, 0); } \
        else { _Pragma("unroll") for (int m = 0; m < 4; ++m) _Pragma("unroll") for (int n = 0; n < 2; ++n) _Pragma("unroll") for (int k = 0; k < 2; ++k) \
            acc[ai][bj][m][n] = __builtin_amdgcn_mfma_f32_16x16x32_bf16(Bt[n][k], At[m][k], acc[ai][bj][m][n], 0, 0, 0); } \
        __builtin_amdgcn_s_setprio(0); } while (0)
#define PG8_WAIT_V(n) asm volatile("s_waitcnt vmcnt(" #n ")" ::: "memory")
#define PG8_WAIT_L(n) asm volatile("s_waitcnt lgkmcnt(" #n ")" ::: "memory")
#define PG8_BAR __builtin_amdgcn_s_barrier()
#define PG8_SCHED __builtin_amdgcn_sched_barrier(0)
    Unit cur, nxt; int ui = 0;
    if (!S.next(0, cur)) return;
    f32x4 acc[2][2][4][2];
#pragma unroll
    for (int a = 0; a < 2; ++a)
#pragma unroll
        for (int b = 0; b < 2; ++b)
#pragma unroll
            for (int m = 0; m < 4; ++m)
#pragma unroll
                for (int n = 0; n < 2; ++n) acc[a][b][m][n] = (f32x4){0.f, 0.f, 0.f, 0.f};
    bf16x8 At[4][2], B0[2][2], B1[2][2];
    const char* cA = (const char*)((Epi::PAIRED && cur.sel) ? g.A2 : g.A) + (size_t)cur.pm * tstepA; const char* cB = (const char*)((Epi::PAIRED && cur.sel) ? g.Bt2 : g.Bt) + (size_t)cur.pn * tstepB;
    S.a_ready(cur);
    if constexpr (SP2) {
        PG8_STAGE(PG8_SB(0, 0), cB, voffB); PG8_STAGE(PG8_SB(0, 1), cB + hstepB, voffB); PG8_STAGE(PG8_SA(0, 0), cA, voffA); PG8_STAGE(PG8_SA(0, 1), cA + hstepA, voffA);
        if (wr == 1) PG8_BAR;
        PG8_WAIT_V(2); PG8_BAR;
        PG8_STAGE(PG8_SB(1, 0), cB + kstep, voffB); PG8_STAGE(PG8_SA(1, 0), cA + kstep, voffA); PG8_STAGE(PG8_SB(1, 1), cB + hstepB + kstep, voffB);
        PG8_WAIT_V(6); PG8_BAR;
    } else {
        PG8_STAGE(PG8_SB(0, 0), cB, voffB); PG8_STAGE(PG8_SA(0, 0), cA, voffA); PG8_STAGE(PG8_SB(0, 1), cB + hstepB, voffB); PG8_STAGE(PG8_SA(0, 1), cA + hstepA, voffA);
        if (wr == 1) PG8_BAR;
        PG8_WAIT_V(4); PG8_BAR;
        PG8_STAGE(PG8_SB(1, 0), cB + kstep, voffB); PG8_STAGE(PG8_SA(1, 0), cA + kstep, voffA); PG8_STAGE(PG8_SB(1, 1), cB + hstepB + kstep, voffB);
        PG8_WAIT_V(6); PG8_BAR;
    }
    for (;;) {
        const bool has_next = S.next(ui + 1, nxt);
        const char* nA = has_next ? (const char*)((Epi::PAIRED && nxt.sel) ? g.A2 : g.A) + (size_t)nxt.pm * tstepA : cA; const char* nB = has_next ? (const char*)((Epi::PAIRED && nxt.sel) ? g.Bt2 : g.Bt) + (size_t)nxt.pn * tstepB : cB;
        for (int t = 0; t < nt; t += 2) {
            const bool last = (t == nt - 2);
            const char* a1 = cA + (size_t)(t + 1) * kstep;
            const char* a2 = last ? nA : cA + (size_t)(t + 2) * kstep; const char* b2 = last ? nB : cB + (size_t)(t + 2) * kstep;
            const char* a3 = a2 + kstep; const char* b3 = b2 + kstep;
            if (last && has_next) S.a_ready(nxt);
            if constexpr (SP2) {
            PG8_LDB(B0, 0, 0); PG8_LDB(B1, 0, 1); PG8_SCHED; PG8_LDA(At, 0, 0); PG8_STAGE(PG8_SA(1, 1), a1 + hstepA, voffA);
            PG8_WAIT_V(8); PG8_WAIT_L(0); PG8_BAR; PG8_MMA(0, 0, At, B0); PG8_MMA(0, 1, At, B1); PG8_BAR; PG8_SCHED;
            PG8_LDA(At, 0, 1); PG8_STAGE(PG8_SB(0, 0), b2, voffB); PG8_STAGE(PG8_SB(0, 1), b2 + hstepB, voffB); PG8_STAGE(PG8_SA(0, 0), a2, voffA);
            PG8_WAIT_V(8); PG8_WAIT_L(0); PG8_BAR; PG8_MMA(1, 0, At, B0); PG8_MMA(1, 1, At, B1); PG8_BAR; PG8_SCHED;
            PG8_LDB(B0, 1, 0); PG8_LDB(B1, 1, 1); PG8_SCHED; PG8_LDA(At, 1, 0); PG8_STAGE(PG8_SA(0, 1), a2 + hstepA, voffA);
            PG8_WAIT_V(8); PG8_WAIT_L(0); PG8_BAR; PG8_MMA(0, 0, At, B0); PG8_MMA(0, 1, At, B1); PG8_BAR; PG8_SCHED;
            PG8_LDA(At, 1, 1); PG8_STAGE(PG8_SB(1, 0), b3, voffB); PG8_STAGE(PG8_SB(1, 1), b3 + hstepB, voffB); PG8_STAGE(PG8_SA(1, 0), a3, voffA);
            PG8_WAIT_V(8); PG8_WAIT_L(0); PG8_BAR; PG8_MMA(1, 0, At, B0); PG8_MMA(1, 1, At, B1); PG8_BAR; PG8_SCHED;
            } else {
            PG8_LDB(B0, 0, 0); PG8_SCHED; PG8_LDA(At, 0, 0); PG8_STAGE(PG8_SA(1, 1), a1 + hstepA, voffA);
            PG8_WAIT_L(8); PG8_BAR; PG8_WAIT_L(0); PG8_MMA(0, 0, At, B0); PG8_BAR; PG8_SCHED;
            PG8_LDB(B1, 0, 1); PG8_STAGE(PG8_SB(0, 0), b2, voffB);
            PG8_BAR; PG8_WAIT_L(0); PG8_MMA(0, 1, At, B1); PG8_BAR;
            PG8_LDA(At, 0, 1); PG8_STAGE(PG8_SA(0, 0), a2, voffA);
            PG8_BAR; PG8_WAIT_L(0); PG8_MMA(1, 0, At, B0); PG8_BAR; PG8_SCHED;
            PG8_STAGE(PG8_SB(0, 1), b2 + hstepB, voffB);
            PG8_WAIT_V(6); PG8_BAR; PG8_MMA(1, 1, At, B1); PG8_BAR;
            PG8_LDB(B0, 1, 0); PG8_SCHED; PG8_LDA(At, 1, 0); PG8_STAGE(PG8_SA(0, 1), a2 + hstepA, voffA);
            PG8_WAIT_L(8); PG8_BAR; PG8_WAIT_L(0); PG8_MMA(0, 0, At, B0); PG8_BAR; PG8_SCHED;
            PG8_LDB(B1, 1, 1); PG8_STAGE(PG8_SB(1, 0), b3, voffB);
            PG8_BAR; PG8_WAIT_L(0); PG8_MMA(0, 1, At, B1); PG8_BAR;
            PG8_LDA(At, 1, 1); PG8_STAGE(PG8_SA(1, 0), a3, voffA);
            PG8_BAR; PG8_WAIT_L(0); PG8_MMA(1, 0, At, B0); PG8_BAR; PG8_SCHED;
            PG8_STAGE(PG8_SB(1, 1), b3 + hstepB, voffB);
            PG8_WAIT_V(6); PG8_BAR; PG8_MMA(1, 1, At, B1); PG8_BAR;
            }
        }
        if constexpr (ALIGN_EPI) { if (wr == 0) PG8_BAR; }
        bool keep_acc = false;
        if constexpr (Epi::PAIRED) { if (cur.sel == 0) { E.mid(acc, cur, wr, wc, fr, fq); keep_acc = true; } else { E(acc, cur, wr, wc, fr, fq); S.done(cur); } }
        else if constexpr (!Epi::AFTER_DRAIN) { E(acc, cur, wr, wc, fr, fq); S.done(cur); }
        if (!has_next) break;
        if (!keep_acc)
#pragma unroll
        for (int a = 0; a < 2; ++a)
#pragma unroll
            for (int b = 0; b < 2; ++b)
#pragma unroll
                for (int m = 0; m < 4; ++m)
#pragma unroll
                    for (int n = 0; n < 2; ++n) acc[a][b][m][n] = (f32x4){0.f, 0.f, 0.f, 0.f};
        cur = nxt; cA = nA; cB = nB; ++ui;
        if constexpr (ALIGN_EPI) { if (wr == 1) PG8_BAR; }
    }
    PG8_WAIT_V(0);
    if constexpr (!ALIGN_EPI) { if (wr == 0) PG8_BAR; }
    PG8_BAR;
    if constexpr (Epi::AFTER_DRAIN) { E.fused(acc, cur, wr, wc, fr, fq, lds, wid, lane); S.done(cur); }
#undef PG8_SA
#undef PG8_SB
#undef PG8_STAGE
#undef PG8_LDA
#undef PG8_LDB
#undef PG8_MMA
#undef PG8_WAIT_V
#undef PG8_WAIT_L
#undef PG8_BAR
#undef PG8_SCHED
}
}
#define LAS __attribute__((address_space(3)))
#define XB_TMO      128
#define XB_XCNT(j)  (256  + 64 * (j))
#define XB_XSUB(j)  (1280 + 64 * (j))
#define XB_XGEN(j)  (2304 + 64 * (j))
#define XB_TOP      3328
#define XB_TOPGEN   3392
#define XCD_BAR_WORDS 3456
#define XB_SPIN_CAP (1u << 18)

__device__ __forceinline__ unsigned xb_ld(unsigned* p)              { return __hip_atomic_load(p, __ATOMIC_RELAXED, __HIP_MEMORY_SCOPE_AGENT); }
__device__ __forceinline__ unsigned xb_add(unsigned* p, unsigned v) { return __hip_atomic_fetch_add(p, v, __ATOMIC_RELAXED, __HIP_MEMORY_SCOPE_AGENT); }
__device__ __forceinline__ unsigned xb_xcc_id() { return (unsigned)__builtin_amdgcn_s_getreg((3 << 11) | 20) & 0xFu; }
#define XB_SPIN(cond, bar) do { unsigned _sp = 0; while (cond) { __builtin_amdgcn_s_sleep(1); \
    if ((++_sp & 255u) == 0u) { if (xb_ld(&(bar)[XB_TMO])) break; if (_sp > XB_SPIN_CAP) { atomicAdd(&(bar)[XB_TMO], 1u); break; } } } } while (0)

struct XcdBarrier {
    unsigned* bar; unsigned x;
    volatile LAS unsigned* st;
};

__device__ __forceinline__ XcdBarrier xcd_barrier_post(unsigned* bar, volatile LAS unsigned* st) {
    XcdBarrier b; b.bar = bar; b.x = xb_xcc_id(); b.st = st;
    if (threadIdx.x == 0) (void)xb_add(&bar[XB_XCNT(b.x)], 1u);
    return b;
}
__device__ __forceinline__ void xcd_barrier_complete(unsigned* bar, unsigned x, unsigned& nloc, unsigned& nx) {
    const unsigned G = gridDim.x * gridDim.y * gridDim.z;
    unsigned sum, cnt, mine, sp = 0u;
    for (;;) {
        sum = 0u; cnt = 0u; mine = 0u;
#pragma unroll
        for (unsigned j = 0; j < 16; ++j) { const unsigned c = xb_ld(&bar[XB_XCNT(j)]); sum += c; cnt += (c > 0u) ? 1u : 0u; mine = (j == x) ? c : mine; }
        if (sum == G) break;
        __builtin_amdgcn_s_sleep(1);
        if ((++sp & 255u) == 0u) { if (xb_ld(&bar[XB_TMO])) break; if (sp > XB_SPIN_CAP) { atomicAdd(&bar[XB_TMO], 1u); break; } }
    }
    nloc = mine > 0u ? mine : 1u; nx = cnt > 0u ? cnt : 1u;
}

__device__ __forceinline__ void xcd_barrier(const XcdBarrier& b) {
    asm volatile("s_waitcnt vmcnt(0)" ::: "memory");
    __syncthreads();
    if (threadIdx.x == 0) {
        unsigned* bar = b.bar;
        __builtin_amdgcn_s_waitcnt(0);
        unsigned nloc = b.st[0], nx = b.st[1];
        if (nloc == 0u) { xcd_barrier_complete(bar, b.x, nloc, nx); b.st[0] = nloc; b.st[1] = nx; }
        const unsigned old = xb_add(&bar[XB_XSUB(b.x)], 1u);
        const unsigned gen = old / nloc;
        if (old + 1u == (gen + 1u) * nloc) {
            __builtin_amdgcn_fence(__ATOMIC_RELEASE, "agent");
            asm volatile("s_waitcnt vmcnt(0)" ::: "memory");
            const unsigned og = xb_add(&bar[XB_TOP], 1u);
            const unsigned tg = og / nx;
            if (og + 1u == (tg + 1u) * nx) xb_add(&bar[XB_TOPGEN], 1u);
            else XB_SPIN(xb_ld(&bar[XB_TOPGEN]) == tg, bar);
            __builtin_amdgcn_fence(__ATOMIC_ACQUIRE, "agent");
            xb_add(&bar[XB_XGEN(b.x)], 1u);
            asm volatile("s_waitcnt vmcnt(0)" ::: "memory");
        } else {
            XB_SPIN(xb_ld(&bar[XB_XGEN(b.x)]) == gen, bar);
            __builtin_amdgcn_fence(__ATOMIC_ACQUIRE, "agent");
            asm volatile("s_waitcnt vmcnt(0)" ::: "memory");
        }
    }
    __syncthreads();
}
constexpr int NWAVES = 8, NTHR = 512;
constexpr int DM = 4096, SEQ = 8192, NMETA = 16, LTOK = SEQ + NMETA  , LP = 8448  ;
constexpr int NPROJ = 16128;
constexpr int DFF = 16384;
constexpr int GH = 8, GDK = 128, GDV = 256, GCH = 64, NXC = SEQ / GCH  ;
constexpr int MH = 16, MQK = 192, MNOPE = 128, MROPE = 64, MV = 128, QRANK = 1024, KVRANK = 512;
constexpr float EPS = 1e-6f;
constexpr float GLA_QSCALE = 0.08838834764831845f;
constexpr float MLA_QSCALE = 0.07216878364870323f * 1.4426950408889634f;
constexpr size_t KiB = 1024, MiB = 1024 * 1024;
constexpr size_t WS_CTL = 0, CTL_BYTES = 1 * MiB;
constexpr size_t WS_W1T = WS_CTL + CTL_BYTES;
constexpr size_t WS_W2T = WS_W1T + (size_t)DFF * DM * 2;
constexpr size_t WS_WOT = WS_W2T + (size_t)DFF * DM * 2;
constexpr size_t WS_WGT = WS_WOT + (size_t)DM * DM * 2;
constexpr size_t WS_WMT = WS_WGT + (size_t)DM * 2048 * 2;
constexpr size_t WS_WUQT = WS_WMT + (size_t)DM * 2048 * 2;
constexpr size_t WS_WUKVT = WS_WUQT + (size_t)3072 * 1024 * 2;
constexpr size_t WS_STATS = WS_WUKVT + (size_t)4096 * 512 * 2;
constexpr size_t ST_RS1 = WS_STATS;
constexpr size_t ST_CQSS = ST_RS1 + (size_t)LP * 4;
constexpr size_t ST_CKVSS = ST_CQSS + (size_t)SEQ * 16 * 4;
constexpr size_t ST_H1SS = ST_CKVSS + (size_t)LP * 8 * 4;
constexpr size_t ST_H2SS = ST_H1SS + (size_t)SEQ * 64 * 4;
constexpr size_t ST_COS = ST_H2SS + (size_t)SEQ * 64 * 4;
constexpr size_t ST_SIN = ST_COS + (size_t)LTOK * 32 * 4;
constexpr size_t ST_DLF = ST_SIN + (size_t)LTOK * 32 * 4;
constexpr size_t ST_DLB = ST_DLF + (size_t)129 * 8 * 128 * 4;
constexpr size_t ST_SMALL = ST_DLB + (size_t)128 * 8 * 128 * 4;
constexpr size_t WS_R1 = (ST_SMALL + (size_t)LP * 96 * 4 + 4095) / 4096 * 4096;
constexpr size_t WS_WINT = WS_R1;
constexpr size_t WS_QM = WS_R1;
constexpr size_t WS_KF = WS_QM + (size_t)SEQ * 3072 * 2;
constexpr size_t WS_R2 = WS_R1 + (size_t)NPROJ * DM * 2;
static_assert(WS_KF + (size_t)LP * 3072 * 2 <= WS_R2, "R1 overlay");
constexpr size_t WS_H0B = WS_R2;
constexpr size_t WS_AO = WS_R2;
constexpr size_t WS_AG = WS_AO + (size_t)SEQ * 2048 * 2;
constexpr size_t WS_P = WS_R2 + (size_t)LP * DM * 2;
static_assert(WS_AG + (size_t)SEQ * 2048 * 2 <= WS_P, "R2 overlay");
constexpr size_t WS_GQ = WS_P;
constexpr size_t WS_GK = WS_GQ + (size_t)SEQ * 1024 * 2;
constexpr size_t WS_GV = WS_GK + (size_t)LP * 1024 * 2;
constexpr size_t WS_GOG = WS_GV + (size_t)LP * 2048 * 2;
constexpr size_t WS_MERGED = WS_P;
static_assert(WS_MERGED + (size_t)SEQ * DM * 2 <= WS_GOG, "merged overlay");
constexpr size_t WS_CQ = WS_GOG + (size_t)SEQ * 2048 * 2;
constexpr size_t WS_CKV = WS_CQ + (size_t)SEQ * 1024 * 2;
constexpr size_t WS_GA = WS_CKV + (size_t)LP * 512 * 2;
constexpr size_t WS_GB = WS_GA + (size_t)SEQ * DM * 2;
constexpr size_t WS_U = WS_R1;
constexpr size_t WS_VB = WS_GB + (size_t)SEQ * DM * 2;
constexpr int LDU = DFF;
static_assert(WS_U + (size_t)SEQ * LDU * 2 <= WS_VB, "U overlay");
constexpr size_t WS_KHTF = WS_VB + (size_t)LP * 2048 * 2;
constexpr size_t WS_KHTB = WS_KHTF + (size_t)129 * 8 * 128 * 64 * 2;
constexpr size_t WS_VT = WS_KHTB + (size_t)128 * 8 * 128 * 64 * 2;
constexpr size_t WS_SNAP = WS_VT + (size_t)129 * 8 * 256 * 64 * 2;
constexpr size_t WS_H1B = WS_SNAP;
constexpr size_t WS_END = WS_SNAP + (size_t)2 * 128 * 8 * 256 * 128 * 2;
static_assert(WS_END <= (size_t)1024 * MiB, "d_ws budget: 4 x largest tensor = 1 GiB");
constexpr size_t WS_H0F8 = WS_W1T;
constexpr size_t WS_WF8 = WS_H0F8 + (size_t)LP * DM;
static_assert(WS_WF8 + (size_t)8192 * DM <= WS_W1T + (size_t)DFF * DM * 2, "fp8 operands inside the W1T region");
constexpr int F8_COL0 = 7680, F8_COL1 = 15872;
constexpr float F8_WSCALE = 64.f;
constexpr int CW_BAR = 4096;
constexpr int LDS_BYTES = 163840;
constexpr int LDS_CTL = LDS_BYTES - 256;

#define GAS __attribute__((address_space(1)))
typedef unsigned short bf16;
typedef float f32x4 __attribute__((ext_vector_type(4)));
typedef float f32x16 __attribute__((ext_vector_type(16)));
typedef short bf16x8 __attribute__((ext_vector_type(8)));
typedef short s16x4 __attribute__((ext_vector_type(4)));
typedef unsigned u32x4 __attribute__((ext_vector_type(4)));
typedef unsigned u32x2 __attribute__((ext_vector_type(2)));
#define LDS_WAIT() asm volatile("s_waitcnt lgkmcnt(0)" ::: "memory")
#define VM_WAIT() asm volatile("s_waitcnt vmcnt(0)" ::: "memory")
#define SBAR() __builtin_amdgcn_sched_barrier(0)
typedef float f32x2_ __attribute__((ext_vector_type(2)));
typedef __bf16 bf16x2_ __attribute__((ext_vector_type(2)));
__device__ __forceinline__ unsigned cvtpk(float lo, float hi) { const f32x2_ v = {lo, hi}; return __builtin_bit_cast(unsigned, __builtin_convertvector(v, bf16x2_)); }
__device__ __forceinline__ float bf2f(unsigned short b) { return __uint_as_float(((unsigned)b) << 16); }
__device__ __forceinline__ float bflo(unsigned w) { return __uint_as_float(w << 16); }
__device__ __forceinline__ float bfhi(unsigned w) { return __uint_as_float(w & 0xffff0000u); }
__device__ __forceinline__ unsigned short f2bf(float f) { return (unsigned short)(cvtpk(f, 0.f) & 0xffffu); }
__device__ __forceinline__ float wave_sum(float v) {
#pragma unroll
    for (int o = 1; o < 64; o <<= 1) v += __shfl_xor(v, o);
    return v;
}
__device__ __forceinline__ float sigmoidf_(float x) { return __builtin_amdgcn_rcpf(1.f + __expf(-x)); }
__device__ __forceinline__ float logsig16(float z) { return (fminf(z, 0.f) - __logf(1.f + __expf(-fabsf(z)))) * 0.0625f; }
template <int KIND> __device__ __forceinline__ int srccol(int n) {
    if (KIND == 1) {
        if (n < 6144) return n;
        if (n < 7168) return 6176 + (n - 6144);
        if (n < 7680) return 7200 + (n - 7168);
        if (n < 15872) return 7776 + (n - 7680);
        if (n < 15936) return 7712 + (n - 15872);
        if (n < 15968) return 6144 + (n - 15936);
        return -1;
    } else if (KIND == 2) {
        const int h = n / 192, w = n - h * 192;
        if (w < 128) return n;
        const int p = w - 128, gp = p >> 5, fq = (p >> 3) & 3, nn = (p >> 2) & 1, j = p & 3;
        return h * 192 + 128 + 32 * nn + 16 * gp + 4 * fq + j;
    }
    return n;
}
constexpr int P0_SCR = 64 * 65 * 4;
struct P0Item { const float* W; const float* gain; bf16* WT; int K, N, kind, k0, n0; unsigned char* F8; };
__device__ __forceinline__ unsigned pk4_fp8(float a, float b, float c, float d) { int w = __builtin_amdgcn_cvt_pk_fp8_f32(a, b, 0, false); w = __builtin_amdgcn_cvt_pk_fp8_f32(c, d, w, true); return (unsigned)w; }
template <int KIND> __device__ __forceinline__ void p0_load_k(const P0Item& d, f32x4 (&v)[16], int lane) {
    const int sc = srccol<KIND>(d.n0 + 4 * (lane & 15)), kr = lane >> 4;
#pragma unroll
    for (int i = 0; i < 16; ++i) v[i] = sc >= 0 ? *(const GAS f32x4*)(d.W + (size_t)(d.k0 + 4 * i + kr) * d.N + sc) : (f32x4){0.f, 0.f, 0.f, 0.f};
}
__device__ __forceinline__ void p0_load(const P0Item& d, f32x4 (&v)[16], int lane) {
    if (d.kind == 1) p0_load_k<1>(d, v, lane); else if (d.kind == 2) p0_load_k<2>(d, v, lane); else p0_load_k<0>(d, v, lane);
}
__device__ __forceinline__ void p0_finish(const P0Item& d, const f32x4 (&v)[16], LAS float* scr, int lane) {
    const int kr = lane >> 4, c4 = 4 * (lane & 15), c = lane & 7;
    f32x4 g0 = (f32x4){1.f, 1.f, 1.f, 1.f}, g1 = g0;
    if (d.gain) { g0 = *(const GAS f32x4*)(d.gain + d.k0 + 8 * c); g1 = *(const GAS f32x4*)(d.gain + d.k0 + 8 * c + 4); }
#pragma unroll
    for (int i = 0; i < 16; ++i) { LAS float* w = scr + (4 * i + kr) * 65 + c4; w[0] = v[i][0]; w[1] = v[i][1]; w[2] = v[i][2]; w[3] = v[i][3]; }
    LDS_WAIT(); asm volatile("" ::: "memory");
#pragma unroll
    for (int j = 0; j < 8; ++j) { const int n = (lane >> 3) + 8 * j; const LAS float* s = scr + (8 * c) * 65 + n;
        u32x4 o; o.x = cvtpk(s[0 * 65] * g0[0], s[1 * 65] * g0[1]); o.y = cvtpk(s[2 * 65] * g0[2], s[3 * 65] * g0[3]); o.z = cvtpk(s[4 * 65] * g1[0], s[5 * 65] * g1[1]); o.w = cvtpk(s[6 * 65] * g1[2], s[7 * 65] * g1[3]);
        if (d.F8) { u32x2 o8; o8.x = pk4_fp8(s[0 * 65] * g0[0] * F8_WSCALE, s[1 * 65] * g0[1] * F8_WSCALE, s[2 * 65] * g0[2] * F8_WSCALE, s[3 * 65] * g0[3] * F8_WSCALE);
                    o8.y = pk4_fp8(s[4 * 65] * g1[0] * F8_WSCALE, s[5 * 65] * g1[1] * F8_WSCALE, s[6 * 65] * g1[2] * F8_WSCALE, s[7 * 65] * g1[3] * F8_WSCALE);
                    *(GAS u32x2*)(d.F8 + (size_t)n * d.K + d.k0 + 8 * c) = o8; }
        else *(GAS u32x4*)(d.WT + (size_t)(d.n0 + n) * d.K + d.k0 + 8 * c) = o; }
    LDS_WAIT(); asm volatile("" ::: "memory");
}
__device__ __forceinline__ void p0_mk(P0Item& d, const float* W, int K, int N, const float* gain, bf16* WT, int kind, int item, int nblk) {
    const int kb = item / nblk, nb = item - kb * nblk; d.W = W; d.gain = gain; d.WT = WT; d.K = K; d.N = N; d.kind = kind; d.k0 = 64 * kb; d.n0 = 64 * nb; d.F8 = nullptr;
}
__device__ const double ROPE_INVF[32] = {
1.00000000000000000e+00, 7.49894209332455874e-01, 5.62341325190349073e-01, 4.21696503428582226e-01, 3.16227766016837941e-01, 2.37137370566165517e-01, 1.77827941003892293e-01, 1.33352143216332403e-01,
1.00000000000000006e-01, 7.49894209332455791e-02, 5.62341325190349114e-02, 4.21696503428582239e-02, 3.16227766016837913e-02, 2.37137370566165538e-02, 1.77827941003892293e-02, 1.33352143216332406e-02,
1.00000000000000002e-02, 7.49894209332455791e-03, 5.62341325190349097e-03, 4.21696503428582292e-03, 3.16227766016837939e-03, 2.37137370566165538e-03, 1.77827941003892275e-03, 1.33352143216332406e-03,
1.00000000000000002e-03, 7.49894209332455856e-04, 5.62341325190349097e-04, 4.21696503428582237e-04, 3.16227766016837939e-04, 2.37137370566165538e-04, 1.77827941003892270e-04, 1.33352143216332395e-04 };
__device__ __forceinline__ void rope_cs(int pos, int i, float& c, float& s) {
    const double x = (double)pos * ROPE_INVF[i];
    const double k = __builtin_rint(x * 0.15915494309189534561);
    double r = __builtin_fma(-k, 6.283185307179586, x); r = __builtin_fma(-k, 2.4492935982947064e-16, r);
    const double r2 = r * r;
    double ss = 1.0, cc = 1.0;
#pragma unroll
    for (int n = 14; n >= 1; --n) { ss = 1.0 - ss * r2 * (1.0 / (double)((2 * n) * (2 * n + 1))); cc = 1.0 - cc * r2 * (1.0 / (double)((2 * n - 1) * (2 * n))); }
    s = (float)(r * ss); c = (float)cc;
}
struct P0Args { const float *x, *meta, *ln1, *w_in, *q_norm, *w_uq, *kv_norm, *w_ukv, *w_gla_out, *w_mla_out, *w_o, *ln2, *w_ff1, *w_ff2; unsigned char* ws; };
__device__ __forceinline__ bool p0_item_early(const P0Args& a, int it, P0Item& d) {
    constexpr int I_IN = (DM / 64) * (NPROJ / 64), I_UQ = (QRANK / 64) * (3072 / 64), I_UKV = (KVRANK / 64) * (4096 / 64), NITEMS = I_IN + I_UQ + I_UKV;
    if (it >= NITEMS) return false;
    unsigned char* ws = a.ws; int r = it;
    if (r < I_IN) { p0_mk(d, a.w_in, DM, 15968, a.ln1, (bf16*)(ws + WS_WINT), 1, r, NPROJ / 64);
                    if (d.n0 >= F8_COL0 && d.n0 < F8_COL1) d.F8 = ws + WS_WF8 + (size_t)(d.n0 - F8_COL0) * DM;
                    return true; } r -= I_IN;
    if (r < I_UQ) { p0_mk(d, a.w_uq, QRANK, 3072, a.q_norm, (bf16*)(ws + WS_WUQT), 2, r, 3072 / 64); return true; } r -= I_UQ;
    p0_mk(d, a.w_ukv, KVRANK, 4096, a.kv_norm, (bf16*)(ws + WS_WUKVT), 0, r, 4096 / 64); return true;
}
__device__ __forceinline__ bool p0_item_late(const P0Args& a, int it, P0Item& d) {
    constexpr int I_F1 = (DM / 64) * (DFF / 64), I_F2 = (DFF / 64) * (DM / 64), I_O = (DM / 64) * (DM / 64), I_G = (2048 / 64) * (DM / 64), I_M = I_G, NITEMS = I_F1 + I_F2 + I_O + I_G + I_M;
    if (it >= NITEMS) return false;
    unsigned char* ws = a.ws; int r = it;
    if (r < I_G) { p0_mk(d, a.w_gla_out, 2048, DM, nullptr, (bf16*)(ws + WS_WGT), 0, r, DM / 64); return true; } r -= I_G;
    if (r < I_M) { p0_mk(d, a.w_mla_out, 2048, DM, nullptr, (bf16*)(ws + WS_WMT), 0, r, DM / 64); return true; } r -= I_M;
    if (r < I_O) { p0_mk(d, a.w_o, DM, DM, nullptr, (bf16*)(ws + WS_WOT), 0, r, DM / 64); return true; } r -= I_O;
    if (r < I_F1) { p0_mk(d, a.w_ff1, DM, DFF, a.ln2, (bf16*)(ws + WS_W1T), 0, r, DFF / 64); return true; } r -= I_F1;
    p0_mk(d, a.w_ff2, DFF, DM, nullptr, (bf16*)(ws + WS_W2T), 0, r, DM / 64); return true;
}
template <bool LATE> __device__ __forceinline__ void p0_weights(const P0Args& a, LAS unsigned char* lds, int gw, int NGW, int wave, int lane) {
    LAS float* scr = (LAS float*)(lds + wave * P0_SCR);
    P0Item cur, nxt; f32x4 va[16], vb[16];
    bool have = LATE ? p0_item_late(a, gw, cur) : p0_item_early(a, gw, cur);
    if (have) p0_load(cur, va, lane);
    for (int it = gw; have; it += 2 * NGW) {
        const bool h1 = LATE ? p0_item_late(a, it + NGW, nxt) : p0_item_early(a, it + NGW, nxt);
        if (h1) p0_load(nxt, vb, lane);
        p0_finish(cur, va, scr, lane);
        if (!h1) break;
        have = LATE ? p0_item_late(a, it + 2 * NGW, cur) : p0_item_early(a, it + 2 * NGW, cur);
        if (have) p0_load(cur, va, lane);
        p0_finish(nxt, vb, scr, lane);
    }
}
__device__ __forceinline__ void p0_weights_early(const P0Args& a, LAS unsigned char* lds, int gw, int NGW, int wave, int lane) { p0_weights<false>(a, lds, gw, NGW, wave, lane); }
__device__ __forceinline__ void p0_weights_late(const P0Args& a, LAS unsigned char* lds, int gw, int NGW, int wave, int lane) { p0_weights<true>(a, lds, gw, NGW, wave, lane); }
__device__ __forceinline__ void p0_prologue(const P0Args& a, LAS unsigned char* lds, int gw, int NGW, int wave, int lane) {
    p0_weights_early(a, lds, gw, NGW, wave, lane);
    unsigned char* ws = a.ws;
    bf16* H0B = (bf16*)(ws + WS_H0B); float* RS1 = (float*)(ws + ST_RS1);
    for (int m = gw; m < LP; m += NGW) {
        GAS u32x2* o8 = (GAS u32x2*)(H0B + (size_t)m * DM) + lane;
        GAS unsigned* f4 = (GAS unsigned*)(ws + WS_H0F8 + (size_t)m * DM) + lane;
        if (m >= LTOK) {
#pragma unroll
            for (int j = 0; j < 16; ++j) { o8[64 * j] = (u32x2){0u, 0u}; f4[64 * j] = 0u; }
            if (lane == 0) RS1[m] = 0.f;
            continue;
        }
        const float* src = m < SEQ ? a.x + (size_t)m * DM : a.meta + (size_t)(m - SEQ) * DM;
        const GAS f32x4* xr = (const GAS f32x4*)src + lane;
        f32x4 v[16]; float s = 0.f;
#pragma unroll
        for (int j = 0; j < 16; ++j) { v[j] = xr[64 * j]; s += (v[j].x * v[j].x + v[j].y * v[j].y) + (v[j].z * v[j].z + v[j].w * v[j].w); }
        s = wave_sum(s);
        if (lane == 0) RS1[m] = 1.f / sqrtf(s * (1.f / DM) + EPS);
#pragma unroll
        for (int j = 0; j < 16; ++j) { o8[64 * j] = (u32x2){cvtpk(v[j].x, v[j].y), cvtpk(v[j].z, v[j].w)}; f4[64 * j] = pk4_fp8(v[j].x, v[j].y, v[j].z, v[j].w); }
    }
    float* COS = (float*)(ws + ST_COS); float* SIN = (float*)(ws + ST_SIN);
    for (int i = gw * 64 + lane; i < LTOK * 32; i += NGW * 64) { float c, s; rope_cs(i >> 5, i & 31, c, s); COS[i] = c; SIN[i] = s; }
}
__device__ __forceinline__ void st_bf8(bf16* p, f32x4 v0, f32x4 v1) { u32x4 w; w.x = cvtpk(v0[0], v0[1]); w.y = cvtpk(v0[2], v0[3]); w.z = cvtpk(v1[0], v1[1]); w.w = cvtpk(v1[2], v1[3]); *(GAS u32x4*)p = w; }
__device__ __forceinline__ void st_bf8_nt(bf16* p, f32x4 v0, f32x4 v1) { u32x4 w; w.x = cvtpk(v0[0], v0[1]); w.y = cvtpk(v0[2], v0[3]); w.z = cvtpk(v1[0], v1[1]); w.w = cvtpk(v1[2], v1[3]); __builtin_nontemporal_store(w, (GAS u32x4*)p); }
__device__ __forceinline__ void ld_bf8(const bf16* p, f32x4& a, f32x4& b) { const u32x4 w = *(const GAS u32x4*)p; a = (f32x4){bflo(w.x), bfhi(w.x), bflo(w.y), bfhi(w.y)}; b = (f32x4){bflo(w.z), bfhi(w.z), bflo(w.w), bfhi(w.w)}; }
__device__ __forceinline__ float dot4(f32x4 a) { return (a[0] * a[0] + a[1] * a[1]) + (a[2] * a[2] + a[3] * a[3]); }
#define EPI_ROWS(ai, m) _Pragma("unroll") for (int ai = 0; ai < 2; ++ai) _Pragma("unroll") for (int m = 0; m < 4; ++m)

struct ProjOrder {
    pg8::StaticOrder so; int G, c, f8;
    __device__ void init(int G_, int c_, int f8_) { f8 = f8_; so.init(SEQ, (f8_ ? 32 : 31) * 256, G_, c_); G = G_; c = c_; }
    __device__ __forceinline__ bool next(int i, pg8::Unit& u) const {
        const int L = i * G + c;
        if (f8) { const bool ok = so.next(i, u); u.pn += 30; return ok; }
        if (L < 32 * 31) { const bool ok = so.next(i, u); const int p2 = 2 * u.pn, q = p2 < 31 ? p2 : p2 - 31; u.pn = q < 30 ? q : 62; return ok; }
        const int e = L - 32 * 31; if (e >= 15) return false;
        u.pm = 32; u.pn = e < 12 ? 4 + e : (e == 12 ? 28 : (e == 13 ? 29 : 62)); return true;
    }
    __device__ __forceinline__ void a_ready(const pg8::Unit&) const {}
    __device__ __forceinline__ void done(const pg8::Unit&) const {}
};
struct EpiProj {
    static constexpr bool PERM = true, AFTER_DRAIN = false, PAIRED = false;
    unsigned char* ws; float wscale;
    template <int MODE> __device__ __forceinline__ void body(const f32x4 (&acc)[2][2][4][2], bf16* base, int ld, int ct, float* ss, int ssld, int row0, int cl, int wc, int fq) const {
        const float* RS1 = (const float*)(ws + ST_RS1); float* SMALL = (float*)(ws + ST_SMALL);
        float rsv[2][4];
        EPI_ROWS(ai, m) rsv[ai][m] = RS1[row0 + ai * 128 + m * 16] * wscale;
        EPI_ROWS(ai, m) {
            const int row = row0 + ai * 128 + m * 16; const float rs = rsv[ai][m]; float ssum = 0.f;
#pragma unroll
            for (int bj = 0; bj < 2; ++bj) {
                f32x4 v0 = acc[ai][bj][m][0] * rs, v1 = acc[ai][bj][m][1] * rs;
                if constexpr (MODE == 5) { if (bj == 0 && wc < 3) { GAS f32x4* d = (GAS f32x4*)(SMALL + (size_t)row * 96 + cl); d[0] = v0; d[1] = v1; } }
                else {
                    if constexpr (MODE == 1) { v0 = v0 * GLA_QSCALE; v1 = v1 * GLA_QSCALE; }
                    if constexpr (MODE == 2 || MODE == 3) {
                        f32x4 e0 = v0 * (-1.4426950408889634f), e1 = v1 * (-1.4426950408889634f);
#pragma unroll
                        for (int j = 0; j < 4; ++j) { e0[j] = __builtin_amdgcn_exp2f(e0[j]); e1[j] = __builtin_amdgcn_exp2f(e1[j]); }
                        asm volatile("" : "+v"(e0), "+v"(e1));
                        e0 = e0 + 1.f; e1 = e1 + 1.f;
#pragma unroll
                        for (int j = 0; j < 4; ++j) { e0[j] = __builtin_amdgcn_rcpf(e0[j]); e1[j] = __builtin_amdgcn_rcpf(e1[j]); }
                        asm volatile("" : "+v"(e0), "+v"(e1));
                        if constexpr (MODE == 2) { v0 = v0 * e0; v1 = v1 * e1; } else { v0 = e0; v1 = e1; } }
                    if constexpr (MODE == 4) ssum += dot4(v0) + dot4(v1);
                    st_bf8(base + (size_t)row * ld + ct * 256 + bj * 128 + cl, v0, v1);
                }
            }
            if constexpr (MODE == 4) { ssum += __shfl_xor(ssum, 16); ssum += __shfl_xor(ssum, 32); if (fq == 0) ss[(size_t)row * ssld + ct * 4 + wc] = ssum; }
        }
    }
    __device__ __forceinline__ void operator()(const f32x4 (&acc)[2][2][4][2], const pg8::Unit& u, int wr, int wc, int fr, int fq) const {
        const int pn = u.pn, row0 = u.pm * 256 + wr * 64 + fr, cl = wc * 32 + 8 * fq;
        int mode, ld, ct, ssld = 0; bf16* base = nullptr; float* ss = nullptr; bool xonly = true;
        if (pn < 4) { mode = 1; base = (bf16*)(ws + WS_GQ); ld = 1024; ct = pn; }
        else if (pn < 8) { mode = 0; base = (bf16*)(ws + WS_GK); ld = 1024; ct = pn - 4; xonly = false; }
        else if (pn < 16) { mode = 0; base = (bf16*)(ws + WS_GV); ld = 2048; ct = pn - 8; xonly = false; }
        else if (pn < 24) { mode = 2; base = (bf16*)(ws + WS_GOG); ld = 2048; ct = pn - 16; }
        else if (pn < 28) { mode = 4; base = (bf16*)(ws + WS_CQ); ld = 1024; ct = pn - 24; ss = (float*)(ws + ST_CQSS); ssld = 16; }
        else if (pn < 30) { mode = 4; base = (bf16*)(ws + WS_CKV); ld = 512; ct = pn - 28; ss = (float*)(ws + ST_CKVSS); ssld = 8; xonly = false; }
        else if (pn < 46) { mode = 3; base = (bf16*)(ws + WS_GA); ld = 4096; ct = pn - 30; }
        else if (pn < 62) { mode = 3; base = (bf16*)(ws + WS_GB); ld = 4096; ct = pn - 46; }
        else { mode = 5; ld = 96; ct = 0; xonly = false; }
        if (xonly && u.pm >= 32) return;
        if (mode == 3) body<3>(acc, base, ld, ct, ss, ssld, row0, cl, wc, fq);
        else if (mode == 2) body<2>(acc, base, ld, ct, ss, ssld, row0, cl, wc, fq);
        else if (mode == 0) body<0>(acc, base, ld, ct, ss, ssld, row0, cl, wc, fq);
        else if (mode == 1) body<1>(acc, base, ld, ct, ss, ssld, row0, cl, wc, fq);
        else if (mode == 4) body<4>(acc, base, ld, ct, ss, ssld, row0, cl, wc, fq);
        else body<5>(acc, base, ld, ct, ss, ssld, row0, cl, wc, fq);
    }
};
struct EpiGate {
    static constexpr bool PERM = true, AFTER_DRAIN = false, PAIRED = false;
    unsigned char* ws;
    __device__ __forceinline__ void operator()(const f32x4 (&acc)[2][2][4][2], const pg8::Unit& u, int wr, int wc, int fr, int fq) const {
        const float* RS1 = (const float*)(ws + ST_RS1);
        const int pn = u.pn, row0 = u.pm * 256 + wr * 64 + fr, cl = wc * 32 + 8 * fq;
        bf16* base = (bf16*)(ws + (pn < 46 ? WS_GA : WS_GB)) + (pn < 46 ? pn - 30 : pn - 46) * 256 + cl;
        EPI_ROWS(ai, m) {
            const int row = row0 + ai * 128 + m * 16; const float rs = RS1[row] * (-1.4426950408889634f / F8_WSCALE);
#pragma unroll
            for (int bj = 0; bj < 2; ++bj) {
                f32x4 e0 = acc[ai][bj][m][0] * rs, e1 = acc[ai][bj][m][1] * rs;
#pragma unroll
                for (int j = 0; j < 4; ++j) { e0[j] = __builtin_amdgcn_exp2f(e0[j]); e1[j] = __builtin_amdgcn_exp2f(e1[j]); }
                e0 = e0 + 1.f; e1 = e1 + 1.f;
#pragma unroll
                for (int j = 0; j < 4; ++j) { e0[j] = __builtin_amdgcn_rcpf(e0[j]); e1[j] = __builtin_amdgcn_rcpf(e1[j]); }
                st_bf8(base + (size_t)row * DM + bj * 128, e0, e1);
            }
        }
    }
};
struct EpiQ {
    static constexpr bool PERM = true, AFTER_DRAIN = false, PAIRED = false;
    unsigned char* ws;
    template <bool R0, bool R1> __device__ __forceinline__ void body(const f32x4 (&acc)[2][2][4][2], int row0, int g0, int g1, int fq) const {
        const float* SS = (const float*)(ws + ST_CQSS); const float* COS = (const float*)(ws + ST_COS); const float* SIN = (const float*)(ws + ST_SIN); bf16* QM = (bf16*)(ws + WS_QM);
        const int f0 = (R0 || R1) ? 16 * ((R0 ? g0 : g1) % 6 - 4) + 4 * fq : 4 * fq;
        const int head0 = g0 / 6, gi0 = g0 - 6 * head0, head1 = g1 / 6, gi1 = g1 - 6 * head1;
#pragma unroll
        for (int ai = 0; ai < 2; ++ai) {
            f32x4 ssv[4], cv[4], sv[4];
#pragma unroll
            for (int m = 0; m < 4; ++m) { const int row = row0 + ai * 128 + m * 16; ssv[m] = *(const GAS f32x4*)(SS + (size_t)row * 16 + 4 * fq);
                if (R0 || R1) { cv[m] = *(const GAS f32x4*)(COS + (size_t)(row + NMETA) * 32 + f0); sv[m] = *(const GAS f32x4*)(SIN + (size_t)(row + NMETA) * 32 + f0); } }
            SBAR();
#pragma unroll
            for (int m = 0; m < 4; ++m) {
                const int row = row0 + ai * 128 + m * 16;
                float s = (ssv[m][0] + ssv[m][1]) + (ssv[m][2] + ssv[m][3]);
                s += __shfl_xor(s, 16); s += __shfl_xor(s, 32);
                const float rs = MLA_QSCALE / sqrtf(s * (1.f / QRANK) + EPS);
#pragma unroll
                for (int bj = 0; bj < 2; ++bj) {
                    f32x4 v0 = acc[ai][bj][m][0], v1 = acc[ai][bj][m][1];
                    if ((bj == 0 && R0) || (bj == 1 && R1)) { const f32x4 o1 = v0 * cv[m] - v1 * sv[m], o2 = v0 * sv[m] + v1 * cv[m]; v0 = o1; v1 = o2; }
                    st_bf8(QM + (size_t)row * 3072 + (bj ? head1 : head0) * 192 + (bj ? gi1 : gi0) * 32 + 8 * fq, v0 * rs, v1 * rs);
                }
            }
        }
    }
    __device__ __forceinline__ void operator()(const f32x4 (&acc)[2][2][4][2], const pg8::Unit& u, int wr, int wc, int fr, int fq) const {
        const int row0 = u.pm * 256 + wr * 64 + fr;
        const int g0 = 8 * u.pn + wc, g1 = g0 + 4;
        const bool rope0 = (g0 % 6) >= 4, rope1 = (g1 % 6) >= 4;
        if (rope0) body<true, false>(acc, row0, g0, g1, fq); else if (rope1) body<false, true>(acc, row0, g0, g1, fq); else body<false, false>(acc, row0, g0, g1, fq);
    }
};
struct EpiKV {
    static constexpr bool PERM = true, AFTER_DRAIN = false, PAIRED = false;
    unsigned char* ws;
    __device__ __forceinline__ void operator()(const f32x4 (&acc)[2][2][4][2], const pg8::Unit& u, int wr, int wc, int fr, int fq) const {
        const float* SS = (const float*)(ws + ST_CKVSS); bf16* KF = (bf16*)(ws + WS_KF); bf16* VB = (bf16*)(ws + WS_VB);
        const int row0 = u.pm * 256 + wr * 64 + fr, cl = wc * 32 + 8 * fq;
        f32x4 t0[2][4], t1[2][4];
        EPI_ROWS(ai, m) { const int row = row0 + ai * 128 + m * 16; t0[ai][m] = *(const GAS f32x4*)(SS + (size_t)row * 8); t1[ai][m] = *(const GAS f32x4*)(SS + (size_t)row * 8 + 4); }
        EPI_ROWS(ai, m) {
            const int row = row0 + ai * 128 + m * 16;
            const float s = ((t0[ai][m][0] + t0[ai][m][1]) + (t0[ai][m][2] + t0[ai][m][3])) + ((t1[ai][m][0] + t1[ai][m][1]) + (t1[ai][m][2] + t1[ai][m][3]));
            const float rs = 1.f / sqrtf(s * (1.f / KVRANK) + EPS);
            st_bf8(KF + (size_t)row * 3072 + u.pn * 192 + cl, acc[ai][0][m][0] * rs, acc[ai][0][m][1] * rs);
            st_bf8(VB + (size_t)row * 2048 + u.pn * 128 + cl, acc[ai][1][m][0] * rs, acc[ai][1][m][1] * rs);
        }
    }
};
struct EpiGla {
    static constexpr bool PERM = true, AFTER_DRAIN = false, PAIRED = false;
    unsigned char* ws;
    __device__ __forceinline__ void operator()(const f32x4 (&acc)[2][2][4][2], const pg8::Unit& u, int wr, int wc, int fr, int fq) const {
        const bf16* GA = (const bf16*)(ws + WS_GA); bf16* MG = (bf16*)(ws + WS_MERGED);
        const int row0 = u.pm * 256 + wr * 64 + fr, col0 = u.pn * 256 + wc * 32 + 8 * fq;
        u32x4 gv[2][4][2];
        EPI_ROWS(ai, m) { const size_t ro = (size_t)(row0 + ai * 128 + m * 16) * DM + col0; gv[ai][m][0] = *(const GAS u32x4*)(GA + ro); gv[ai][m][1] = *(const GAS u32x4*)(GA + ro + 128); }
        EPI_ROWS(ai, m) {
            const size_t ro = (size_t)(row0 + ai * 128 + m * 16) * DM + col0;
#pragma unroll
            for (int bj = 0; bj < 2; ++bj) { const u32x4 w = gv[ai][m][bj];
                const f32x4 g0 = (f32x4){bflo(w.x), bfhi(w.x), bflo(w.y), bfhi(w.y)}, g1 = (f32x4){bflo(w.z), bfhi(w.z), bflo(w.w), bfhi(w.w)};
                st_bf8(MG + ro + bj * 128, acc[ai][bj][m][0] * g0, acc[ai][bj][m][1] * g1); }
        }
    }
};
struct EpiMla {
    static constexpr bool PERM = true, AFTER_DRAIN = false, PAIRED = false;
    unsigned char* ws;
    __device__ __forceinline__ void operator()(const f32x4 (&acc)[2][2][4][2], const pg8::Unit& u, int wr, int wc, int fr, int fq) const {
        const bf16* GB = (const bf16*)(ws + WS_GB); bf16* MG = (bf16*)(ws + WS_MERGED);
        const int row0 = u.pm * 256 + wr * 64 + fr, col0 = u.pn * 256 + wc * 32 + 8 * fq;
#pragma unroll
        for (int ai = 0; ai < 2; ++ai) {
            u32x4 gv[4][2], pv[4][2];
#pragma unroll
            for (int m = 0; m < 4; ++m) { const size_t ro = (size_t)(row0 + ai * 128 + m * 16) * DM + col0;
                gv[m][0] = *(const GAS u32x4*)(GB + ro); gv[m][1] = *(const GAS u32x4*)(GB + ro + 128); pv[m][0] = *(const GAS u32x4*)(MG + ro); pv[m][1] = *(const GAS u32x4*)(MG + ro + 128); }
#pragma unroll
            for (int m = 0; m < 4; ++m) { const size_t ro = (size_t)(row0 + ai * 128 + m * 16) * DM + col0;
#pragma unroll
                for (int bj = 0; bj < 2; ++bj) { const u32x4 w = gv[m][bj], q = pv[m][bj];
                    const f32x4 g0 = (f32x4){bflo(w.x), bfhi(w.x), bflo(w.y), bfhi(w.y)}, g1 = (f32x4){bflo(w.z), bfhi(w.z), bflo(w.w), bfhi(w.w)};
                    const f32x4 p0 = (f32x4){bflo(q.x), bfhi(q.x), bflo(q.y), bfhi(q.y)}, p1 = (f32x4){bflo(q.z), bfhi(q.z), bflo(q.w), bfhi(q.w)};
                    st_bf8(MG + ro + bj * 128, p0 + acc[ai][bj][m][0] * g0, p1 + acc[ai][bj][m][1] * g1); } }
        }
    }
};
struct EpiWo {
    static constexpr bool PERM = true, AFTER_DRAIN = false, PAIRED = false;
    unsigned char* ws; const float* x; float* out;
    __device__ __forceinline__ void operator()(const f32x4 (&acc)[2][2][4][2], const pg8::Unit& u, int wr, int wc, int fr, int fq) const {
        bf16* H1B = (bf16*)(ws + WS_H1B); float* SS = (float*)(ws + ST_H1SS); const bf16* XB = (const bf16*)(ws + WS_H0B);
        const int row0 = u.pm * 256 + wr * 64 + fr, col0 = u.pn * 256 + wc * 32 + 8 * fq;
        u32x4 xv[2][4][2];
        EPI_ROWS(ai, m) { const size_t ro = (size_t)(row0 + ai * 128 + m * 16) * DM + col0; xv[ai][m][0] = *(const GAS u32x4*)(XB + ro); xv[ai][m][1] = *(const GAS u32x4*)(XB + ro + 128); }
        EPI_ROWS(ai, m) { const int row = row0 + ai * 128 + m * 16; const size_t ro = (size_t)row * DM + col0; float ssum = 0.f;
#pragma unroll
            for (int bj = 0; bj < 2; ++bj) { const u32x4 w = xv[ai][m][bj];
                const f32x4 x0 = (f32x4){bflo(w.x), bfhi(w.x), bflo(w.y), bfhi(w.y)}, x1 = (f32x4){bflo(w.z), bfhi(w.z), bflo(w.w), bfhi(w.w)};
                const f32x4 v0 = x0 + acc[ai][bj][m][0], v1 = x1 + acc[ai][bj][m][1];
                st_bf8(H1B + ro + bj * 128, v0, v1); ssum += dot4(v0) + dot4(v1);
            }
            ssum += __shfl_xor(ssum, 16); ssum += __shfl_xor(ssum, 32); if (fq == 0) SS[(size_t)row * 64 + u.pn * 4 + wc] = ssum; }
    }
};
constexpr int LDS_RSTAB = 131072;
struct EpiFF1 {
    static constexpr bool PERM = true, AFTER_DRAIN = false, PAIRED = false;
    unsigned char* ws; LAS unsigned char* lds; int pm0;
    __device__ __forceinline__ void operator()(const f32x4 (&acc)[2][2][4][2], const pg8::Unit& u, int wr, int wc, int fr, int fq) const {
        const float* SS = (const float*)(ws + ST_H1SS); bf16* U = (bf16*)(ws + WS_U);
        const int row0 = u.pm * 256 + wr * 64 + fr, col0 = u.pn * 256 + wc * 32 + 8 * fq;
        float rsv[2][4];
        if (u.pm == pm0) { const LAS float* T = (const LAS float*)(lds + LDS_RSTAB) + wr * 64 + fr; EPI_ROWS(ai, m) rsv[ai][m] = T[ai * 128 + m * 16]; }
        else {
            EPI_ROWS(ai, m) { const float* p = SS + (size_t)(row0 + ai * 128 + m * 16) * 64 + 16 * fq;
                const f32x4 a = *(const GAS f32x4*)p, b = *(const GAS f32x4*)(p + 4), c = *(const GAS f32x4*)(p + 8), d = *(const GAS f32x4*)(p + 12);
                float s = (((a[0] + a[1]) + (a[2] + a[3])) + ((b[0] + b[1]) + (b[2] + b[3]))) + (((c[0] + c[1]) + (c[2] + c[3])) + ((d[0] + d[1]) + (d[2] + d[3])));
                s += __shfl_xor(s, 16); s += __shfl_xor(s, 32); rsv[ai][m] = 1.f / sqrtf(s * (1.f / DM) + EPS); }
        }
        EPI_ROWS(ai, m) {
            const int row = row0 + ai * 128 + m * 16; const float rs = rsv[ai][m];
#pragma unroll
            for (int bj = 0; bj < 2; ++bj) { f32x4 v0 = acc[ai][bj][m][0] * rs, v1 = acc[ai][bj][m][1] * rs;
#pragma unroll
                for (int j = 0; j < 4; ++j) { const float a = fmaxf(v0[j], 0.f), b = fmaxf(v1[j], 0.f); v0[j] = a * a; v1[j] = b * b; }
                st_bf8(U + (size_t)row * LDU + col0 + bj * 128, v0, v1); }
        }
    }
};
__device__ __forceinline__ void ff1_rs_table(const unsigned char* ws, LAS unsigned char* lds, int pm0, int tid) {
    const float* SS = (const float*)(ws + ST_H1SS) + (size_t)(pm0 * 256 + (tid >> 1)) * 64 + 32 * (tid & 1);
    float s = 0.f;
#pragma unroll
    for (int q = 0; q < 8; ++q) { const f32x4 a = *(const GAS f32x4*)(SS + 4 * q); s += (a[0] + a[1]) + (a[2] + a[3]); }
    s += __shfl_xor(s, 1);
    if ((tid & 1) == 0) ((LAS float*)(lds + LDS_RSTAB))[tid >> 1] = 1.f / sqrtf(s * (1.f / DM) + EPS);
    __syncthreads();
}
struct EpiFF2 {
    static constexpr bool PERM = true, AFTER_DRAIN = false, PAIRED = false;
    unsigned char* ws; float* out;
    __device__ __forceinline__ void operator()(const f32x4 (&acc)[2][2][4][2], const pg8::Unit& u, int wr, int wc, int fr, int fq) const {
        float* SS = (float*)(ws + ST_H2SS); const bf16* H1B = (const bf16*)(ws + WS_H1B);
        const int row0 = u.pm * 256 + wr * 64 + fr, col0 = u.pn * 256 + wc * 32 + 8 * fq;
        u32x4 hv[2][4][2];
        EPI_ROWS(ai, m) { const size_t ro = (size_t)(row0 + ai * 128 + m * 16) * DM + col0; hv[ai][m][0] = *(const GAS u32x4*)(H1B + ro); hv[ai][m][1] = *(const GAS u32x4*)(H1B + ro + 128); }
        EPI_ROWS(ai, m) {
            const int row = row0 + ai * 128 + m * 16; const size_t ro = (size_t)row * DM + col0; float ssum = 0.f;
#pragma unroll
            for (int bj = 0; bj < 2; ++bj) { const u32x4 w = hv[ai][m][bj];
                const f32x4 h0 = (f32x4){bflo(w.x), bfhi(w.x), bflo(w.y), bfhi(w.y)}, h1 = (f32x4){bflo(w.z), bfhi(w.z), bflo(w.w), bfhi(w.w)};
                const f32x4 v0 = h0 + acc[ai][bj][m][0], v1 = h1 + acc[ai][bj][m][1];
                st_bf8((bf16*)(ws + WS_H1B) + ro + bj * 128, v0, v1); ssum += dot4(v0) + dot4(v1);
            }
            ssum += __shfl_xor(ssum, 16); ssum += __shfl_xor(ssum, 32); if (fq == 0) SS[(size_t)row * 64 + u.pn * 4 + wc] = ssum;
        }
    }
};
struct EpiNull {
    static constexpr bool PERM = true, AFTER_DRAIN = false, PAIRED = false;
    unsigned char* ws;
    __device__ __forceinline__ void operator()(const f32x4 (&acc)[2][2][4][2], const pg8::Unit& u, int wr, int wc, int fr, int fq) const {
        float s = 0.f;
        EPI_ROWS(ai, m) {
#pragma unroll
            for (int bj = 0; bj < 2; ++bj) s += dot4(acc[ai][bj][m][0]) + dot4(acc[ai][bj][m][1]); }
        if (s == 1234567.125f) ((float*)(ws + ST_H2SS))[0] = s;
    }
};

struct PairOrder {
    pg8::StaticOrder so;
    __device__ void init(int M, int N, int G_, int c_) { so.init(M, N, G_, c_); }
    __device__ __forceinline__ bool next(int i, pg8::Unit& u) const { const bool ok = so.next(i >> 1, u); u.sel = i & 1; return ok; }
    __device__ __forceinline__ void a_ready(const pg8::Unit&) const {}
    __device__ __forceinline__ void done(const pg8::Unit&) const {}
};
struct EpiMerged {
    static constexpr bool PERM = true, AFTER_DRAIN = false, PAIRED = true;
    unsigned char* ws;
    static __device__ __forceinline__ void unpack(const u32x4 w, f32x4& a, f32x4& b) { a = (f32x4){bflo(w.x), bfhi(w.x), bflo(w.y), bfhi(w.y)}; b = (f32x4){bflo(w.z), bfhi(w.z), bflo(w.w), bfhi(w.w)}; }
    __device__ __forceinline__ void mid(f32x4 (&acc)[2][2][4][2], const pg8::Unit& u, int wr, int wc, int fr, int fq) const {
        const bf16* GA = (const bf16*)(ws + WS_GA); const bf16* GB = (const bf16*)(ws + WS_GB);
        const int row0 = u.pm * 256 + wr * 64 + fr, col0 = u.pn * 256 + wc * 32 + 8 * fq;
#pragma unroll
        for (int ai = 0; ai < 2; ++ai) {
            u32x4 av[4][2], bv[4][2];
#pragma unroll
            for (int m = 0; m < 4; ++m) { const size_t ro = (size_t)(row0 + ai * 128 + m * 16) * DM + col0;
                av[m][0] = *(const GAS u32x4*)(GA + ro); av[m][1] = *(const GAS u32x4*)(GA + ro + 128); bv[m][0] = *(const GAS u32x4*)(GB + ro); bv[m][1] = *(const GAS u32x4*)(GB + ro + 128); }
#pragma unroll
            for (int m = 0; m < 4; ++m)
#pragma unroll
                for (int bj = 0; bj < 2; ++bj) { f32x4 a0, a1, b0, b1; unpack(av[m][bj], a0, a1); unpack(bv[m][bj], b0, b1);
#pragma unroll
                    for (int j = 0; j < 4; ++j) { acc[ai][bj][m][0][j] *= a0[j] * __builtin_amdgcn_rcpf(fmaxf(b0[j], 1e-6f)); acc[ai][bj][m][1][j] *= a1[j] * __builtin_amdgcn_rcpf(fmaxf(b1[j], 1e-6f)); } }
        }
    }
    __device__ __forceinline__ void operator()(const f32x4 (&acc)[2][2][4][2], const pg8::Unit& u, int wr, int wc, int fr, int fq) const {
        const bf16* GB = (const bf16*)(ws + WS_GB); bf16* MG = (bf16*)(ws + WS_MERGED);
        const int row0 = u.pm * 256 + wr * 64 + fr, col0 = u.pn * 256 + wc * 32 + 8 * fq;
        u32x4 bv[2][4][2];
        EPI_ROWS(ai, m) { const size_t ro = (size_t)(row0 + ai * 128 + m * 16) * DM + col0; bv[ai][m][0] = *(const GAS u32x4*)(GB + ro); bv[ai][m][1] = *(const GAS u32x4*)(GB + ro + 128); }
        EPI_ROWS(ai, m) { const size_t ro = (size_t)(row0 + ai * 128 + m * 16) * DM + col0;
#pragma unroll
            for (int bj = 0; bj < 2; ++bj) { f32x4 b0, b1; unpack(bv[ai][m][bj], b0, b1);
#pragma unroll
                for (int j = 0; j < 4; ++j) { b0[j] = fmaxf(b0[j], 1e-6f); b1[j] = fmaxf(b1[j], 1e-6f); }
                st_bf8(MG + ro + bj * 128, acc[ai][bj][m][0] * b0, acc[ai][bj][m][1] * b1); } }
    }
};
__device__ __forceinline__ int gla_row(int c, int t) { return c == 0 ? (t < 48 ? -1 : SEQ + (t - 48)) : 64 * (c - 1) + t; }

struct GateW { float Wf[16], Wb[16], biasf, biasb; };
__device__ __forceinline__ void gate_lg(const GateW& w, const LAS float* GL, int t, bool valid, float& lgf, float& lgb) {
    float zf = w.biasf, zb = w.biasb;
#pragma unroll
    for (int q = 0; q < 4; ++q) { const f32x4 gf = *(const LAS f32x4*)(GL + t * 32 + 4 * q), gb = *(const LAS f32x4*)(GL + t * 32 + 16 + 4 * q);
#pragma unroll
        for (int j = 0; j < 4; ++j) { zf = fmaf(gf[j], w.Wf[4 * q + j], zf); zb = fmaf(gb[j], w.Wb[4 * q + j], zb); } }
    lgf = valid ? logsig16(zf) : 0.f; lgb = valid ? logsig16(zb) : 0.f;
}
struct GateTot { float offF, F63, sumB, offR, R0; };
__device__ __forceinline__ void gates_begin(GateW& w, GateTot& T, const unsigned char* ws, const float* wf, const float* bfv, const float* wb, const float* bbv, int c, int h, LAS unsigned char* lds, int tid) {
    const float* SMALL = (const float*)(ws + ST_SMALL);
    LAS float* GL = (LAS float*)lds; LAS float* TOT = (LAS float*)(lds + 8192);
    { const int t = tid >> 3, part = tid & 7, row = gla_row(c, t);
      f32x4 v = (f32x4){0.f, 0.f, 0.f, 0.f}; if (row >= 0) v = *(const GAS f32x4*)(SMALL + (size_t)row * 96 + 64 + 4 * part);
      *(LAS f32x4*)(GL + t * 32 + 4 * part) = v; }
    const int d = tid & 127, tq = tid >> 7, col = h * 128 + d;
#pragma unroll
    for (int r = 0; r < 16; ++r) { w.Wf[r] = wf[r * 1024 + col]; w.Wb[r] = wb[r * 1024 + col]; }
    w.biasf = bfv[col]; w.biasb = bbv[col];
    __syncthreads();
    float sF = 0.f, sB = 0.f;
#pragma unroll 2
    for (int i = 0; i < 16; ++i) { const int t = 16 * tq + i; float lf, lb; gate_lg(w, GL, t, gla_row(c, t) >= 0, lf, lb); sF += lf; sB += lb; }
    TOT[tq * 128 + d] = sF; TOT[512 + tq * 128 + d] = sB;
    __syncthreads();
    float offF = 0.f, offR = 0.f, totF = 0.f, totR = 0.f;
#pragma unroll
    for (int q = 0; q < 4; ++q) { const float a = TOT[q * 128 + d], b = TOT[512 + q * 128 + d]; totF += a; totR += b; if (q < tq) offF += a; if (q > tq) offR += b; }
    T.offF = offF; T.F63 = totF; T.sumB = sB; T.offR = offR; T.R0 = totR;
}
struct GlaW { const float *wf, *bf, *wb, *bb, *gnorm; };
__device__ __forceinline__ void stage_tile(LAS bf16* dst, const bf16* src, int ld, int col0, int c, int tid) {
#pragma unroll
    for (int k = 0; k < 2; ++k) { const int idx = tid + 512 * k, t = idx >> 4, ch = idx & 15, row = gla_row(c, t);
        u32x4 v = (u32x4){0u, 0u, 0u, 0u}; if (row >= 0) v = *(const GAS u32x4*)(src + (size_t)row * ld + col0 + 8 * ch);
        *(LAS u32x4*)(dst + t * 128 + 8 * ch) = v; }
}
constexpr int PA_K = 16384, PA_KTF = 32768, PA_KTB = PA_KTF + 128 * 132, PA_LG = PA_KTB + 128 * 132, PA_VS = PA_LG, PA_VSS = 264;
static_assert(PA_LG + 2 * 64 * 128 * 4 <= LDS_CTL && PA_VS + 64 * PA_VSS * 2 <= LDS_CTL, "pass A LDS");
__device__ __forceinline__ void gla_pass_a(unsigned char* ws, const GlaW& gw, LAS unsigned char* lds, int tid, int G, int bid, float* LG) {
    const bf16* GK = (const bf16*)(ws + WS_GK); const bf16* GV = (const bf16*)(ws + WS_GV); const float* SMALL = (const float*)(ws + ST_SMALL);
    bf16* KHTF = (bf16*)(ws + WS_KHTF); bf16* KHTB = (bf16*)(ws + WS_KHTB); bf16* VT = (bf16*)(ws + WS_VT);
    float* DLF = (float*)(ws + ST_DLF); float* DLB = (float*)(ws + ST_DLB);
    LAS float* GL = (LAS float*)lds; LAS float* TOT = (LAS float*)(lds + 8192); LAS bf16* KS = (LAS bf16*)(lds + PA_K); LAS bf16* KTF = (LAS bf16*)(lds + PA_KTF); LAS bf16* KTB = (LAS bf16*)(lds + PA_KTB);
    LAS float* LGC = (LAS float*)(lds + PA_LG); LAS bf16* VS = (LAS bf16*)(lds + PA_VS);
    const int nmine = (NXC * GH - bid + G - 1) / G + ((bid >= 16 && bid < 16 + GH) ? 1 : 0);
    for (int k = 0; k < nmine; ++k) {
        const int u = bid + k * G; const bool meta = u >= NXC * GH;
        const int c = meta ? 0 : 1 + (u >> 3), h = meta ? bid - 16 : (u & 7);
        const int d = tid & 127, tq = tid >> 7, col = h * 128 + d;
        __syncthreads();
        u32x4 vreg[4];
#pragma unroll
        for (int q = 0; q < 4; ++q) { const int idx = tid + 512 * q, t = idx >> 5, ch = idx & 31, row = gla_row(c, t);
            vreg[q] = (u32x4){0u, 0u, 0u, 0u}; if (row >= 0) vreg[q] = *(const GAS u32x4*)(GV + (size_t)row * 2048 + h * 256 + 8 * ch); }
        stage_tile(KS, GK, 1024, h * 128, c, tid);
        { const int t = tid >> 3, part = tid & 7, row = gla_row(c, t);
          f32x4 v = (f32x4){0.f, 0.f, 0.f, 0.f}; if (row >= 0) v = *(const GAS f32x4*)(SMALL + (size_t)row * 96 + 64 + 4 * part);
          *(LAS f32x4*)(GL + t * 32 + 4 * part) = v; }
        GateW w;
#pragma unroll
        for (int r = 0; r < 16; ++r) { w.Wf[r] = gw.wf[r * 1024 + col]; w.Wb[r] = gw.wb[r * 1024 + col]; }
        w.biasf = gw.bf[col]; w.biasb = gw.bb[col];
        __syncthreads();
        float sF = 0.f, sB = 0.f;
#pragma unroll 2
        for (int i = 0; i < 16; ++i) { const int t = 16 * tq + i, row = gla_row(c, t); float lf, lb; gate_lg(w, GL, t, row >= 0, lf, lb); sF += lf; sB += lb;
            LGC[t * 128 + d] = lf; LGC[8192 + t * 128 + d] = lb;
            if (c >= 1) { LG[(size_t)row * 1024 + col] = lf; LG[(size_t)SEQ * 1024 + (size_t)row * 1024 + col] = lb; } }
        TOT[tq * 128 + d] = sF; TOT[512 + tq * 128 + d] = sB;
        __syncthreads();
        float offF = 0.f, offR = 0.f, F63 = 0.f, R0 = 0.f;
#pragma unroll
        for (int q = 0; q < 4; ++q) { const float a = TOT[q * 128 + d], b2 = TOT[512 + q * 128 + d]; F63 += a; R0 += b2; if (q < tq) offF += a; if (q > tq) offR += b2; }
        { float runF = offF, runB = 0.f;
#pragma unroll 4
          for (int i = 0; i < 16; ++i) { const int t = 16 * tq + i; const float lf = LGC[t * 128 + d], lb = LGC[8192 + t * 128 + d];
              runF += lf; const float R = offR + (sB - runB); runB += lb;
              const float kv = bf2f(KS[t * 128 + d]);
              KTF[d * 66 + t] = f2bf(kv * __expf(F63 - runF)); KTB[d * 66 + t] = f2bf(kv * __expf(R0 - R)); } }
        if (tq == 0) { DLF[(size_t)(c * GH + h) * 128 + d] = __expf(F63); if (c >= 1) DLB[(size_t)((c - 1) * GH + h) * 128 + d] = __expf(R0); }
        __syncthreads();
#pragma unroll
        for (int q = 0; q < 4; ++q) { const int idx = tid + 512 * q, t = idx >> 5, ch = idx & 31; *(LAS u32x4*)(VS + t * PA_VSS + 8 * ch) = vreg[q]; }
        { GAS unsigned* of = (GAS unsigned*)(KHTF + (size_t)(c * GH + h) * 128 * 64); GAS unsigned* ob = (GAS unsigned*)(KHTB + (size_t)((c > 0 ? c - 1 : 0) * GH + h) * 128 * 64);
#pragma unroll
          for (int q = 0; q < 8; ++q) { const int idx = tid + 512 * q, dd = idx >> 5, dw = idx & 31;
              of[idx] = *(const LAS unsigned*)(KTF + dd * 66 + 2 * dw); if (c >= 1) ob[idx] = *(const LAS unsigned*)(KTB + dd * 66 + 2 * dw); } }
        __syncthreads();
        { const int e = tid & 255, th = tid >> 8; unsigned pv[16];
#pragma unroll
          for (int i = 0; i < 32; i += 2) { const unsigned a = VS[(32 * th + i) * PA_VSS + e], b2 = VS[(32 * th + i + 1) * PA_VSS + e]; pv[i >> 1] = a | (b2 << 16); }
          GAS u32x4* o = (GAS u32x4*)(VT + ((size_t)(c * GH + h) * 256 + e) * 64 + 32 * th);
#pragma unroll
          for (int q = 0; q < 4; ++q) o[q] = (u32x4){pv[4 * q], pv[4 * q + 1], pv[4 * q + 2], pv[4 * q + 3]}; }
    }
}
__device__ __forceinline__ void gla_chain(unsigned char* ws, int bid, int G, int wave, int lane) {
    const bf16* KHTF = (const bf16*)(ws + WS_KHTF); const bf16* KHTB = (const bf16*)(ws + WS_KHTB); const bf16* VT = (const bf16*)(ws + WS_VT);
    const float* DLF = (const float*)(ws + ST_DLF); const float* DLB = (const float*)(ws + ST_DLB); bf16* SNAP = (bf16*)(ws + WS_SNAP);
    const int r32 = lane & 31, hi = lane >> 5;
    for (int wc = bid * 2 + wave; wc < 512; wc += G * 2) {
        const int dir = wc >> 8, h = (wc >> 5) & 7, e0 = 32 * ((wc >> 2) & 7), d0 = 32 * (wc & 3);
        f32x16 S = {};
        bf16* snap = SNAP + (size_t)dir * 128 * GH * 256 * 128 + ((size_t)h * 256 + e0 + r32) * 128 + d0 + 4 * hi;
        const bf16* khb = (dir == 0 ? KHTF : KHTB) + ((size_t)h * 128 + d0 + r32) * 64 + 8 * hi;
        const bf16* vtb = VT + ((size_t)h * 256 + e0 + r32) * 64 + 8 * hi;
        const float* dlb = (dir == 0 ? DLF : DLB) + (size_t)h * 128 + d0 + 4 * hi;
        constexpr int PD = 3;
        bf16x8 A[PD][4], B[PD][4]; f32x4 DV[PD][4];
#define CH_LOAD(slot, s_) do { const int kc_ = dir == 0 ? (s_) : 127 - (s_), vc_ = dir == 0 ? (s_) : 128 - (s_); \
            const bf16* kh_ = khb + (size_t)kc_ * (GH * 128 * 64); const bf16* vt_ = vtb + (size_t)vc_ * (GH * 256 * 64); const float* dl_ = dlb + (size_t)kc_ * (GH * 128); \
            _Pragma("unroll") for (int q_ = 0; q_ < 4; ++q_) { A[slot][q_] = *(const GAS bf16x8*)(kh_ + 16 * q_); B[slot][q_] = *(const GAS bf16x8*)(vt_ + 16 * q_); DV[slot][q_] = *(const GAS f32x4*)(dl_ + 8 * q_); } } while (0)
#define CH_STORE(xc_) do { bf16* sp_ = snap + (size_t)(xc_) * (GH * 256 * 128); \
            _Pragma("unroll") for (int g_ = 0; g_ < 4; ++g_) *(GAS u32x2*)(sp_ + 8 * g_) = (u32x2){cvtpk(S[4 * g_], S[4 * g_ + 1]), cvtpk(S[4 * g_ + 2], S[4 * g_ + 3])}; } while (0)
#pragma unroll
        for (int p = 0; p < PD; ++p) CH_LOAD(p, p);
        if (dir == 1) CH_STORE(127);
        for (int sb = 0; sb < 129; sb += PD) {
#pragma unroll
            for (int p = 0; p < PD; ++p) {
                const int s = sb + p;
                if (s < 128) {
#pragma unroll
                    for (int g = 0; g < 4; ++g) { S[4 * g] *= DV[p][g][0]; S[4 * g + 1] *= DV[p][g][1]; S[4 * g + 2] *= DV[p][g][2]; S[4 * g + 3] *= DV[p][g][3]; }
#pragma unroll
                    for (int q = 0; q < 4; ++q) S = __builtin_amdgcn_mfma_f32_32x32x16_bf16(A[p][q], B[p][q], S, 0, 0, 0);
                    if (s + PD < 128) CH_LOAD(p, s + PD);
                    if (dir == 0) CH_STORE(s); else if (s < 127) CH_STORE(126 - s);
                }
            }
        }
#undef CH_LOAD
#undef CH_STORE
    }
}
__device__ __forceinline__ int crow(int r, int hi) { return (r & 3) + 8 * (r >> 2) + 4 * hi; }
constexpr int PC_OPS = 16384, PC_OPB = 64 * 272, PC_ATT = PC_OPS + 6 * PC_OPB, PC_ATTB = 64 * 144, PC_END = PC_ATT + 2 * PC_ATTB;
constexpr int PC_STK = PC_ATT, PC_STQ = PC_STK + 16384;
constexpr int PC_OT = PC_OPS, PC_OTS = 260;
static_assert(PC_END <= LDS_CTL && PC_STQ + 16384 <= LDS_CTL && PC_OT + 64 * PC_OTS * 4 <= PC_ATT, "pass C LDS");
template <int PV> __device__ __forceinline__ void gla_pass_c(unsigned char* ws, const GlaW& gw, LAS unsigned char* lds, int tid, int G, int bid, bf16* AGout, const float* LG) {
    const bf16* GQ = (const bf16*)(ws + WS_GQ); const bf16* GK = (const bf16*)(ws + WS_GK); const bf16* GOG = (const bf16*)(ws + WS_GOG);
    const bf16* VT = (const bf16*)(ws + WS_VT); const bf16* SNAP = (const bf16*)(ws + WS_SNAP); bf16* AG = AGout;
    const int wave = __builtin_amdgcn_readfirstlane(tid >> 6), lane = tid & 63, r32 = lane & 31, hi = lane >> 5;
#define PC_OP(i) ((LAS bf16*)(lds + PC_OPS + (i) * PC_OPB))
#define PC_AT(i) ((LAS bf16*)(lds + PC_ATT + (i) * PC_ATTB))
    for (int u = bid; u < NXC * GH; u += G) {
        const int xc = u >> 3, h = u & 7, c = xc + 1, e0 = 32 * wave;
        __syncthreads();
        const int d = tid & 127, tq = tid >> 7;
        float lgf[16], lgb[16];
        { const float* lp = LG + (size_t)(64 * xc + 16 * tq) * 1024 + h * 128 + d;
#pragma unroll
          for (int i = 0; i < 16; ++i) { lgf[i] = lp[(size_t)i * 1024]; lgb[i] = lp[(size_t)SEQ * 1024 + (size_t)i * 1024]; } }
        stage_tile((LAS bf16*)(lds + PC_STK), GK, 1024, h * 128, c, tid); stage_tile((LAS bf16*)(lds + PC_STQ), GQ, 1024, h * 128, c, tid);
        LAS float* TOT = (LAS float*)(lds + 8192);
#pragma unroll
        for (int i = 1; i < 16; ++i) lgf[i] += lgf[i - 1];
#pragma unroll
        for (int i = 14; i >= 0; --i) lgb[i] += lgb[i + 1];
        TOT[tq * 128 + d] = lgf[15]; TOT[512 + tq * 128 + d] = lgb[0];
        __syncthreads();
        { float offF = 0.f, offR = 0.f, F63 = 0.f, R0 = 0.f;
#pragma unroll
          for (int q = 0; q < 4; ++q) { const float a = TOT[q * 128 + d], b2 = TOT[512 + q * 128 + d]; F63 += a; R0 += b2; if (q < tq) offF += a; if (q > tq) offR += b2; }
          const LAS bf16* KS = (const LAS bf16*)(lds + PC_STK); const LAS bf16* QS = (const LAS bf16*)(lds + PC_STQ);
          const float dF = __expf(F63), dR = __expf(R0);
#pragma unroll
          for (int i = 0; i < 16; ++i) { const int t = 16 * tq + i; const float F = lgf[i] + offF, R = lgb[i] + offR;
              const float q = bf2f(QS[t * 128 + d]), kv = bf2f(KS[t * 128 + d]);
              const float ef = __expf(F - F63), er = __expf(R - R0), qf = q * ef, qr2 = q * er;
              PC_OP(0)[t * 136 + d] = f2bf(qf); PC_OP(1)[t * 136 + d] = f2bf(kv * __builtin_amdgcn_rcpf(ef)); PC_OP(4)[t * 136 + d] = f2bf(qf * dF);
              PC_OP(2)[t * 136 + d] = f2bf(qr2); PC_OP(3)[t * 136 + d] = f2bf(kv * __builtin_amdgcn_rcpf(er)); PC_OP(5)[t * 136 + d] = f2bf(qr2 * dR); } }
        __syncthreads();
        bf16x8 sfr[2][8], vfr[4];
#pragma unroll
        for (int dir = 0; dir < 2; ++dir) { const bf16* sp = SNAP + (size_t)dir * 128 * GH * 256 * 128 + ((size_t)(xc * GH + h) * 256 + e0 + r32) * 128 + 8 * hi;
#pragma unroll
            for (int ks = 0; ks < 8; ++ks) sfr[dir][ks] = *(const GAS bf16x8*)(sp + 16 * ks); }
        { const bf16* vp = VT + ((size_t)(c * GH + h) * 256 + e0 + r32) * 64 + 8 * hi;
#pragma unroll
          for (int ks = 0; ks < 4; ++ks) vfr[ks] = *(const GAS bf16x8*)(vp + 16 * ks); }
        { const int dirw = wave >> 2, ti = (wave >> 1) & 1, sj = wave & 1;
          f32x16 a = {};
          const bool live = dirw == 0 ? sj <= ti : sj >= ti;
          if (live) {
              const LAS bf16* QH = PC_OP(2 * dirw) + (32 * ti + r32) * 136 + 8 * hi; const LAS bf16* KH = PC_OP(2 * dirw + 1) + (32 * sj + r32) * 136 + 8 * hi;
#pragma unroll
              for (int ks = 0; ks < 8; ++ks) a = __builtin_amdgcn_mfma_f32_32x32x16_bf16(*(const LAS bf16x8*)(QH + 16 * ks), *(const LAS bf16x8*)(KH + 16 * ks), a, 0, 0, 0);
          }
          LAS bf16* AT = PC_AT(dirw);
#pragma unroll
          for (int r = 0; r < 16; ++r) { const int t = 32 * ti + crow(r, hi), s2 = 32 * sj + r32; const bool keep = dirw == 0 ? s2 <= t : s2 >= t; AT[t * 72 + s2] = f2bf(keep ? a[r] : 0.f); } }
        __syncthreads();
        f32x16 o0 = {}, o1 = {};
#pragma unroll
        for (int dir = 0; dir < 2; ++dir) {
            const LAS bf16* QT = PC_OP(4 + dir) + r32 * 136 + 8 * hi;
#pragma unroll
            for (int ks = 0; ks < 8; ++ks) {
                o0 = __builtin_amdgcn_mfma_f32_32x32x16_bf16(*(const LAS bf16x8*)(QT + 16 * ks), sfr[dir][ks], o0, 0, 0, 0);
                o1 = __builtin_amdgcn_mfma_f32_32x32x16_bf16(*(const LAS bf16x8*)(QT + 32 * 136 + 16 * ks), sfr[dir][ks], o1, 0, 0, 0); }
        }
#pragma unroll
        for (int dir = 0; dir < 2; ++dir) { const LAS bf16* AT = PC_AT(dir) + r32 * 72 + 8 * hi;
#pragma unroll
            for (int ks = 0; ks < 4; ++ks) {
                o0 = __builtin_amdgcn_mfma_f32_32x32x16_bf16(*(const LAS bf16x8*)(AT + 16 * ks), vfr[ks], o0, 0, 0, 0);
                o1 = __builtin_amdgcn_mfma_f32_32x32x16_bf16(*(const LAS bf16x8*)(AT + 32 * 72 + 16 * ks), vfr[ks], o1, 0, 0, 0); } }
        __syncthreads();
        { LAS float* OT = (LAS float*)(lds + PC_OT);
#pragma unroll
          for (int r = 0; r < 16; ++r) { OT[crow(r, hi) * PC_OTS + e0 + r32] = o0[r]; OT[(32 + crow(r, hi)) * PC_OTS + e0 + r32] = o1[r]; } }
        __syncthreads();
        { const int t = tid >> 3, j = tid & 7; const LAS float* OT = (const LAS float*)(lds + PC_OT) + t * PC_OTS + 8 * j;
          const size_t ro = (size_t)(64 * xc + t) * 2048 + h * 256 + 8 * j;
          f32x4 v[4][2]; u32x4 gg[4]; float ssq = 0.f;
#pragma unroll
          for (int i = 0; i < 4; ++i) { gg[i] = *(const GAS u32x4*)(GOG + ro + 64 * i); v[i][0] = *(const LAS f32x4*)(OT + 64 * i); v[i][1] = *(const LAS f32x4*)(OT + 64 * i + 4); ssq += dot4(v[i][0]) + dot4(v[i][1]); }
          ssq += __shfl_xor(ssq, 1); ssq += __shfl_xor(ssq, 2); ssq += __shfl_xor(ssq, 4);
          const float rn = 1.f / sqrtf(ssq * (1.f / GDV) + EPS);
#pragma unroll
          for (int i = 0; i < 4; ++i) { const f32x4 g0 = *(const GAS f32x4*)(gw.gnorm + 8 * j + 64 * i), g1 = *(const GAS f32x4*)(gw.gnorm + 8 * j + 64 * i + 4); const u32x4 q = gg[i];
              const f32x4 a0 = (f32x4){bflo(q.x), bfhi(q.x), bflo(q.y), bfhi(q.y)}, a1 = (f32x4){bflo(q.z), bfhi(q.z), bflo(q.w), bfhi(q.w)};
              st_bf8(AG + ro + 64 * i, v[i][0] * rn * g0 * a0, v[i][1] * rn * g1 * a1); } }
    }
#undef PC_OP
#undef PC_AT
}
namespace att {
constexpr int NW = 8, QBLK = 32, KVBLK = 64, NT = 129, LDQ = 3072, LDK = 3072, LDV = 2048, LDO = 2048;
constexpr float THR = 11.5f;
constexpr int SHM_V = KVBLK * 128 * 2, SHM_KN = KVBLK * 128 * 2, SHM_KR = KVBLK * 64 * 2;
constexpr int NBUF = 3, OFF_V = 0, OFF_KN = NBUF * SHM_V, OFF_KR = OFF_KN + NBUF * SHM_KN, OFF_WS = OFF_KR + NBUF * SHM_KR, SHM_ATTN = OFF_WS + NW * 64 * 4;
#define KSWZ(row, colB) ((row) * 256 + ((colB) ^ (((row) & 15) << 4)))
#define KRSWZ(row, chunk) ((row) * 128 + ((((chunk) ^ (((row) >> 1) & 7))) << 4))
constexpr float NEG = -1e30f;
__device__ __forceinline__ void partialSM(f32x16& p0, f32x16& p1, float& m_reg, float& mn, float& alpha) {
    float pmax = p0[0];
#pragma unroll
    for (int r = 1; r < 16; ++r) pmax = fmaxf(pmax, p0[r]);
#pragma unroll
    for (int r = 0; r < 16; ++r) pmax = fmaxf(pmax, p1[r]);
    { auto rr = __builtin_amdgcn_permlane32_swap(__float_as_uint(pmax), __float_as_uint(pmax), false, false);
      pmax = fmaxf(__uint_as_float(rr[0]), __uint_as_float(rr[1])); }
    { const bool keep = __all(pmax - m_reg <= THR);
      const float mx = fmaxf(m_reg, pmax); mn = keep ? m_reg : mx; alpha = keep ? 1.f : __builtin_amdgcn_exp2f(m_reg - mx); m_reg = mn; }
#pragma unroll
    for (int r = 0; r < 16; ++r) p0[r] = p0[r] - mn;
#pragma unroll
    for (int r = 0; r < 16; ++r) p1[r] = p1[r] - mn;
#pragma unroll
    for (int r = 0; r < 16; ++r) p0[r] = __builtin_amdgcn_exp2f(p0[r]);
}
__device__ __forceinline__ void finishSM(f32x16& p0, f32x16& p1, float alpha, float& l_reg, bf16x8& pa0, bf16x8& pa1, bf16x8& pa2, bf16x8& pa3) {
#pragma unroll
    for (int r = 0; r < 16; ++r) p1[r] = __builtin_amdgcn_exp2f(p1[r]);
    float ps = 0;
#pragma unroll
    for (int r = 0; r < 16; ++r) ps += p0[r];
#pragma unroll
    for (int r = 0; r < 16; ++r) ps += p1[r];
    { auto rr = __builtin_amdgcn_permlane32_swap(__float_as_uint(ps), __float_as_uint(ps), false, false);
      ps = __uint_as_float(rr[0]) + __uint_as_float(rr[1]); }
    l_reg = l_reg * alpha + ps;
#define PK4(P, BASE, OUT) do { u32x4 w = {cvtpk(P[BASE + 0], P[BASE + 1]), cvtpk(P[BASE + 2], P[BASE + 3]), cvtpk(P[BASE + 4], P[BASE + 5]), cvtpk(P[BASE + 6], P[BASE + 7])}; \
    OUT = *reinterpret_cast<bf16x8*>(&w); } while (0)
    PK4(p0, 0, pa0); PK4(p0, 8, pa1); PK4(p1, 0, pa2); PK4(p1, 8, pa3);
#undef PK4
}
__device__ __forceinline__ void qkt(f32x16& p0, f32x16& p1, const LAS char* Kn, const LAS char* Kr, const bf16x8* qr, int r32, int hi) {
    p0 = f32x16{}; p1 = f32x16{};
#pragma unroll
    for (int d0 = 0; d0 < 8; ++d0) { const int cb = (d0 * 16 + hi * 8) * 2;
        const bf16x8 b0 = *(const LAS bf16x8*)(Kn + KSWZ(r32, cb)), b1 = *(const LAS bf16x8*)(Kn + KSWZ(32 + r32, cb));
        p0 = __builtin_amdgcn_mfma_f32_32x32x16_bf16(b0, qr[d0], p0, 0, 0, 0);
        p1 = __builtin_amdgcn_mfma_f32_32x32x16_bf16(b1, qr[d0], p1, 0, 0, 0); }
#pragma unroll
    for (int d0 = 0; d0 < 4; ++d0) { const int ch = d0 * 2 + hi;
        const bf16x8 b0 = *(const LAS bf16x8*)(Kr + KRSWZ(r32, ch)), b1 = *(const LAS bf16x8*)(Kr + KRSWZ(32 + r32, ch));
        p0 = __builtin_amdgcn_mfma_f32_32x32x16_bf16(b0, qr[8 + d0], p0, 0, 0, 0);
        p1 = __builtin_amdgcn_mfma_f32_32x32x16_bf16(b1, qr[8 + d0], p1, 0, 0, 0); }
}
template <int MODE> __device__ __forceinline__ void maskp(f32x16& p0, f32x16& p1) {
    if (MODE == 1) {
#pragma unroll
        for (int r = 8; r < 16; ++r) p0[r] = NEG;
    } else {
#pragma unroll
        for (int r = 0; r < 16; ++r) p0[r] = NEG;
    }
#pragma unroll
    for (int r = 0; r < 16; ++r) p1[r] = NEG;
}
__device__ __forceinline__ int v_st(int k, int c) { const int kk = (k & ~0xC) | ((k & 4) << 1) | ((k & 8) >> 1); return ((kk >> 3) * 4 + (c >> 5)) * 512 + ((kk & 7) * 32 + (c & 31)) * 2; }
__device__ __forceinline__ int v_rd_base(int lane) { return ((lane & 3) << 3) | (((lane >> 2) & 3) << 6) | (((lane >> 4) & 1) << 5) | (((lane >> 5) & 1) << 8); }
constexpr int v_rd_off(int d0, int ks, int half) { return d0 * 512 + ks * 4096 + half * 2048; }
template <int OFF> __device__ __forceinline__ s16x4 tr_read(int vb) {
    return __builtin_amdgcn_ds_read_tr16_b64_v4i16((LAS s16x4*)(uintptr_t)(unsigned)(vb + OFF));
}
template <int D0> __device__ __forceinline__ void pv_one(f32x16& od, int vb, bf16x8 pa0, bf16x8 pa1, bf16x8 pa2, bf16x8 pa3) {
    const s16x4 l0 = tr_read<v_rd_off(D0, 0, 0)>(vb), h0 = tr_read<v_rd_off(D0, 0, 1)>(vb), l1 = tr_read<v_rd_off(D0, 1, 0)>(vb), h1 = tr_read<v_rd_off(D0, 1, 1)>(vb);
    const s16x4 l2 = tr_read<v_rd_off(D0, 2, 0)>(vb), h2 = tr_read<v_rd_off(D0, 2, 1)>(vb), l3 = tr_read<v_rd_off(D0, 3, 0)>(vb), h3 = tr_read<v_rd_off(D0, 3, 1)>(vb);
#define PK(L, H) (bf16x8){L[0], L[1], L[2], L[3], H[0], H[1], H[2], H[3]}
    od = __builtin_amdgcn_mfma_f32_32x32x16_bf16(pa0, PK(l0, h0), od, 0, 0, 0);
    od = __builtin_amdgcn_mfma_f32_32x32x16_bf16(pa1, PK(l1, h1), od, 0, 0, 0);
    od = __builtin_amdgcn_mfma_f32_32x32x16_bf16(pa2, PK(l2, h2), od, 0, 0, 0);
    od = __builtin_amdgcn_mfma_f32_32x32x16_bf16(pa3, PK(l3, h3), od, 0, 0, 0);
#undef PK
}
__device__ __forceinline__ void pv_d0(f32x16* o, int vb, bf16x8 pa0, bf16x8 pa1, bf16x8 pa2, bf16x8 pa3) {
    pv_one<0>(o[0], vb, pa0, pa1, pa2, pa3); pv_one<1>(o[1], vb, pa0, pa1, pa2, pa3); pv_one<2>(o[2], vb, pa0, pa1, pa2, pa3); pv_one<3>(o[3], vb, pa0, pa1, pa2, pa3);
}
#define PINV(x) asm volatile("" : "+v"(x))
struct KFrag { bf16x8 b0, b1; };
template <int P> __device__ __forceinline__ void kfrag(KFrag& f, const LAS char* Kn, const LAS char* Kr, int r32, int hi) {
    if (P < 8) { const int cb = (P * 16 + hi * 8) * 2; f.b0 = *(const LAS bf16x8*)(Kn + KSWZ(r32, cb)); f.b1 = *(const LAS bf16x8*)(Kn + KSWZ(32 + r32, cb)); }
    else { const int ch = (P - 8) * 2 + hi; f.b0 = *(const LAS bf16x8*)(Kr + KRSWZ(r32, ch)); f.b1 = *(const LAS bf16x8*)(Kr + KRSWZ(32 + r32, ch)); }
}
struct VFrag { s16x4 l0, h0, l1, h1, l2, h2, l3, h3; };
template <int D0> __device__ __forceinline__ void vfrag_lo(VFrag& f, int vb) { f.l0 = tr_read<v_rd_off(D0, 0, 0)>(vb); f.h0 = tr_read<v_rd_off(D0, 0, 1)>(vb); f.l1 = tr_read<v_rd_off(D0, 1, 0)>(vb); f.h1 = tr_read<v_rd_off(D0, 1, 1)>(vb); }
template <int D0> __device__ __forceinline__ void vfrag_hi(VFrag& f, int vb) { f.l2 = tr_read<v_rd_off(D0, 2, 0)>(vb); f.h2 = tr_read<v_rd_off(D0, 2, 1)>(vb); f.l3 = tr_read<v_rd_off(D0, 3, 0)>(vb); f.h3 = tr_read<v_rd_off(D0, 3, 1)>(vb); }
__device__ __forceinline__ void pv4(f32x16& od, const VFrag& f, bf16x8 pa0, bf16x8 pa1, bf16x8 pa2, bf16x8 pa3) {
#define PK(L, H) (bf16x8){L[0], L[1], L[2], L[3], H[0], H[1], H[2], H[3]}
    od = __builtin_amdgcn_mfma_f32_32x32x16_bf16(pa0, PK(f.l0, f.h0), od, 0, 0, 0);
    od = __builtin_amdgcn_mfma_f32_32x32x16_bf16(pa1, PK(f.l1, f.h1), od, 0, 0, 0);
    od = __builtin_amdgcn_mfma_f32_32x32x16_bf16(pa2, PK(f.l2, f.h2), od, 0, 0, 0);
    od = __builtin_amdgcn_mfma_f32_32x32x16_bf16(pa3, PK(f.l3, f.h3), od, 0, 0, 0);
#undef PK
}
__device__ __forceinline__ bf16x8 pk4(const f32x16& P, int base) {
    u32x4 w = {cvtpk(P[base + 0], P[base + 1]), cvtpk(P[base + 2], P[base + 3]), cvtpk(P[base + 4], P[base + 5]), cvtpk(P[base + 6], P[base + 7])};
    PINV(w); return *reinterpret_cast<bf16x8*>(&w);
}
template <int P> __device__ __forceinline__ void fill_a(f32x16& Y0, f32x16& Y1, float alY, float& ps, float& l_reg, bf16x8& pa0, bf16x8& pa1, bf16x8& pa2, bf16x8& pa3, VFrag& va, int vbY) {
    if constexpr (P == 0) { ps = Y0[0] + Y0[1];
#pragma unroll
        for (int r = 2; r < 8; ++r) ps += Y0[r];
        PINV(ps); pa0 = pk4(Y0, 0); }
    else if constexpr (P == 1) {
#pragma unroll
        for (int r = 8; r < 16; ++r) ps += Y0[r];
        PINV(ps); pa1 = pk4(Y0, 8); }
    else if constexpr (P < 10) { constexpr int i = 2 * (P - 2);
        float e0 = __builtin_amdgcn_exp2f(Y1[i]), e1 = __builtin_amdgcn_exp2f(Y1[i + 1]); PINV(e0); PINV(e1); Y1[i] = e0; Y1[i + 1] = e1;
        if constexpr (P > 2) { ps += Y1[i - 2]; ps += Y1[i - 1]; PINV(ps); }
        if constexpr (P == 6) pa2 = pk4(Y1, 0); }
    else if constexpr (P == 10) { ps += Y1[14]; ps += Y1[15]; pa3 = pk4(Y1, 8);
        auto rr = __builtin_amdgcn_permlane32_swap(__float_as_uint(ps), __float_as_uint(ps), false, false);
        l_reg = l_reg * alY + (__uint_as_float(rr[0]) + __uint_as_float(rr[1])); PINV(l_reg); vfrag_lo<0>(va, vbY); }
    else vfrag_hi<0>(va, vbY);
}
#ifndef DMA_IN_A
#define DMA_IN_A 0
#endif
__device__ __forceinline__ void dma16(const char* base, unsigned voff, LAS char* dst) {
    asm volatile("s_mov_b32 m0, %2\n\ts_nop 0\n\tglobal_load_lds_dwordx4 %0, %1" :: "v"(voff), "s"(base), "s"((unsigned)(uintptr_t)dst) : "memory", "m0");
}
struct DmaCtx { const char* kt; const char* vt; unsigned voKn0, voKn1, voKr, voV0, voV1; LAS char* lKn; LAS char* lKr; LAS char* lV; };
template <int I> __device__ __forceinline__ void dma_piece(const DmaCtx& c) {
    if (I == 0) dma16(c.kt, c.voKn0, c.lKn);
    if (I == 1) dma16(c.kt, c.voKn1, c.lKn + 1024);
    if (I == 2) dma16(c.kt, c.voKr, c.lKr);
    if (I == 3) dma16(c.vt, c.voV0, c.lV);
    if (I == 4) dma16(c.vt, c.voV1, c.lV + 1024);
}
template <int AV, bool DK, bool DV> __device__ __forceinline__ void phase_a(const DmaCtx& dc, const f32x16& negm, f32x16& X0, f32x16& X1, f32x16& Y0, f32x16& Y1, float alY, float& l_reg, bf16x8& pa0, bf16x8& pa1, bf16x8& pa2, bf16x8& pa3, VFrag& va,
                                        const LAS char* Kn, const LAS char* Kr, const bf16x8* qr, int vbY, int r32, int hi) {
    KFrag k; float ps = 0.f;
    kfrag<0>(k, Kn, Kr, r32, hi); if (AV != 2) fill_a<0>(Y0, Y1, alY, ps, l_reg, pa0, pa1, pa2, pa3, va, vbY); SBAR();
#define QKP(P) do { if (AV != 8) { X0 = __builtin_amdgcn_mfma_f32_32x32x16_bf16(k.b0, qr[P], P == 0 ? negm : X0, 0, 0, 0); X1 = __builtin_amdgcn_mfma_f32_32x32x16_bf16(k.b1, qr[P], P == 0 ? negm : X1, 0, 0, 0); } \
        else asm volatile("" :: "v"(k.b0), "v"(k.b1)); \
        if (AV != 5 && DMA_IN_A) { if (DK && P == 1) dma_piece<0>(dc); if (DK && P == 3) dma_piece<1>(dc); if (DK && P == 5) dma_piece<2>(dc); if (DV && P == 7) dma_piece<3>(dc); if (DV && P == 9) dma_piece<4>(dc); } \
        if (P < 11) { if (AV != 7) kfrag<(P < 11 ? P + 1 : 0)>(k, Kn, Kr, r32, hi); if (AV != 2 || P >= 9) fill_a<(P < 11 ? P + 1 : 1)>(Y0, Y1, alY, ps, l_reg, pa0, pa1, pa2, pa3, va, vbY); } SBAR(); } while (0)
    QKP(0); QKP(1); QKP(2); QKP(3); QKP(4); QKP(5); QKP(6); QKP(7); QKP(8); QKP(9); QKP(10); QKP(11);
#undef QKP
}
template <int S> __device__ __forceinline__ void fill_b(f32x16& X0) {
    constexpr int lo = S == 0 ? 0 : S == 1 ? 5 : 10, hi_ = S == 0 ? 5 : S == 1 ? 10 : 16;
#pragma unroll
    for (int r = lo; r < hi_; ++r) { float e = __builtin_amdgcn_exp2f(X0[r]); PINV(e); X0[r] = e; }
}
template <bool MASK, int AV> __device__ __forceinline__ void phase_b(f32x16* o, f32x16& negm, f32x16& X0, f32x16& X1, float& m_reg, float& alpha, bf16x8 pa0, bf16x8 pa1, bf16x8 pa2, bf16x8 pa3, VFrag& va, int vbY) {
#define PV4(D) do { if (AV != 8) pv4(o[D], va, pa0, pa1, pa2, pa3); else asm volatile("" :: "v"(va.l0), "v"(va.h0), "v"(va.l1), "v"(va.h1), "v"(va.l2), "v"(va.h2), "v"(va.l3), "v"(va.h3)); } while (0)
    PV4(0); if (AV != 7) { vfrag_lo<1>(va, vbY); vfrag_hi<1>(va, vbY); }
    bool keep = true;
    if (AV != 2) { if (MASK) maskp<1>(X0, X1);
      float m0 = X0[0], m1 = X1[0];
#pragma unroll
      for (int r = 1; r < 16; ++r) { m0 = fmaxf(m0, X0[r]); m1 = fmaxf(m1, X1[r]); }
      float pmax = fmaxf(m0, m1);
      { auto rr = __builtin_amdgcn_permlane32_swap(__float_as_uint(pmax), __float_as_uint(pmax), false, false); pmax = fmaxf(__uint_as_float(rr[0]), __uint_as_float(rr[1])); }
      PINV(pmax);
      keep = __all(pmax <= THR); alpha = 1.f;
      SBAR();
      if (__builtin_expect(!keep, 0)) {
          const float dlt = fmaxf(pmax, 0.f); alpha = __builtin_amdgcn_exp2f(-dlt); m_reg += dlt;
#pragma unroll
          for (int r = 0; r < 16; ++r) { X0[r] -= dlt; X1[r] -= dlt; negm[r] = -m_reg; } }
    }
    else { float t0 = X0[0], t1 = X1[0]; PINV(t0); PINV(t1); }
    SBAR();
    PV4(1); if (AV != 7) { vfrag_lo<2>(va, vbY); vfrag_hi<2>(va, vbY); } if (AV != 2) fill_b<0>(X0); SBAR();
    PV4(2); if (AV != 7) { vfrag_lo<3>(va, vbY); vfrag_hi<3>(va, vbY); } if (AV != 2) fill_b<1>(X0); SBAR();
    PV4(3); if (AV != 2) fill_b<2>(X0); SBAR();
#undef PV4
}
template <int AV> __device__ __forceinline__ void attn_body(const bf16* __restrict__ Qb, const bf16* __restrict__ Kh, const bf16* __restrict__ Vh, bf16* __restrict__ Ob, LAS char* lds) {
    int tid = threadIdx.x; asm volatile("" : "+v"(tid)); const int wid = __builtin_amdgcn_readfirstlane(tid >> 6), lane = tid & 63, r32 = lane & 31, hi = lane >> 5;
    LAS char* V_lds = lds + OFF_V; LAS char* Kn_lds = lds + OFF_KN; LAS char* Kr_lds = lds + OFF_KR;
    LAS float* wsf = (LAS float*)(lds + OFF_WS) + wid * 64; LAS float* li_l = wsf; LAS float* al_l = wsf + 32;
    float m_reg = -1e30f, l_reg = 0; f32x16 o[4] = {}; bf16x8 qr[12];
    const bf16* Qw = Qb + (long)(wid * QBLK + r32) * LDQ + hi * 8;
#pragma unroll
    for (int d0 = 0; d0 < 12; ++d0) qr[d0] = *(const GAS bf16x8*)(Qw + d0 * 16);
    unsigned voKn[2], voV[2], voKr;
#pragma unroll
    for (int i = 0; i < 2; ++i) { const int ch = 2 * wid + i;
        { const int row = 4 * ch + (lane >> 4), lc = (lane & 15) ^ (row & 15); voKn[i] = (unsigned)(row * LDK + lc * 8) * 2u; }
        { const int P = ch * 64 + lane, sub = P >> 5, k = (sub >> 2) * 8 + ((P >> 2) & 7), c = (sub & 3) * 32 + (P & 3) * 8; voV[i] = (unsigned)(k * LDV + c) * 2u; } }
    { const int row = 8 * wid + (lane >> 3), lc = (lane & 7) ^ ((row >> 1) & 7); voKr = (unsigned)(row * LDK + 128 + lc * 8) * 2u; }
    const int vb0 = (int)(uintptr_t)V_lds + v_rd_base(lane);
#define DMA_K(t, b) do { const char* kt_ = (const char*)Kh + (size_t)(t) * (KVBLK * LDK * 2); \
    dma16(kt_, voKn[0], Kn_lds + (b) * SHM_KN + (2 * wid) * 1024); dma16(kt_, voKn[1], Kn_lds + (b) * SHM_KN + (2 * wid + 1) * 1024); dma16(kt_, voKr, Kr_lds + (b) * SHM_KR + wid * 1024); } while (0)
#define DMA_V(t, b) do { const char* vt_ = (const char*)Vh + (size_t)(t) * (KVBLK * LDV * 2); \
    dma16(vt_, voV[0], V_lds + (b) * SHM_V + (2 * wid) * 1024); dma16(vt_, voV[1], V_lds + (b) * SHM_V + (2 * wid + 1) * 1024); } while (0)
#define RESC(a) do { if (__any((a) < 1.f)) { if (hi == 0) al_l[r32] = (a); asm volatile("s_waitcnt lgkmcnt(0)" ::: "memory"); \
    _Pragma("unroll") for (int d = 0; d < 4; ++d) _Pragma("unroll") for (int r = 0; r < 16; ++r) o[d][r] *= al_l[crow(r, hi)]; } } while (0)
#define WBAR(N) do { asm volatile("s_waitcnt vmcnt(" #N ") lgkmcnt(0)" ::: "memory"); __builtin_amdgcn_s_barrier(); asm volatile("" ::: "memory"); } while (0)
    f32x16 pA0, pA1, pB0, pB1; float mnA, mnB, alA, alB; bf16x8 pa0, pa1, pa2, pa3;
    DMA_K(0, 0); DMA_K(1, 1); DMA_V(0, 0);
    WBAR(0);
    DMA_K(2, 2); DMA_V(1, 1);
    qkt(pA0, pA1, Kn_lds, Kr_lds, qr, r32, hi); partialSM(pA0, pA1, m_reg, mnA, alA); RESC(alA);
    WBAR(5);
    f32x16 negm;
#pragma unroll
    for (int r = 0; r < 16; ++r) negm[r] = -m_reg;
    int bc = 1;
#define STEP(j, X0, X1, mnX, alX, Y0, Y1, alY, MASK, DK, DV) do { const int bp_ = bc == 0 ? 2 : bc - 1, bn_ = bc == 2 ? 0 : bc + 1; \
        const DmaCtx dc_{(const char*)Kh + (size_t)((j) + 2) * (KVBLK * LDK * 2), (const char*)Vh + (size_t)((j) + 1) * (KVBLK * LDV * 2), voKn[0], voKn[1], voKr, voV[0], voV[1], \
                         Kn_lds + bp_ * SHM_KN + (2 * wid) * 1024, Kr_lds + bp_ * SHM_KR + wid * 1024, V_lds + bn_ * SHM_V + (2 * wid) * 1024}; \
        phase_a<AV, DK, DV>(dc_, negm, X0, X1, Y0, Y1, alY, l_reg, pa0, pa1, pa2, pa3, vfa, Kn_lds + bc * SHM_KN, Kr_lds + bc * SHM_KR, qr, vb0 + bp_ * SHM_V, r32, hi); \
        phase_b<MASK, AV>(o, negm, X0, X1, m_reg, alX, pa0, pa1, pa2, pa3, vfa, vb0 + bp_ * SHM_V); \
        if (AV != 2) RESC(alX); \
        if (AV != 5 && !DMA_IN_A) { SBAR(); if (DK) { dma_piece<0>(dc_); dma_piece<1>(dc_); dma_piece<2>(dc_); } if (DV) { dma_piece<3>(dc_); dma_piece<4>(dc_); } } \
        if (DK && AV != 5) WBAR(5); else if (DV && AV != 5 && !DMA_IN_A) WBAR(2); else WBAR(0); \
        bc = bn_; } while (0)
    VFrag vfa;
    for (int j = 1; j + 3 < NT; j += 2) {
        STEP(j, pB0, pB1, mnB, alB, pA0, pA1, alA, false, true, true);
        STEP(j + 1, pA0, pA1, mnA, alA, pB0, pB1, alB, false, true, true);
    }
    STEP(NT - 2, pB0, pB1, mnB, alB, pA0, pA1, alA, false, false, true);
    STEP(NT - 1, pA0, pA1, mnA, alA, pB0, pB1, alB, true, false, false);
#undef STEP
    finishSM(pA0, pA1, alA, l_reg, pa0, pa1, pa2, pa3); SBAR();
    pv_d0(o, vb0 + ((NT - 1) % 3) * SHM_V, pa0, pa1, pa2, pa3);
    if (hi == 0) li_l[r32] = l_reg; LDS_WAIT();
    float rli[16];
#pragma unroll
    for (int r = 0; r < 16; ++r) rli[r] = __builtin_amdgcn_rcpf(li_l[crow(r, hi)]);
    bf16* Ow = Ob + (long)(wid * QBLK) * LDO;
    if (AV != 0) { float s = 0.f;
#pragma unroll
        for (int d0 = 0; d0 < 4; ++d0) _Pragma("unroll") for (int r = 0; r < 16; ++r) s += o[d0][r];
        if (s != 1234567.125f) return; }
#pragma unroll
    for (int r = 0; r < 16; ++r) { const int orow = crow(r, hi);
#pragma unroll
        for (int d0 = 0; d0 < 4; ++d0) Ow[(long)orow * LDO + d0 * 32 + r32] = f2bf(o[d0][r] * rli[r]); }
#undef DMA_K
#undef DMA_V
#undef WBAR
#undef RESC
}
__device__ __forceinline__ void attn_phase(unsigned char* ws, LAS unsigned char* lds, int G, int bid, bf16* exp_out, bf16* AO) {
    const bf16* QM = (const bf16*)(ws + WS_QM); const bf16* KF = (const bf16*)(ws + WS_KF); const bf16* VB = (const bf16*)(ws + WS_VB);
    for (int u = bid; u < MH * (SEQ / 256); u += G) {
        const int b = u & 255, r = u >> 8, h = 2 * (b & 7) + r, qb = b >> 3;
        __syncthreads();
        attn_body<0>(QM + (size_t)(256 * qb) * 3072 + h * 192, KF + h * 192, VB + h * 128, AO + (size_t)(256 * qb) * 2048 + h * 128, (LAS char*)lds);
    }
#if defined(EXP_ATT)
    for (int u = bid; u < MH * (SEQ / 256); u += G) {
        const int b = u & 255, r = u >> 8, h = 2 * (b & 7) + r, qb = b >> 3;
        __syncthreads();
        attn_body<EXP_ATT>(QM + (size_t)(256 * qb) * 3072 + h * 192, KF + h * 192, VB + h * 128, (EXP_ATT == 0 ? AO : exp_out) + (size_t)(256 * qb) * 2048 + h * 128, (LAS char*)lds);
    }
#endif
}
}
__device__ __forceinline__ void kpe_pass(unsigned char* ws, int gw, int NGW, int lane) {
    const float* SMALL = (const float*)(ws + ST_SMALL); const float* COS = (const float*)(ws + ST_COS); const float* SIN = (const float*)(ws + ST_SIN); bf16* KF = (bf16*)(ws + WS_KF);
    const int l = lane & 31, p = 2 * l, gp = p >> 5, fq = (p >> 3) & 3, nn = (p >> 2) & 1, j = p & 3, f = 16 * gp + 4 * fq + j;
    for (int row = 2 * gw + (lane >> 5); row < LP; row += 2 * NGW) {
        float v0 = 0.f, v1 = 0.f;
        if (row < LTOK) {
            const int pos = row < SEQ ? row + NMETA : row - SEQ;
            const float a0 = SMALL[(size_t)row * 96 + f], a1 = SMALL[(size_t)row * 96 + f + 1], b0 = SMALL[(size_t)row * 96 + 32 + f], b1 = SMALL[(size_t)row * 96 + 32 + f + 1];
            const float c0 = COS[pos * 32 + f], c1 = COS[pos * 32 + f + 1], s0 = SIN[pos * 32 + f], s1 = SIN[pos * 32 + f + 1];
            v0 = nn == 0 ? a0 * c0 - b0 * s0 : a0 * s0 + b0 * c0; v1 = nn == 0 ? a1 * c1 - b1 * s1 : a1 * s1 + b1 * c1;
        }
        const unsigned w = cvtpk(v0, v1);
#pragma unroll
        for (int h = 0; h < MH; ++h) *(GAS unsigned*)(KF + (size_t)row * 3072 + h * 192 + 128 + p) = w;
    }
}
__device__ __forceinline__ void final_norm(unsigned char* ws, float* out, const float* g, int gw, int NGW, int lane) {
    const float* SS = (const float*)(ws + ST_H2SS); const bf16* H2 = (const bf16*)(ws + WS_H1B);
    for (int row = gw; row < SEQ; row += NGW) {
        const float s = wave_sum(SS[(size_t)row * 64 + lane]);
        const float rs = 1.f / sqrtf(s * (1.f / DM) + EPS);
        const GAS u32x4* hp = (const GAS u32x4*)(H2 + (size_t)row * DM) + lane;
        GAS f32x4* o = (GAS f32x4*)(out + (size_t)row * DM) + 2 * lane; const GAS f32x4* gp = (const GAS f32x4*)g + 2 * lane;
        u32x4 w[8];
#pragma unroll
        for (int j = 0; j < 8; ++j) w[j] = hp[64 * j];
#pragma unroll
        for (int j = 0; j < 8; ++j) { const f32x4 a = (f32x4){bflo(w[j].x), bfhi(w[j].x), bflo(w[j].y), bfhi(w[j].y)}, b = (f32x4){bflo(w[j].z), bfhi(w[j].z), bflo(w[j].w), bfhi(w[j].w)};
            o[128 * j] = a * rs * gp[128 * j]; o[128 * j + 1] = b * rs * gp[128 * j + 1]; }
    }
}

#ifndef PG_SP2
#define PG_SP2 true
#endif
#ifndef PG_ALIGN
#define PG_ALIGN true
#endif
struct Args { const float* in[20]; float* out; unsigned char* ws; int ph_lo, ph_hi; };
constexpr int NPHASE = 10;
__global__ void __launch_bounds__(NTHR, 2) mega_fwd(Args args) {
    extern __shared__ __attribute__((aligned(16))) unsigned char lds_raw[];
    LAS unsigned char* lds = (LAS unsigned char*)lds_raw;
#define FRESH_IDS() int tid = threadIdx.x; asm volatile("" : "+v"(tid)); const int lane = tid & 63, wave = __builtin_amdgcn_readfirstlane(tid >> 6), gw = bid * NWAVES + wave; (void)lane; (void)gw
    const int G = gridDim.x, bid = blockIdx.x, NGW = G * NWAVES;
    unsigned char* ws = args.ws;
    volatile LAS unsigned* MISC = (volatile LAS unsigned*)(lds + LDS_CTL);
    if (threadIdx.x < 64) MISC[threadIdx.x] = 0u;
    __syncthreads();
    XcdBarrier bar = xcd_barrier_post((unsigned*)(ws + WS_CTL) + CW_BAR, MISC + 8);
    const int lo = args.ph_lo, hi = args.ph_hi;
#ifndef PH_MASK
#define PH_MASK 0x3ff
#endif
#define IN(k) ((((PH_MASK) >> (k)) & 1) && lo <= (k) && (k) < hi)
#define SEAM(k) do { if (IN(k) && IN((k) + 1)) xcd_barrier(bar); } while (0)
#ifndef DUP_PHASE
#define DUP_PHASE -1
#endif
#define REP(k) for (int rep_ = 0; rep_ < (DUP_PHASE == (k) ? 2 : 1); ++rep_, (DUP_PHASE == (k) && rep_ == 1 ? xcd_barrier(bar) : (void)0))
    GlaW glw{args.in[4], args.in[5], args.in[6], args.in[7], args.in[8]};
#if defined(DBG_TIME)
    volatile LAS unsigned long long* TS = (volatile LAS unsigned long long*)(lds + LDS_CTL + 64);
#define STAMP(k) do { if (bid == 0 && threadIdx.x == 0) TS[k] = __builtin_amdgcn_s_memrealtime(); } while (0)
#else
#define STAMP(k) do {} while (0)
#endif
    STAMP(0);

    REP(0) if (IN(0)) {
        P0Args a{args.in[0], args.in[1], args.in[2], args.in[3], args.in[9], args.in[10], args.in[11], args.in[12], args.in[13], args.in[14], args.in[15], args.in[16], args.in[17], args.in[18], ws};
        FRESH_IDS(); p0_prologue(a, lds, gw, NGW, wave, lane);
    }
    SEAM(0); STAMP(1);
    REP(1) if (IN(1)) {
        { pg8::Gemm g{(const bf16*)(ws + WS_H0B), (const bf16*)(ws + WS_WINT), LP, NPROJ, DM}; ProjOrder S; S.init(G, bid, 0); EpiProj E{ws, 1.f};
          pg8::gemm_phase<EpiProj, ProjOrder, PG_ALIGN, PG_SP2>(lds, g, S, E); }
        { pg8::Gemm g{(const bf16*)(ws + WS_H0F8), (const bf16*)(ws + WS_WF8 - (size_t)30 * 256 * DM), LP, NPROJ, DM}; ProjOrder S; S.init(G, bid, 1); EpiGate E{ws};
          pg8::gemm_phase<EpiGate, ProjOrder, PG_ALIGN, PG_SP2, true>(lds, g, S, E); }
    }
    SEAM(1); STAMP(2);
    REP(2) if (IN(2)) {
#ifndef NO_QUP
        { pg8::Gemm g{(const bf16*)(ws + WS_CQ), (const bf16*)(ws + WS_WUQT), SEQ, 3072, QRANK}; pg8::StaticOrder S; S.init(SEQ, 3072, G, (bid + G / 2) % G); EpiQ E{ws};
          pg8::gemm_phase<EpiQ, pg8::StaticOrder, PG_ALIGN, PG_SP2>(lds, g, S, E); }
#endif
        STAMP(11);
#ifndef NO_KVUP
        { pg8::Gemm g{(const bf16*)(ws + WS_CKV), (const bf16*)(ws + WS_WUKVT), LP, 4096, KVRANK}; pg8::StaticOrder S; S.init(LP, 4096, G, bid); EpiKV E{ws};
          pg8::gemm_phase<EpiKV, pg8::StaticOrder, PG_ALIGN, PG_SP2>(lds, g, S, E); }
#endif
        STAMP(12);
        { FRESH_IDS(); kpe_pass(ws, gw, NGW, lane); }
        STAMP(13);
        { FRESH_IDS(); gla_pass_a(ws, glw, lds, tid, G, bid, args.out); }
#if defined(DUP_PA)
        { FRESH_IDS(); gla_pass_a(ws, glw, lds, tid, G, bid, args.out); }
#endif
#if defined(DUP_KPE)
        { FRESH_IDS(); kpe_pass(ws, gw, NGW, lane); }
#endif
    }
    SEAM(2); STAMP(3);
    REP(3) if (IN(3)) {
#ifndef NO_CHAIN
        { FRESH_IDS();
          if (wave < 2) gla_chain(ws, bid, G, wave, lane);
          else { P0Args a{args.in[0], args.in[1], args.in[2], args.in[3], args.in[9], args.in[10], args.in[11], args.in[12], args.in[13], args.in[14], args.in[15], args.in[16], args.in[17], args.in[18], ws};
                 p0_weights_late(a, lds, bid * 6 + (wave - 2), G * 6, wave, lane); } }
#if defined(DUP_CHAIN)
        { FRESH_IDS();
          if (wave < 2) { if (DUP_CHAIN != 3) gla_chain(ws, bid, G, wave, lane); }
          else if (DUP_CHAIN != 2) { P0Args a{args.in[0], args.in[1], args.in[2], args.in[3], args.in[9], args.in[10], args.in[11], args.in[12], args.in[13], args.in[14], args.in[15], args.in[16], args.in[17], args.in[18], ws};
                 p0_weights_late(a, lds, bid * 6 + (wave - 2), G * 6, wave, lane); } }
#endif
#endif
        STAMP(14);
#ifndef NO_ATT
        att::attn_phase(ws, lds, G, bid, (bf16*)args.out, (bf16*)args.out + (size_t)32 * 1024 * 1024);
#endif
    }
    SEAM(3); STAMP(4);
    REP(4) if (IN(4)) { FRESH_IDS(); gla_pass_c<0>(ws, glw, lds, tid, G, bid, (bf16*)args.out + (size_t)48 * 1024 * 1024, args.out);
    }
    SEAM(4); STAMP(5);
    REP(5) if (IN(5)) {
        pg8::Gemm g{(const bf16*)args.out + (size_t)48 * 1024 * 1024, (const bf16*)(ws + WS_WGT), SEQ, DM, 2048, (const bf16*)args.out + (size_t)32 * 1024 * 1024, (const bf16*)(ws + WS_WMT)}; PairOrder S; S.init(SEQ, DM, G, bid); EpiMerged E{ws};
        pg8::gemm_phase<EpiMerged, PairOrder, PG_ALIGN, PG_SP2>(lds, g, S, E);
    }
    SEAM(5); STAMP(6);
    REP(6) if (IN(6)) {
        pg8::Gemm g{(const bf16*)(ws + WS_MERGED), (const bf16*)(ws + WS_WOT), SEQ, DM, DM}; pg8::StaticOrder S; S.init(SEQ, DM, G, bid); EpiWo E{ws, args.in[0], args.out};
        pg8::gemm_phase<EpiWo, pg8::StaticOrder, PG_ALIGN, PG_SP2>(lds, g, S, E);
    }
    SEAM(6); STAMP(7);
#if defined(EXTRA_BAR)
    for (int eb_ = 0; eb_ < EXTRA_BAR; ++eb_) xcd_barrier(bar);
#endif
    REP(7) if (IN(7)) {
        pg8::Gemm g{(const bf16*)(ws + WS_H1B), (const bf16*)(ws + WS_W1T), SEQ, DFF, DM}; pg8::StaticOrder S; S.init(SEQ, DFF, G, bid); pg8::Unit u0; u0.pm = 0; u0.pn = 0; S.next(0, u0); { FRESH_IDS(); ff1_rs_table(ws, lds, u0.pm, tid); } EpiFF1 E{ws, lds, u0.pm};
#if defined(EXP_BURN)
        if (rep_ == 1) {
            f32x4 bacc[32]; bf16x8 ba, bb;
#pragma unroll
            for (int q = 0; q < 32; ++q) bacc[q] = (f32x4){0.f, 0.f, 0.f, 0.f};
#pragma unroll
            for (int q = 0; q < 8; ++q) { ba[q] = (short)(0x3f80 + (threadIdx.x & 7)); bb[q] = (short)(0x3c00 + (threadIdx.x & 3)); }
            for (int it = 0; it < 512; ++it) {
#pragma unroll
                for (int k2 = 0; k2 < 64; ++k2) bacc[k2 & 31] = __builtin_amdgcn_mfma_f32_16x16x32_bf16(ba, bb, bacc[k2 & 31], 0, 0, 0);
            }
            float sm = 0.f;
#pragma unroll
            for (int q = 0; q < 32; ++q) sm += bacc[q][0] + bacc[q][1] + bacc[q][2] + bacc[q][3];
            if (sm == 1234567.125f) ((float*)(ws + ST_H2SS))[0] = sm;
        } else
#endif
#if defined(EXP_NULLEPI)
        if (rep_ == 1) { EpiNull EN{ws};
#if EXP_NULLEPI == 2
            pg8::Gemm g2{(const bf16*)(ws + WS_H1B), (const bf16*)(ws + WS_W1T), 256, 256, DM}; pg8::StaticOrder S2; S2.init(256, 256, 1, 0); S2.nwg = 8; S2.nN = 1; S2.nM = 1;
            struct HotOrder { __device__ bool next(int i, pg8::Unit& u) const { u.pm = 0; u.pn = 0; return i < 8; } __device__ __forceinline__ void a_ready(const pg8::Unit&) const {} __device__ __forceinline__ void done(const pg8::Unit&) const {} } HS;
            pg8::gemm_phase<EpiNull, HotOrder, true, true>(lds, g2, HS, EN);
#else
            pg8::gemm_phase<EpiNull, pg8::StaticOrder, true, true>(lds, g, S, EN);
#endif
        } else
#endif
        pg8::gemm_phase<EpiFF1, pg8::StaticOrder, PG_ALIGN, PG_SP2>(lds, g, S, E);
    }
    SEAM(7); STAMP(8);
    REP(8) if (IN(8)) {
        pg8::Gemm g{(const bf16*)(ws + WS_U), (const bf16*)(ws + WS_W2T), SEQ, DM, DFF, nullptr, nullptr, LDU, 0}; pg8::StaticOrder S; S.init(SEQ, DM, G, bid); EpiFF2 E{ws, args.out};
        pg8::gemm_phase<EpiFF2, pg8::StaticOrder, PG_ALIGN, PG_SP2>(lds, g, S, E);
#if defined(EXP_NULLEPI8)
        xcd_barrier(bar); { EpiNull EN{ws}; pg8::gemm_phase<EpiNull, pg8::StaticOrder, PG_ALIGN, PG_SP2>(lds, g, S, EN); }
#endif
    }
    SEAM(8); STAMP(9);
    REP(9) if (IN(9)) { FRESH_IDS(); final_norm(ws, args.out, args.in[19], gw, NGW, lane); }
#undef IN
#undef SEAM
}

#if defined(DBG_BISECT)
__global__ void __launch_bounds__(256) dbg_cksum(const unsigned* p, size_t nwords, unsigned* slot) {
    unsigned s = 0;
    for (size_t i = (size_t)blockIdx.x * 256 + threadIdx.x; i < nwords; i += (size_t)gridDim.x * 256) { const unsigned w = p[i]; s += w * 2654435761u + (unsigned)(i & 0xffff) * (w >> 7); }
    for (int o = 1; o < 64; o <<= 1) s += __shfl_xor(s, o);
    if ((threadIdx.x & 63) == 0) atomicAdd(slot, s);
}
__global__ void dbg_report(const unsigned* tab, int nbuf, float* out, size_t nout) {
    int first = 0;
    for (int i = 0; i < nbuf; ++i) if (tab[i] != tab[64 + i]) { first = i + 1; break; }
    for (size_t i = (size_t)blockIdx.x * blockDim.x + threadIdx.x; i < nout; i += (size_t)gridDim.x * blockDim.x) out[i] = (float)first * 1000.f;
}
struct DbgBuf { size_t off, bytes; int phase; int where; };
static const DbgBuf DBG_BUFS[] = {
    {WS_WINT, (size_t)NPROJ * DM * 2, 0, 0}, {WS_W1T, (size_t)DFF * DM * 2, 0, 0}, {WS_W2T, (size_t)DFF * DM * 2, 0, 0}, {WS_WOT, (size_t)DM * DM * 2, 0, 0},
    {WS_WGT, (size_t)DM * 2048 * 2, 0, 0}, {WS_WMT, (size_t)DM * 2048 * 2, 0, 0}, {WS_WUQT, (size_t)3072 * 1024 * 2, 0, 0}, {WS_WUKVT, (size_t)4096 * 512 * 2, 0, 0},
    {WS_H0B, (size_t)LP * DM * 2, 0, 0}, {ST_RS1, (size_t)LP * 4, 0, 0}, {ST_COS, (size_t)LTOK * 32 * 4, 0, 0}, {ST_SIN, (size_t)LTOK * 32 * 4, 0, 0},
    {WS_GQ, (size_t)SEQ * 1024 * 2, 1, 0}, {WS_GK, (size_t)LP * 1024 * 2, 1, 0}, {WS_GV, (size_t)LP * 2048 * 2, 1, 0}, {WS_GOG, (size_t)SEQ * 2048 * 2, 1, 0},
    {WS_CQ, (size_t)SEQ * 1024 * 2, 1, 0}, {WS_CKV, (size_t)LP * 512 * 2, 1, 0}, {WS_GA, (size_t)SEQ * DM * 2, 1, 0}, {WS_GB, (size_t)SEQ * DM * 2, 1, 0},
    {ST_SMALL, (size_t)LP * 96 * 4, 1, 0}, {ST_CQSS, (size_t)SEQ * 16 * 4, 1, 0}, {ST_CKVSS, (size_t)LP * 8 * 4, 1, 0},
    {WS_QM, (size_t)SEQ * 3072 * 2, 2, 0}, {WS_KF, (size_t)LP * 3072 * 2, 2, 0}, {WS_VB, (size_t)LP * 2048 * 2, 2, 0},
    {WS_KHTF, (size_t)129 * 8 * 128 * 64 * 2, 2, 0}, {WS_KHTB, (size_t)128 * 8 * 128 * 64 * 2, 2, 0}, {WS_VT, (size_t)129 * 8 * 256 * 64 * 2, 2, 0},
    {ST_DLF, (size_t)129 * 8 * 128 * 4, 2, 0}, {ST_DLB, (size_t)128 * 8 * 128 * 4, 2, 0},
    {WS_SNAP, (size_t)2 * 128 * 8 * 256 * 128 * 2, 3, 0}, {WS_AO, (size_t)SEQ * 2048 * 2, 3, 0},
    {WS_AG, (size_t)SEQ * 2048 * 2, 4, 0},
    {WS_MERGED, (size_t)SEQ * DM * 2, 5, 0},
    {0, (size_t)SEQ * DM * 4, 6, 1}, {WS_H1B, (size_t)SEQ * DM * 2, 6, 0}, {ST_H1SS, (size_t)SEQ * 64 * 4, 6, 0},
    {WS_U, (size_t)SEQ * DFF * 2, 7, 0},
    {0, (size_t)SEQ * DM * 4, 8, 1}, {ST_H2SS, (size_t)SEQ * 64 * 4, 8, 0},
    {0, (size_t)SEQ * DM * 4, 9, 1},
};
static void dbg_launch(Args a, int grid, void* d_out, void* d_ws, hipStream_t stream) {
    const int nbuf = (int)(sizeof(DBG_BUFS) / sizeof(DBG_BUFS[0]));
    unsigned* tab = (unsigned*)((char*)d_ws + WS_CTL + 65536);
    for (int run = 0; run < 2; ++run)
        for (int p = 0; p < NPHASE; ++p) {
            a.ph_lo = p; a.ph_hi = p + 1; hipLaunchKernelGGL(mega_fwd, dim3(grid), dim3(NTHR), LDS_BYTES, stream, a);
            for (int i = 0; i < nbuf; ++i) if (DBG_BUFS[i].phase == p) {
                const char* base = DBG_BUFS[i].where ? (const char*)d_out : (const char*)d_ws + DBG_BUFS[i].off;
                hipLaunchKernelGGL(dbg_cksum, dim3(1024), dim3(256), 0, stream, (const unsigned*)base, DBG_BUFS[i].bytes / 4, tab + run * 64 + i);
            }
        }
    hipLaunchKernelGGL(dbg_report, dim3(1024), dim3(256), 0, stream, (const unsigned*)tab, nbuf, (float*)d_out, (size_t)SEQ * DM);
}

#endif
#ifndef MK_N_LAUNCHES
#define MK_N_LAUNCHES 1
#endif
extern "C" void kernel_launch(void* const* d_in, const int* in_sizes, int n_in, void* d_out, int out_size, void* d_ws, size_t ws_size, hipStream_t stream) {
    static int grid = 0;
    if (grid == 0) {
        if (n_in != 20 || out_size != SEQ * DM || ws_size < WS_END) { fprintf(stderr, "kernel_launch: unexpected shapes: n_in %d out %d ws %zu (need %zu)\n", n_in, out_size, ws_size, (size_t)WS_END); grid = -1; return; }
        int dev = 0, cus = 0, per_cu = 0;
        if (hipGetDevice(&dev) != hipSuccess || hipDeviceGetAttribute(&cus, hipDeviceAttributeMultiprocessorCount, dev) != hipSuccess) { grid = -1; return; }
        if (hipFuncSetAttribute((const void*)mega_fwd, hipFuncAttributeMaxDynamicSharedMemorySize, LDS_BYTES) != hipSuccess) { fprintf(stderr, "kernel_launch: hipFuncSetAttribute failed\n"); grid = -1; return; }
        if (hipOccupancyMaxActiveBlocksPerMultiprocessor(&per_cu, (const void*)mega_fwd, NTHR, LDS_BYTES) != hipSuccess || per_cu < 1) fprintf(stderr, "kernel_launch: occupancy query says %d\n", per_cu);
        (void)hipGetLastError();
        grid = cus;
    }
    if (grid < 0) return;
    if (hipMemsetAsync((char*)d_ws + WS_CTL, 0, CTL_BYTES, stream) != hipSuccess) return;
    Args a{};
    for (int i = 0; i < 20; ++i) a.in[i] = (const float*)d_in[i];
    a.out = (float*)d_out; a.ws = (unsigned char*)d_ws;
#if defined(DBG_BISECT)
    dbg_launch(a, grid, d_out, d_ws, stream);
#elif MK_N_LAUNCHES == 1
    a.ph_lo = 0; a.ph_hi = NPHASE;
    hipLaunchKernelGGL(mega_fwd, dim3(grid), dim3(NTHR), LDS_BYTES, stream, a);
#else
    for (int p = 0; p < NPHASE; ++p) { a.ph_lo = p; a.ph_hi = p + 1; hipLaunchKernelGGL(mega_fwd, dim3(grid), dim3(NTHR), LDS_BYTES, stream, a); }
#endif
    const hipError_t le = hipPeekAtLastError();
    if (le != hipSuccess) fprintf(stderr, "kernel_launch: launch failed: %s\n", hipGetErrorName(le));
}
```

```cpp
#include <hip/hip_runtime.h>
#include <cstdio>
#include <cstdint>
namespace pg8 {
#define PG8_LAS __attribute__((address_space(3)))
typedef unsigned short bf16_t;
typedef short bf16x8 __attribute__((ext_vector_type(8)));
typedef float f32x4 __attribute__((ext_vector_type(4)));
typedef unsigned u32x4 __attribute__((ext_vector_type(4)));
typedef int i32x8 __attribute__((ext_vector_type(8)));
typedef int i32x4 __attribute__((ext_vector_type(4)));
constexpr int BM = 256, BK = 64, HALF = 128, HTB = HALF * BK * 2  , STAGE_BYTES = 8 * HTB, NXCD = 8, WGM = 8;

__host__ __device__ __forceinline__ int lds_byte(int r, int c) { const int st = (r >> 4) * 2 + (c >> 5), rr = r & 15, cc = c & 31, ob = rr * 64 + cc * 2; return st * 1024 + (ob ^ (((ob >> 9) & 1) << 5)); }
__host__ __device__ __forceinline__ void stage_rc(int b, int& R, int& C) { const int st = b / 1024, sb = b % 1024, swz = sb ^ (((sb >> 9) & 1) << 5); R = (st >> 1) * 16 + swz / 64; C = (st & 1) * 32 + (swz % 64) / 2; }
__host__ __device__ __forceinline__ int perm32(int rho) { const int n = rho >> 4, i = rho & 15; return 8 * (i >> 2) + 4 * n + (i & 3); }

struct Unit { int pm, pn, sel; };
struct Gemm { const bf16_t* A; const bf16_t* Bt; int M, N, K; const bf16_t* A2; const bf16_t* Bt2; int lda, ldb; };

struct StaticOrder {
    int nM, nN, nwg, G, c;
    __host__ __device__ void init(int M, int N, int G_, int c_) { nM = M / BM; nN = N / BM; nwg = nM * nN; G = G_; c = c_; }
    __host__ __device__ __forceinline__ bool next(int i, Unit& u) const {
        const long L = (long)i * G + c; if (L >= nwg) return false;
        int wgid = (int)L; { const int q = nwg / NXCD, r = nwg % NXCD, xcd = wgid % NXCD, off = wgid / NXCD; wgid = (xcd < r ? xcd * (q + 1) : r * (q + 1) + (xcd - r) * q) + off; }
        const int nig = WGM * nN, gid = wgid / nig, fm = gid * WGM, gsz = (nM - fm) < WGM ? (nM - fm) : WGM;
        u.pm = fm + ((wgid % nig) % gsz); u.pn = (wgid % nig) / gsz; return true;
    }
    __device__ __forceinline__ void a_ready(const Unit&) const {}
    __device__ __forceinline__ void done(const Unit&) const {}
};

template <class Epi, class Sched, bool ALIGN_EPI = false, bool SP2 = false, bool F8 = false>
__device__ __forceinline__ void gemm_phase(PG8_LAS unsigned char* lds, const Gemm g, const Sched& S, const Epi& E) {
    int tid = threadIdx.x; asm volatile("" : "+v"(tid)); const int wid = __builtin_amdgcn_readfirstlane(tid >> 6), lane = tid & 63, wr = wid >> 2, wc = wid & 3, fr = lane & 15, fq = lane >> 4;
    const int K = g.K, nt = F8 ? K / (2 * BK) : K / BK, lda = g.lda ? g.lda : K, ldb = g.ldb ? g.ldb : K;
    unsigned voffA, voffB;
    { int R, C; stage_rc(tid * 16, R, C); const int Rb = Epi::PERM ? ((R & ~31) + perm32(R & 31)) : R;
      voffA = F8 ? (unsigned)(R * lda + 2 * C) : (unsigned)(R * lda + C) * 2u; voffB = F8 ? (unsigned)(Rb * ldb + 2 * C) : (unsigned)(Rb * ldb + C) * 2u; }
    const size_t r64_voffA = (size_t)64 * lda * (F8 ? 1 : 2), r64_voffB = (size_t)64 * ldb * (F8 ? 1 : 2);
    const size_t kstep = (size_t)(BK * 2);
    const size_t hstepA = (size_t)HALF * lda * (F8 ? 1 : 2), hstepB = (size_t)HALF * ldb * (F8 ? 1 : 2);
    const size_t tstepA = 2 * hstepA, tstepB = 2 * hstepB;
    const unsigned ldsw = (unsigned)wid * 1024u;
    const int aoff = lds_byte(wr * 64 + fr, fq * 8), boff = lds_byte(wc * 32 + fr, fq * 8);
#define PG8_SA(b, h) (((b) * 2 + (h)) * HTB)
#define PG8_SB(b, h) ((4 + (b) * 2 + (h)) * HTB)
#define PG8_STAGE(bufoff, gbase, voff) do { _Pragma("unroll") for (int _i = 0; _i < 2; ++_i) \
        asm volatile("s_mov_b32 m0, %2\n\ts_nop 0\n\tglobal_load_lds_dwordx4 %0, %1" :: "v"(voff), "s"((const char*)(gbase) + _i * r64_##voff), "s"((unsigned)(uintptr_t)(lds + (bufoff) + ldsw + _i * 8192)) : "memory", "m0"); } while (0)
#define PG8_LDA(dst, b, h) do { _Pragma("unroll") for (int m = 0; m < 4; ++m) _Pragma("unroll") for (int k = 0; k < 2; ++k) dst[m][k] = *(const PG8_LAS bf16x8*)(lds + PG8_SA(b, h) + aoff + m * 2048 + k * 1024); } while (0)
#define PG8_LDB(dst, b, h) do { _Pragma("unroll") for (int n = 0; n < 2; ++n) _Pragma("unroll") for (int k = 0; k < 2; ++k) dst[n][k] = *(const PG8_LAS bf16x8*)(lds + PG8_SB(b, h) + boff + n * 2048 + k * 1024); } while (0)
#define PG8_CAT(F) __builtin_shufflevector(__builtin_bit_cast(i32x4, F[0]), __builtin_bit_cast(i32x4, F[1]), 0, 1, 2, 3, 4, 5, 6, 7)
#define PG8_MMA(ai, bj, At, Bt) do { __builtin_amdgcn_s_setprio(1); \
        if constexpr (F8) { _Pragma("unroll") for (int m = 0; m < 4; ++m) _Pragma("unroll") for (int n = 0; n < 2; ++n) \
            acc[ai][bj][m][n] = __builtin_amdgcn_mfma_scale_f32_16x16x128_f8f6f4(PG8_CAT(Bt[n]), PG8_CAT(At[m]), acc[ai][bj][m][n], 0, 0, 0, 0, 0, 0); } \
        else { _Pragma("unroll") for (int m = 0; m < 4; ++m) _Pragma("unroll") for (int n = 0; n < 2; ++n) _Pragma("unroll") for (int k = 0; k < 2; ++k) \
            acc[ai][bj][m][n] = __builtin_amdgcn_mfma_f32_16x16x32_bf16(Bt[n][k], At[m][k], acc[ai][bj][m][n], 0, 0, 0); } \
        __builtin_amdgcn_s_setprio(0); } while (0)
#define PG8_WAIT_V(n) asm volatile("s_waitcnt vmcnt(" #n ")" ::: "memory")
#define PG8_WAIT_L(n) asm volatile("s_waitcnt lgkmcnt(" #n ")" ::: "memory")
#define PG8_BAR __builtin_amdgcn_s_barrier()
#define PG8_SCHED __builtin_amdgcn_sched_barrier(0)
    Unit cur, nxt; int ui = 0;
    if (!S.next(0, cur)) return;
    f32x4 acc[2][2][4][2];
#pragma unroll
    for (int a = 0; a < 2; ++a)
#pragma unroll
        for (int b = 0; b < 2; ++b)
#pragma unroll
            for (int m = 0; m < 4; ++m)
#pragma unroll
                for (int n = 0; n < 2; ++n) acc[a][b][m][n] = (f32x4){0.f, 0.f, 0.f, 0.f};
    bf16x8 At[4][2], B0[2][2], B1[2][2];
    const char* cA = (const char*)((Epi::PAIRED && cur.sel) ? g.A2 : g.A) + (size_t)cur.pm * tstepA; const char* cB = (const char*)((Epi::PAIRED && cur.sel) ? g.Bt2 : g.Bt) + (size_t)cur.pn * tstepB;
    S.a_ready(cur);
    if constexpr (SP2) {
        PG8_STAGE(PG8_SB(0, 0), cB, voffB); PG8_STAGE(PG8_SB(0, 1), cB + hstepB, voffB); PG8_STAGE(PG8_SA(0, 0), cA, voffA); PG8_STAGE(PG8_SA(0, 1), cA + hstepA, voffA);
        if (wr == 1) PG8_BAR;
        PG8_WAIT_V(2); PG8_BAR;
        PG8_STAGE(PG8_SB(1, 0), cB + kstep, voffB); PG8_STAGE(PG8_SA(1, 0), cA + kstep, voffA); PG8_STAGE(PG8_SB(1, 1), cB + hstepB + kstep, voffB);
        PG8_WAIT_V(6); PG8_BAR;
    } else {
        PG8_STAGE(PG8_SB(0, 0), cB, voffB); PG8_STAGE(PG8_SA(0, 0), cA, voffA); PG8_STAGE(PG8_SB(0, 1), cB + hstepB, voffB); PG8_STAGE(PG8_SA(0, 1), cA + hstepA, voffA);
        if (wr == 1) PG8_BAR;
        PG8_WAIT_V(4); PG8_BAR;
        PG8_STAGE(PG8_SB(1, 0), cB + kstep, voffB); PG8_STAGE(PG8_SA(1, 0), cA + kstep, voffA); PG8_STAGE(PG8_SB(1, 1), cB + hstepB + kstep, voffB);
        PG8_WAIT_V(6); PG8_BAR;
    }
    for (;;) {
        const bool has_next = S.next(ui + 1, nxt);
        const char* nA = has_next ? (const char*)((Epi::PAIRED && nxt.sel) ? g.A2 : g.A) + (size_t)nxt.pm * tstepA : cA; const char* nB = has_next ? (const char*)((Epi::PAIRED && nxt.sel) ? g.Bt2 : g.Bt) + (size_t)nxt.pn * tstepB : cB;
        for (int t = 0; t < nt; t += 2) {
            const bool last = (t == nt - 2);
            const char* a1 = cA + (size_t)(t + 1) * kstep;
            const char* a2 = last ? nA : cA + (size_t)(t + 2) * kstep; const char* b2 = last ? nB : cB + (size_t)(t + 2) * kstep;
            const char* a3 = a2 + kstep; const char* b3 = b2 + kstep;
            if (last && has_next) S.a_ready(nxt);
            if constexpr (SP2) {
            PG8_LDB(B0, 0, 0); PG8_LDB(B1, 0, 1); PG8_SCHED; PG8_LDA(At, 0, 0); PG8_STAGE(PG8_SA(1, 1), a1 + hstepA, voffA);
            PG8_WAIT_V(8); PG8_WAIT_L(0); PG8_BAR; PG8_MMA(0, 0, At, B0); PG8_MMA(0, 1, At, B1); PG8_BAR; PG8_SCHED;
            PG8_LDA(At, 0, 1); PG8_STAGE(PG8_SB(0, 0), b2, voffB); PG8_STAGE(PG8_SB(0, 1), b2 + hstepB, voffB); PG8_STAGE(PG8_SA(0, 0), a2, voffA);
            PG8_WAIT_V(8); PG8_WAIT_L(0); PG8_BAR; PG8_MMA(1, 0, At, B0); PG8_MMA(1, 1, At, B1); PG8_BAR; PG8_SCHED;
            PG8_LDB(B0, 1, 0); PG8_LDB(B1, 1, 1); PG8_SCHED; PG8_LDA(At, 1, 0); PG8_STAGE(PG8_SA(0, 1), a2 + hstepA, voffA);
            PG8_WAIT_V(8); PG8_WAIT_L(0); PG8_BAR; PG8_MMA(0, 0, At, B0); PG8_MMA(0, 1, At, B1); PG8_BAR; PG8_SCHED;
            PG8_LDA(At, 1, 1); PG8_STAGE(PG8_SB(1, 0), b3, voffB); PG8_STAGE(PG8_SB(1, 1), b3 + hstepB, voffB); PG8_STAGE(PG8_SA(1, 0), a3, voffA);
            PG8_WAIT_V(8); PG8_WAIT_L(0); PG8_BAR; PG8_MMA(1, 0, At, B0); PG8_MMA(1, 1, At, B1); PG8_BAR; PG8_SCHED;
            } else {
            PG8_LDB(B0, 0, 0); PG8_SCHED; PG8_LDA(At, 0, 0); PG8_STAGE(PG8_SA(1, 1), a1 + hstepA, voffA);
            PG8_WAIT_L(8); PG8_BAR; PG8_WAIT_L(0); PG8_MMA(0, 0, At, B0); PG8_BAR; PG8_SCHED;
            PG8_LDB(B1, 0, 1); PG8_STAGE(PG8_SB(0, 0), b2, voffB);
            PG8_BAR; PG8_WAIT_L(0); PG8_MMA(0, 1, At, B1); PG8_BAR;
            PG8_LDA(At, 0, 1); PG8_STAGE(PG8_SA(0, 0), a2, voffA);
            PG8_BAR; PG8_WAIT_L(0); PG8_MMA(1, 0, At, B0); PG8_BAR; PG8_SCHED;
            PG8_STAGE(PG8_SB(0, 1), b2 + hstepB, voffB);
            PG8_WAIT_V(6); PG8_BAR; PG8_MMA(1, 1, At, B1); PG8_BAR;
            PG8_LDB(B0, 1, 0); PG8_SCHED; PG8_LDA(At, 1, 0); PG8_STAGE(PG8_SA(0, 1), a2 + hstepA, voffA);
            PG8_WAIT_L(8); PG8_BAR; PG8_WAIT_L(0); PG8_MMA(0, 0, At, B0); PG8_BAR; PG8_SCHED;
            PG8_LDB(B1, 1, 1); PG8_STAGE(PG8_SB(1, 0), b3, voffB);
            PG8_BAR; PG8_WAIT_L(0); PG8_MMA(0, 1, At, B1); PG8_BAR;
            PG8_LDA(At, 1, 1); PG8_STAGE(PG8_SA(1, 0), a3, voffA);
            PG8_BAR; PG8_WAIT_L(0); PG8_MMA(1, 0, At, B0); PG8_BAR; PG8_SCHED;
            PG8_STAGE(PG8_SB(1, 1), b3 + hstepB, voffB);
            PG8_WAIT_V(6); PG8_BAR; PG8_MMA(1, 1, At, B1); PG8_BAR;
            }
        }
        if constexpr (ALIGN_EPI) { if (wr == 0) PG8_BAR; }
        bool keep_acc = false;
        int t2_ = threadIdx.x; asm volatile("" : "+v"(t2_)); const int fr2 = t2_ & 15, fq2 = (t2_ & 63) >> 4;
        if constexpr (Epi::PAIRED) { if (cur.sel == 0) { E.mid(acc, cur, wr, wc, fr2, fq2); keep_acc = true; } else { E(acc, cur, wr, wc, fr2, fq2); S.done(cur); } }
        else if constexpr (!Epi::AFTER_DRAIN) { E(acc, cur, wr, wc, fr2, fq2); S.done(cur); }
        if (!has_next) break;
        if (!keep_acc)
#pragma unroll
        for (int a = 0; a < 2; ++a)
#pragma unroll
            for (int b = 0; b < 2; ++b)
#pragma unroll
                for (int m = 0; m < 4; ++m)
#pragma unroll
                    for (int n = 0; n < 2; ++n) acc[a][b][m][n] = (f32x4){0.f, 0.f, 0.f, 0.f};
        cur = nxt; cA = nA; cB = nB; ++ui;
        if constexpr (ALIGN_EPI) { if (wr == 1) PG8_BAR; }
    }
    PG8_WAIT_V(0);
    if constexpr (!ALIGN_EPI) { if (wr == 0) PG8_BAR; }
    PG8_BAR;
    if constexpr (Epi::AFTER_DRAIN) { E.fused(acc, cur, wr, wc, fr, fq, lds, wid, lane); S.done(cur); }
#undef PG8_SA
#undef PG8_SB
#undef PG8_STAGE
#undef PG8_LDA
#undef PG8_LDB
#undef PG8_MMA
#undef PG8_WAIT_V
#undef PG8_WAIT_L
#undef PG8_BAR
#undef PG8_SCHED
}
}
#define LAS __attribute__((address_space(3)))
#define XB_TMO      128
#define XB_XCNT(j)  (256  + 64 * (j))
#define XB_XSUB(j)  (1280 + 64 * (j))
#define XB_XGEN(j)  (2304 + 64 * (j))
#define XB_TOP      3328
#define XB_TOPGEN   3392
#define XCD_BAR_WORDS 3456
#define XB_SPIN_CAP (1u << 18)

__device__ __forceinline__ unsigned xb_ld(unsigned* p)              { return __hip_atomic_load(p, __ATOMIC_RELAXED, __HIP_MEMORY_SCOPE_AGENT); }
__device__ __forceinline__ unsigned xb_add(unsigned* p, unsigned v) { return __hip_atomic_fetch_add(p, v, __ATOMIC_RELAXED, __HIP_MEMORY_SCOPE_AGENT); }
__device__ __forceinline__ unsigned xb_xcc_id() { return (unsigned)__builtin_amdgcn_s_getreg((3 << 11) | 20) & 0xFu; }
#define XB_SPIN(cond, bar) do { unsigned _sp = 0; while (cond) { __builtin_amdgcn_s_sleep(1); \
    if ((++_sp & 255u) == 0u) { if (xb_ld(&(bar)[XB_TMO])) break; if (_sp > XB_SPIN_CAP) { atomicAdd(&(bar)[XB_TMO], 1u); break; } } } } while (0)

struct XcdBarrier {
    unsigned* bar; unsigned x;
    volatile LAS unsigned* st;
};

__device__ __forceinline__ XcdBarrier xcd_barrier_post(unsigned* bar, volatile LAS unsigned* st) {
    XcdBarrier b; b.bar = bar; b.x = xb_xcc_id(); b.st = st;
    if (threadIdx.x == 0) (void)xb_add(&bar[XB_XCNT(b.x)], 1u);
    return b;
}
__device__ __forceinline__ void xcd_barrier_complete(unsigned* bar, unsigned x, unsigned& nloc, unsigned& nx) {
    const unsigned G = gridDim.x * gridDim.y * gridDim.z;
    unsigned sum, cnt, mine, sp = 0u;
    for (;;) {
        sum = 0u; cnt = 0u; mine = 0u;
#pragma unroll
        for (unsigned j = 0; j < 16; ++j) { const unsigned c = xb_ld(&bar[XB_XCNT(j)]); sum += c; cnt += (c > 0u) ? 1u : 0u; mine = (j == x) ? c : mine; }
        if (sum == G) break;
        __builtin_amdgcn_s_sleep(1);
        if ((++sp & 255u) == 0u) { if (xb_ld(&bar[XB_TMO])) break; if (sp > XB_SPIN_CAP) { atomicAdd(&bar[XB_TMO], 1u); break; } }
    }
    nloc = mine > 0u ? mine : 1u; nx = cnt > 0u ? cnt : 1u;
}

__device__ __forceinline__ void xcd_barrier(const XcdBarrier& b) {
    asm volatile("s_waitcnt vmcnt(0)" ::: "memory");
    __syncthreads();
    if (threadIdx.x == 0) {
        unsigned* bar = b.bar;
        __builtin_amdgcn_s_waitcnt(0);
        unsigned nloc = b.st[0], nx = b.st[1];
        if (nloc == 0u) { xcd_barrier_complete(bar, b.x, nloc, nx); b.st[0] = nloc; b.st[1] = nx; }
        const unsigned old = xb_add(&bar[XB_XSUB(b.x)], 1u);
        const unsigned gen = old / nloc;
        if (old + 1u == (gen + 1u) * nloc) {
            __builtin_amdgcn_fence(__ATOMIC_RELEASE, "agent");
            asm volatile("s_waitcnt vmcnt(0)" ::: "memory");
            const unsigned og = xb_add(&bar[XB_TOP], 1u);
            const unsigned tg = og / nx;
            if (og + 1u == (tg + 1u) * nx) xb_add(&bar[XB_TOPGEN], 1u);
            else XB_SPIN(xb_ld(&bar[XB_TOPGEN]) == tg, bar);
            __builtin_amdgcn_fence(__ATOMIC_ACQUIRE, "agent");
            xb_add(&bar[XB_XGEN(b.x)], 1u);
            asm volatile("s_waitcnt vmcnt(0)" ::: "memory");
        } else {
            XB_SPIN(xb_ld(&bar[XB_XGEN(b.x)]) == gen, bar);
            __builtin_amdgcn_fence(__ATOMIC_ACQUIRE, "agent");
            asm volatile("s_waitcnt vmcnt(0)" ::: "memory");
        }
    }
    __syncthreads();
}
constexpr int NWAVES = 8, NTHR = 512;
constexpr int DM = 4096, SEQ = 8192, NMETA = 16, LTOK = SEQ + NMETA  , LP = 8448  ;
constexpr int NPROJ = 16128;
constexpr int DFF = 16384;
constexpr int GH = 8, GDK = 128, GDV = 256, GCH = 64, NXC = SEQ / GCH  ;
constexpr int MH = 16, MQK = 192, MNOPE = 128, MROPE = 64, MV = 128, QRANK = 1024, KVRANK = 512;
constexpr float EPS = 1e-6f;
constexpr float GLA_QSCALE = 0.08838834764831845f;
constexpr float MLA_QSCALE = 0.07216878364870323f * 1.4426950408889634f;
constexpr size_t KiB = 1024, MiB = 1024 * 1024;
constexpr size_t WS_CTL = 0, CTL_BYTES = 1 * MiB;
constexpr size_t WS_W1T = WS_CTL + CTL_BYTES;
constexpr size_t WS_W2T = WS_W1T + (size_t)DFF * DM * 2;
constexpr size_t WS_WOT = WS_W2T + (size_t)DFF * DM * 2;
constexpr size_t WS_WGT = WS_WOT + (size_t)DM * DM * 2;
constexpr size_t WS_WMT = WS_WGT + (size_t)DM * 2048 * 2;
constexpr size_t WS_WUQT = WS_WMT + (size_t)DM * 2048 * 2;
constexpr size_t WS_WUKVT = WS_WUQT + (size_t)3072 * 1024 * 2;
constexpr size_t WS_STATS = WS_WUKVT + (size_t)4096 * 512 * 2;
constexpr size_t ST_RS1 = WS_STATS;
constexpr size_t ST_CQSS = ST_RS1 + (size_t)LP * 4;
constexpr size_t ST_CKVSS = ST_CQSS + (size_t)SEQ * 16 * 4;
constexpr size_t ST_H1SS = ST_CKVSS + (size_t)LP * 8 * 4;
constexpr size_t ST_H2SS = ST_H1SS + (size_t)SEQ * 64 * 4;
constexpr size_t ST_COS = ST_H2SS + (size_t)SEQ * 64 * 4;
constexpr size_t ST_SIN = ST_COS + (size_t)LTOK * 32 * 4;
constexpr size_t ST_DLF = ST_SIN + (size_t)LTOK * 32 * 4;
constexpr size_t ST_DLB = ST_DLF + (size_t)129 * 8 * 128 * 4;
constexpr size_t ST_SMALL = ST_DLB + (size_t)128 * 8 * 128 * 4;
constexpr size_t WS_R1 = (ST_SMALL + (size_t)LP * 96 * 4 + 4095) / 4096 * 4096;
constexpr size_t WS_WINT = WS_R1;
constexpr size_t WS_QM = WS_R1;
constexpr size_t WS_KF = WS_QM + (size_t)SEQ * 3072 * 2;
constexpr size_t WS_R2 = WS_R1 + (size_t)NPROJ * DM * 2;
static_assert(WS_KF + (size_t)LP * 3072 * 2 <= WS_R2, "R1 overlay");
constexpr size_t WS_H0B = WS_R2;
constexpr size_t WS_AO = WS_R2;
constexpr size_t WS_AG = WS_AO + (size_t)SEQ * 2048 * 2;
constexpr size_t WS_P = WS_R2 + (size_t)LP * DM * 2;
static_assert(WS_AG + (size_t)SEQ * 2048 * 2 <= WS_P, "R2 overlay");
constexpr size_t WS_GQ = WS_P;
constexpr size_t WS_GK = WS_GQ + (size_t)SEQ * 1024 * 2;
constexpr size_t WS_GV = WS_GK + (size_t)LP * 1024 * 2;
constexpr size_t WS_GOG = WS_GV + (size_t)LP * 2048 * 2;
constexpr size_t WS_MERGED = WS_P;
static_assert(WS_MERGED + (size_t)SEQ * DM * 2 <= WS_GOG, "merged overlay");
constexpr size_t WS_CQ = WS_GOG + (size_t)SEQ * 2048 * 2;
constexpr size_t WS_CKV = WS_CQ + (size_t)SEQ * 1024 * 2;
constexpr size_t WS_GA = WS_CKV + (size_t)LP * 512 * 2;
constexpr size_t WS_GB = WS_GA + (size_t)SEQ * DM * 2;
constexpr size_t WS_U = WS_R1;
constexpr size_t WS_VB = WS_GB + (size_t)SEQ * DM * 2;
constexpr int LDU = DFF;
static_assert(WS_U + (size_t)SEQ * LDU * 2 <= WS_VB, "U overlay");
constexpr size_t WS_KHTF = WS_VB + (size_t)LP * 2048 * 2;
constexpr size_t WS_KHTB = WS_KHTF + (size_t)129 * 8 * 128 * 64 * 2;
constexpr size_t WS_VT = WS_KHTB + (size_t)128 * 8 * 128 * 64 * 2;
constexpr size_t WS_SNAP = WS_VT + (size_t)129 * 8 * 256 * 64 * 2;
constexpr size_t WS_H1B = WS_SNAP;
constexpr size_t WS_END = WS_SNAP + (size_t)2 * 128 * 8 * 256 * 128 * 2;
static_assert(WS_END <= (size_t)1024 * MiB, "d_ws budget: 4 x largest tensor = 1 GiB");
constexpr size_t WS_H0F8 = WS_W1T;
constexpr size_t WS_WF8 = WS_H0F8 + (size_t)LP * DM;
static_assert(WS_WF8 + (size_t)8192 * DM <= WS_W1T + (size_t)DFF * DM * 2, "fp8 operands inside the W1T region");
constexpr size_t WS_CQ8 = WS_WF8 + (size_t)8192 * DM;
constexpr size_t WS_CKV8 = WS_CQ8 + (size_t)SEQ * QRANK;
constexpr size_t WS_WUQ8 = WS_CKV8 + (size_t)LP * KVRANK;
constexpr size_t WS_WUKV8 = WS_WUQ8 + (size_t)3072 * QRANK;
static_assert(WS_WUKV8 + (size_t)4096 * KVRANK <= WS_W1T + (size_t)DFF * DM * 2, "fp8 operands inside the W1T region");
constexpr float F8_UQSCALE = 32.f, F8_UKVSCALE = 16.f;
constexpr int F8_COL0 = 7680, F8_COL1 = 15872;
constexpr float F8_WSCALE = 64.f;
constexpr int CW_BAR = 4096;
constexpr int LDS_BYTES = 163840;
constexpr int LDS_CTL = LDS_BYTES - 256;

#define GAS __attribute__((address_space(1)))
typedef unsigned short bf16;
typedef float f32x4 __attribute__((ext_vector_type(4)));
typedef float f32x16 __attribute__((ext_vector_type(16)));
typedef short bf16x8 __attribute__((ext_vector_type(8)));
typedef short s16x4 __attribute__((ext_vector_type(4)));
typedef unsigned u32x4 __attribute__((ext_vector_type(4)));
typedef unsigned u32x2 __attribute__((ext_vector_type(2)));
#define LDS_WAIT() asm volatile("s_waitcnt lgkmcnt(0)" ::: "memory")
#define VM_WAIT() asm volatile("s_waitcnt vmcnt(0)" ::: "memory")
#define SBAR() __builtin_amdgcn_sched_barrier(0)
typedef float f32x2_ __attribute__((ext_vector_type(2)));
typedef __bf16 bf16x2_ __attribute__((ext_vector_type(2)));
__device__ __forceinline__ unsigned cvtpk(float lo, float hi) { const f32x2_ v = {lo, hi}; return __builtin_bit_cast(unsigned, __builtin_convertvector(v, bf16x2_)); }
__device__ __forceinline__ float bf2f(unsigned short b) { return __uint_as_float(((unsigned)b) << 16); }
__device__ __forceinline__ float bflo(unsigned w) { return __uint_as_float(w << 16); }
__device__ __forceinline__ float bfhi(unsigned w) { return __uint_as_float(w & 0xffff0000u); }
__device__ __forceinline__ unsigned short f2bf(float f) { return (unsigned short)(cvtpk(f, 0.f) & 0xffffu); }
__device__ __forceinline__ float wave_sum(float v) {
#pragma unroll
    for (int o = 1; o < 64; o <<= 1) v += __shfl_xor(v, o);
    return v;
}
__device__ __forceinline__ float sigmoidf_(float x) { return __builtin_amdgcn_rcpf(1.f + __expf(-x)); }
__device__ __forceinline__ float logsig16(float z) { return (fminf(z, 0.f) - __logf(1.f + __expf(-fabsf(z)))) * 0.0625f; }
template <int KIND> __device__ __forceinline__ int srccol(int n) {
    if (KIND == 1) {
        if (n < 6144) return n;
        if (n < 7168) return 6176 + (n - 6144);
        if (n < 7680) return 7200 + (n - 7168);
        if (n < 15872) return 7776 + (n - 7680);
        if (n < 15936) return 7712 + (n - 15872);
        if (n < 15968) return 6144 + (n - 15936);
        return -1;
    } else if (KIND == 2) {
        const int h = n / 192, w = n - h * 192;
        if (w < 128) return n;
        const int p = w - 128, gp = p >> 5, fq = (p >> 3) & 3, nn = (p >> 2) & 1, j = p & 3;
        return h * 192 + 128 + 32 * nn + 16 * gp + 4 * fq + j;
    }
    return n;
}
constexpr int P0_SCR = 64 * 65 * 4;
struct P0Item { const float* W; const float* gain; bf16* WT; int K, N, kind, k0, n0; unsigned char* F8; float fscale; };
__device__ __forceinline__ unsigned pk4_fp8(float a, float b, float c, float d) { int w = __builtin_amdgcn_cvt_pk_fp8_f32(a, b, 0, false); w = __builtin_amdgcn_cvt_pk_fp8_f32(c, d, w, true); return (unsigned)w; }
template <int KIND> __device__ __forceinline__ void p0_load_k(const P0Item& d, f32x4 (&v)[16], int lane) {
    const int sc = srccol<KIND>(d.n0 + 4 * (lane & 15)), kr = lane >> 4;
#pragma unroll
    for (int i = 0; i < 16; ++i) v[i] = sc >= 0 ? *(const GAS f32x4*)(d.W + (size_t)(d.k0 + 4 * i + kr) * d.N + sc) : (f32x4){0.f, 0.f, 0.f, 0.f};
}
__device__ __forceinline__ void p0_load(const P0Item& d, f32x4 (&v)[16], int lane) {
    if (d.kind == 1) p0_load_k<1>(d, v, lane); else if (d.kind == 2) p0_load_k<2>(d, v, lane); else p0_load_k<0>(d, v, lane);
}
__device__ __forceinline__ void p0_finish(const P0Item& d, const f32x4 (&v)[16], LAS float* scr, int lane) {
    const int kr = lane >> 4, c4 = 4 * (lane & 15), c = lane & 7;
    f32x4 g0 = (f32x4){1.f, 1.f, 1.f, 1.f}, g1 = g0;
    if (d.gain) { g0 = *(const GAS f32x4*)(d.gain + d.k0 + 8 * c); g1 = *(const GAS f32x4*)(d.gain + d.k0 + 8 * c + 4); }
#pragma unroll
    for (int i = 0; i < 16; ++i) { LAS float* w = scr + (4 * i + kr) * 65 + c4; w[0] = v[i][0]; w[1] = v[i][1]; w[2] = v[i][2]; w[3] = v[i][3]; }
    LDS_WAIT(); asm volatile("" ::: "memory");
#pragma unroll
    for (int j = 0; j < 8; ++j) { const int n = (lane >> 3) + 8 * j; const LAS float* s = scr + (8 * c) * 65 + n;
        u32x4 o; o.x = cvtpk(s[0 * 65] * g0[0], s[1 * 65] * g0[1]); o.y = cvtpk(s[2 * 65] * g0[2], s[3 * 65] * g0[3]); o.z = cvtpk(s[4 * 65] * g1[0], s[5 * 65] * g1[1]); o.w = cvtpk(s[6 * 65] * g1[2], s[7 * 65] * g1[3]);
        if (d.F8) { u32x2 o8; o8.x = pk4_fp8(s[0 * 65] * g0[0] * d.fscale, s[1 * 65] * g0[1] * d.fscale, s[2 * 65] * g0[2] * d.fscale, s[3 * 65] * g0[3] * d.fscale);
                    o8.y = pk4_fp8(s[4 * 65] * g1[0] * d.fscale, s[5 * 65] * g1[1] * d.fscale, s[6 * 65] * g1[2] * d.fscale, s[7 * 65] * g1[3] * d.fscale);
                    *(GAS u32x2*)(d.F8 + (size_t)n * d.K + d.k0 + 8 * c) = o8; }
        else *(GAS u32x4*)(d.WT + (size_t)(d.n0 + n) * d.K + d.k0 + 8 * c) = o; }
    LDS_WAIT(); asm volatile("" ::: "memory");
}
__device__ __forceinline__ void p0_mk(P0Item& d, const float* W, int K, int N, const float* gain, bf16* WT, int kind, int item, int nblk) {
    const int kb = item / nblk, nb = item - kb * nblk; d.W = W; d.gain = gain; d.WT = WT; d.K = K; d.N = N; d.kind = kind; d.k0 = 64 * kb; d.n0 = 64 * nb; d.F8 = nullptr; d.fscale = F8_WSCALE;
}
__device__ const double ROPE_INVF[32] = {
1.00000000000000000e+00, 7.49894209332455874e-01, 5.62341325190349073e-01, 4.21696503428582226e-01, 3.16227766016837941e-01, 2.37137370566165517e-01, 1.77827941003892293e-01, 1.33352143216332403e-01,
1.00000000000000006e-01, 7.49894209332455791e-02, 5.62341325190349114e-02, 4.21696503428582239e-02, 3.16227766016837913e-02, 2.37137370566165538e-02, 1.77827941003892293e-02, 1.33352143216332406e-02,
1.00000000000000002e-02, 7.49894209332455791e-03, 5.62341325190349097e-03, 4.21696503428582292e-03, 3.16227766016837939e-03, 2.37137370566165538e-03, 1.77827941003892275e-03, 1.33352143216332406e-03,
1.00000000000000002e-03, 7.49894209332455856e-04, 5.62341325190349097e-04, 4.21696503428582237e-04, 3.16227766016837939e-04, 2.37137370566165538e-04, 1.77827941003892270e-04, 1.33352143216332395e-04 };
__device__ __forceinline__ void rope_cs(int pos, int i, float& c, float& s) {
    const double x = (double)pos * ROPE_INVF[i];
    const double k = __builtin_rint(x * 0.15915494309189534561);
    double r = __builtin_fma(-k, 6.283185307179586, x); r = __builtin_fma(-k, 2.4492935982947064e-16, r);
    const double r2 = r * r;
    double ss = 1.0, cc = 1.0;
#pragma unroll
    for (int n = 14; n >= 1; --n) { ss = 1.0 - ss * r2 * (1.0 / (double)((2 * n) * (2 * n + 1))); cc = 1.0 - cc * r2 * (1.0 / (double)((2 * n - 1) * (2 * n))); }
    s = (float)(r * ss); c = (float)cc;
}
struct P0Args { const float *x, *meta, *ln1, *w_in, *q_norm, *w_uq, *kv_norm, *w_ukv, *w_gla_out, *w_mla_out, *w_o, *ln2, *w_ff1, *w_ff2; unsigned char* ws; };
__device__ __forceinline__ bool p0_item_early(const P0Args& a, int it, P0Item& d) {
    constexpr int I_IN = (DM / 64) * (NPROJ / 64), I_UQ = (QRANK / 64) * (3072 / 64), I_UKV = (KVRANK / 64) * (4096 / 64), NITEMS = I_IN + I_UQ + I_UKV;
    if (it >= NITEMS) return false;
    unsigned char* ws = a.ws; int r = it;
    if (r < I_IN) { p0_mk(d, a.w_in, DM, 15968, a.ln1, (bf16*)(ws + WS_WINT), 1, r, NPROJ / 64);
                    if (d.n0 >= F8_COL0 && d.n0 < F8_COL1) d.F8 = ws + WS_WF8 + (size_t)(d.n0 - F8_COL0) * DM;
                    return true; } r -= I_IN;
    if (r < I_UQ) { p0_mk(d, a.w_uq, QRANK, 3072, a.q_norm, (bf16*)(ws + WS_WUQT), 2, r, 3072 / 64); d.F8 = ws + WS_WUQ8 + (size_t)d.n0 * QRANK; d.fscale = F8_UQSCALE; return true; } r -= I_UQ;
    p0_mk(d, a.w_ukv, KVRANK, 4096, a.kv_norm, (bf16*)(ws + WS_WUKVT), 0, r, 4096 / 64); d.F8 = ws + WS_WUKV8 + (size_t)d.n0 * KVRANK; d.fscale = F8_UKVSCALE; return true;
}
__device__ __forceinline__ bool p0_item_late(const P0Args& a, int it, P0Item& d) {
    constexpr int I_F1 = (DM / 64) * (DFF / 64), I_F2 = (DFF / 64) * (DM / 64), I_O = (DM / 64) * (DM / 64), I_G = (2048 / 64) * (DM / 64), I_M = I_G, NITEMS = I_F1 + I_F2 + I_O + I_G + I_M;
    if (it >= NITEMS) return false;
    unsigned char* ws = a.ws; int r = it;
    if (r < I_G) { p0_mk(d, a.w_gla_out, 2048, DM, nullptr, (bf16*)(ws + WS_WGT), 0, r, DM / 64); return true; } r -= I_G;
    if (r < I_M) { p0_mk(d, a.w_mla_out, 2048, DM, nullptr, (bf16*)(ws + WS_WMT), 0, r, DM / 64); return true; } r -= I_M;
    if (r < I_O) { p0_mk(d, a.w_o, DM, DM, nullptr, (bf16*)(ws + WS_WOT), 0, r, DM / 64); return true; } r -= I_O;
    if (r < I_F1) { p0_mk(d, a.w_ff1, DM, DFF, a.ln2, (bf16*)(ws + WS_W1T), 0, r, DFF / 64); return true; } r -= I_F1;
    p0_mk(d, a.w_ff2, DFF, DM, nullptr, (bf16*)(ws + WS_W2T), 0, r, DM / 64); return true;
}
template <bool LATE> __device__ __forceinline__ void p0_weights(const P0Args& a, LAS unsigned char* lds, int gw, int NGW, int wave, int lane) {
    LAS float* scr = (LAS float*)(lds + wave * P0_SCR);
    P0Item cur, nxt; f32x4 va[16], vb[16];
    bool have = LATE ? p0_item_late(a, gw, cur) : p0_item_early(a, gw, cur);
    if (have) p0_load(cur, va, lane);
    for (int it = gw; have; it += 2 * NGW) {
        const bool h1 = LATE ? p0_item_late(a, it + NGW, nxt) : p0_item_early(a, it + NGW, nxt);
        if (h1) p0_load(nxt, vb, lane);
        p0_finish(cur, va, scr, lane);
        if (!h1) break;
        have = LATE ? p0_item_late(a, it + 2 * NGW, cur) : p0_item_early(a, it + 2 * NGW, cur);
        if (have) p0_load(cur, va, lane);
        p0_finish(nxt, vb, scr, lane);
    }
}
__device__ __forceinline__ void p0_weights_early(const P0Args& a, LAS unsigned char* lds, int gw, int NGW, int wave, int lane) { p0_weights<false>(a, lds, gw, NGW, wave, lane); }
__device__ __forceinline__ void p0_weights_late(const P0Args& a, LAS unsigned char* lds, int gw, int NGW, int wave, int lane) { p0_weights<true>(a, lds, gw, NGW, wave, lane); }
__device__ __forceinline__ void p0_prologue(const P0Args& a, LAS unsigned char* lds, int gw, int NGW, int wave, int lane) {
    p0_weights_early(a, lds, gw, NGW, wave, lane);
    unsigned char* ws = a.ws;
    bf16* H0B = (bf16*)(ws + WS_H0B); float* RS1 = (float*)(ws + ST_RS1);
    for (int m = gw; m < LP; m += NGW) {
        GAS u32x2* o8 = (GAS u32x2*)(H0B + (size_t)m * DM) + lane;
        GAS unsigned* f4 = (GAS unsigned*)(ws + WS_H0F8 + (size_t)m * DM) + lane;
        if (m >= LTOK) {
#pragma unroll
            for (int j = 0; j < 16; ++j) { o8[64 * j] = (u32x2){0u, 0u}; f4[64 * j] = 0u; }
            if (lane == 0) RS1[m] = 0.f;
            continue;
        }
        const float* src = m < SEQ ? a.x + (size_t)m * DM : a.meta + (size_t)(m - SEQ) * DM;
        const GAS f32x4* xr = (const GAS f32x4*)src + lane;
        f32x4 v[16]; float s = 0.f;
#pragma unroll
        for (int j = 0; j < 16; ++j) { v[j] = xr[64 * j]; s += (v[j].x * v[j].x + v[j].y * v[j].y) + (v[j].z * v[j].z + v[j].w * v[j].w); }
        s = wave_sum(s);
        if (lane == 0) RS1[m] = 1.f / sqrtf(s * (1.f / DM) + EPS);
#pragma unroll
        for (int j = 0; j < 16; ++j) { o8[64 * j] = (u32x2){cvtpk(v[j].x, v[j].y), cvtpk(v[j].z, v[j].w)}; f4[64 * j] = pk4_fp8(v[j].x, v[j].y, v[j].z, v[j].w); }
    }
    float* COS = (float*)(ws + ST_COS); float* SIN = (float*)(ws + ST_SIN);
    for (int i = gw * 64 + lane; i < LTOK * 32; i += NGW * 64) { float c, s; rope_cs(i >> 5, i & 31, c, s); COS[i] = c; SIN[i] = s; }
}
__device__ __forceinline__ void st_bf8(bf16* p, f32x4 v0, f32x4 v1) { u32x4 w; w.x = cvtpk(v0[0], v0[1]); w.y = cvtpk(v0[2], v0[3]); w.z = cvtpk(v1[0], v1[1]); w.w = cvtpk(v1[2], v1[3]); *(GAS u32x4*)p = w; }
__device__ __forceinline__ void st_bf8_nt(bf16* p, f32x4 v0, f32x4 v1) { u32x4 w; w.x = cvtpk(v0[0], v0[1]); w.y = cvtpk(v0[2], v0[3]); w.z = cvtpk(v1[0], v1[1]); w.w = cvtpk(v1[2], v1[3]); __builtin_nontemporal_store(w, (GAS u32x4*)p); }
__device__ __forceinline__ void ld_bf8(const bf16* p, f32x4& a, f32x4& b) { const u32x4 w = *(const GAS u32x4*)p; a = (f32x4){bflo(w.x), bfhi(w.x), bflo(w.y), bfhi(w.y)}; b = (f32x4){bflo(w.z), bfhi(w.z), bflo(w.w), bfhi(w.w)}; }
__device__ __forceinline__ float dot4(f32x4 a) { return (a[0] * a[0] + a[1] * a[1]) + (a[2] * a[2] + a[3] * a[3]); }
#define EPI_ROWS(ai, m) _Pragma("unroll") for (int ai = 0; ai < 2; ++ai) _Pragma("unroll") for (int m = 0; m < 4; ++m)

struct ProjOrder {
    pg8::StaticOrder so; int G, c, f8;
    __device__ void init(int G_, int c_, int f8_) { f8 = f8_; so.init(SEQ, (f8_ ? 32 : 31) * 256, G_, c_); G = G_; c = c_; }
    __device__ __forceinline__ bool next(int i, pg8::Unit& u) const {
        const int L = i * G + c;
        if (f8) { const bool ok = so.next(i, u); u.pn += 30; return ok; }
        if (L < 32 * 31) { const bool ok = so.next(i, u); const int p2 = 2 * u.pn, q = p2 < 31 ? p2 : p2 - 31; u.pn = q < 30 ? q : 62; return ok; }
        const int e = L - 32 * 31; if (e >= 15) return false;
        u.pm = 32; u.pn = e < 12 ? 4 + e : (e == 12 ? 28 : (e == 13 ? 29 : 62)); return true;
    }
    __device__ __forceinline__ void a_ready(const pg8::Unit&) const {}
    __device__ __forceinline__ void done(const pg8::Unit&) const {}
};
struct EpiProj {
    static constexpr bool PERM = true, AFTER_DRAIN = false, PAIRED = false;
    unsigned char* ws; float wscale;
    template <int MODE> __device__ __forceinline__ void body(const f32x4 (&acc)[2][2][4][2], bf16* base, int ld, int ct, float* ss, int ssld, int row0, int cl, int wc, int fq) const {
        const float* RS1 = (const float*)(ws + ST_RS1); float* SMALL = (float*)(ws + ST_SMALL);
        float rsv[2][4];
        EPI_ROWS(ai, m) rsv[ai][m] = RS1[row0 + ai * 128 + m * 16] * wscale;
        EPI_ROWS(ai, m) {
            const int row = row0 + ai * 128 + m * 16; const float rs = rsv[ai][m]; float ssum = 0.f;
#pragma unroll
            for (int bj = 0; bj < 2; ++bj) {
                f32x4 v0 = acc[ai][bj][m][0] * rs, v1 = acc[ai][bj][m][1] * rs;
                if constexpr (MODE == 5) { if (bj == 0 && wc < 3) { GAS f32x4* d = (GAS f32x4*)(SMALL + (size_t)row * 96 + cl); d[0] = v0; d[1] = v1; } }
                else {
                    if constexpr (MODE == 1) { v0 = v0 * GLA_QSCALE; v1 = v1 * GLA_QSCALE; }
                    if constexpr (MODE == 2 || MODE == 3) {
                        f32x4 e0 = v0 * (-1.4426950408889634f), e1 = v1 * (-1.4426950408889634f);
#pragma unroll
                        for (int j = 0; j < 4; ++j) { e0[j] = __builtin_amdgcn_exp2f(e0[j]); e1[j] = __builtin_amdgcn_exp2f(e1[j]); }
                        asm volatile("" : "+v"(e0), "+v"(e1));
                        e0 = e0 + 1.f; e1 = e1 + 1.f;
#pragma unroll
                        for (int j = 0; j < 4; ++j) { e0[j] = __builtin_amdgcn_rcpf(e0[j]); e1[j] = __builtin_amdgcn_rcpf(e1[j]); }
                        asm volatile("" : "+v"(e0), "+v"(e1));
                        if constexpr (MODE == 2) { v0 = v0 * e0; v1 = v1 * e1; } else { v0 = e0; v1 = e1; } }
                    if constexpr (MODE == 4) ssum += dot4(v0) + dot4(v1);
                    if constexpr (MODE == 4) { u32x2 o8; o8.x = pk4_fp8(v0[0], v0[1], v0[2], v0[3]); o8.y = pk4_fp8(v1[0], v1[1], v1[2], v1[3]);
                        *(GAS u32x2*)((unsigned char*)base + (size_t)row * ld + ct * 256 + bj * 128 + cl) = o8; }
                    else st_bf8(base + (size_t)row * ld + ct * 256 + bj * 128 + cl, v0, v1);
                }
            }
            if constexpr (MODE == 4) { ssum += __shfl_xor(ssum, 16); ssum += __shfl_xor(ssum, 32); if (fq == 0) ss[(size_t)row * ssld + ct * 4 + wc] = ssum; }
        }
    }
    __device__ __forceinline__ void operator()(const f32x4 (&acc)[2][2][4][2], const pg8::Unit& u, int wr, int wc, int fr, int fq) const {
        const int pn = u.pn, row0 = u.pm * 256 + wr * 64 + fr, cl = wc * 32 + 8 * fq;
        int mode, ld, ct, ssld = 0; bf16* base = nullptr; float* ss = nullptr; bool xonly = true;
        if (pn < 4) { mode = 1; base = (bf16*)(ws + WS_GQ); ld = 1024; ct = pn; }
        else if (pn < 8) { mode = 0; base = (bf16*)(ws + WS_GK); ld = 1024; ct = pn - 4; xonly = false; }
        else if (pn < 16) { mode = 0; base = (bf16*)(ws + WS_GV); ld = 2048; ct = pn - 8; xonly = false; }
        else if (pn < 24) { mode = 2; base = (bf16*)(ws + WS_GOG); ld = 2048; ct = pn - 16; }
        else if (pn < 28) { mode = 4; base = (bf16*)(ws + WS_CQ8); ld = 1024; ct = pn - 24; ss = (float*)(ws + ST_CQSS); ssld = 16; }
        else if (pn < 30) { mode = 4; base = (bf16*)(ws + WS_CKV8); ld = 512; ct = pn - 28; ss = (float*)(ws + ST_CKVSS); ssld = 8; xonly = false; }
        else if (pn < 46) { mode = 3; base = (bf16*)(ws + WS_GA); ld = 4096; ct = pn - 30; }
        else if (pn < 62) { mode = 3; base = (bf16*)(ws + WS_GB); ld = 4096; ct = pn - 46; }
        else { mode = 5; ld = 96; ct = 0; xonly = false; }
        if (xonly && u.pm >= 32) return;
        if (mode == 3) body<3>(acc, base, ld, ct, ss, ssld, row0, cl, wc, fq);
        else if (mode == 2) body<2>(acc, base, ld, ct, ss, ssld, row0, cl, wc, fq);
        else if (mode == 0) body<0>(acc, base, ld, ct, ss, ssld, row0, cl, wc, fq);
        else if (mode == 1) body<1>(acc, base, ld, ct, ss, ssld, row0, cl, wc, fq);
        else if (mode == 4) body<4>(acc, base, ld, ct, ss, ssld, row0, cl, wc, fq);
        else body<5>(acc, base, ld, ct, ss, ssld, row0, cl, wc, fq);
    }
};
struct EpiGate {
    static constexpr bool PERM = true, AFTER_DRAIN = false, PAIRED = false;
    unsigned char* ws;
    __device__ __forceinline__ void operator()(const f32x4 (&acc)[2][2][4][2], const pg8::Unit& u, int wr, int wc, int fr, int fq) const {
        const float* RS1 = (const float*)(ws + ST_RS1);
        const int pn = u.pn, row0 = u.pm * 256 + wr * 64 + fr, cl = wc * 32 + 8 * fq;
        bf16* base = (bf16*)(ws + (pn < 46 ? WS_GA : WS_GB)) + (pn < 46 ? pn - 30 : pn - 46) * 256 + cl;
        EPI_ROWS(ai, m) {
            const int row = row0 + ai * 128 + m * 16; const float rs = RS1[row] * (-1.4426950408889634f / F8_WSCALE);
#pragma unroll
            for (int bj = 0; bj < 2; ++bj) {
                f32x4 e0 = acc[ai][bj][m][0] * rs, e1 = acc[ai][bj][m][1] * rs;
#pragma unroll
                for (int j = 0; j < 4; ++j) { e0[j] = __builtin_amdgcn_exp2f(e0[j]); e1[j] = __builtin_amdgcn_exp2f(e1[j]); }
                e0 = e0 + 1.f; e1 = e1 + 1.f;
#pragma unroll
                for (int j = 0; j < 4; ++j) { e0[j] = __builtin_amdgcn_rcpf(e0[j]); e1[j] = __builtin_amdgcn_rcpf(e1[j]); }
                st_bf8(base + (size_t)row * DM + bj * 128, e0, e1);
            }
        }
    }
};
struct EpiQ {
    static constexpr bool PERM = true, AFTER_DRAIN = false, PAIRED = false;
    unsigned char* ws;
    __device__ __forceinline__ void operator()(const f32x4 (&acc)[2][2][4][2], const pg8::Unit& u, int wr, int wc, int fr, int fq) const {
        unsigned char* w_ = ws; asm volatile("" : "+s"(w_));
        const float* SS = (const float*)(w_ + ST_CQSS); const float* COS = (const float*)(w_ + ST_COS); const float* SIN = (const float*)(w_ + ST_SIN); bf16* QM = (bf16*)(w_ + WS_QM);
        const int row0 = u.pm * 256 + wr * 64 + fr;
        const int g0 = 8 * u.pn + wc, g1 = g0 + 4;
        const bool rope0 = (g0 % 6) >= 4, rope1 = (g1 % 6) >= 4;
        const int f0 = (rope0 || rope1) ? 16 * ((rope0 ? g0 : g1) % 6 - 4) + 4 * fq : 4 * fq;
        const int head0 = g0 / 6, head1 = g1 / 6;
        bf16* q0 = QM + head0 * 192 + (g0 - 6 * head0) * 32 + 8 * fq; bf16* q1 = QM + head1 * 192 + (g1 - 6 * head1) * 32 + 8 * fq;
        const float k0 = rope0 ? 1.f : 0.f, k1 = rope1 ? 1.f : 0.f;
        EPI_ROWS(ai, m) {
            const int row = row0 + ai * 128 + m * 16;
            const f32x4 ssv = *(const GAS f32x4*)(SS + (size_t)row * 16 + 4 * fq);
            const f32x4 cv = *(const GAS f32x4*)(COS + (size_t)(row + NMETA) * 32 + f0), sv = *(const GAS f32x4*)(SIN + (size_t)(row + NMETA) * 32 + f0);
            float s = (ssv[0] + ssv[1]) + (ssv[2] + ssv[3]);
            s += __shfl_xor(s, 16); s += __shfl_xor(s, 32);
            const float rs = (MLA_QSCALE / F8_UQSCALE) * __builtin_amdgcn_rsqf(s * (1.f / QRANK) + EPS);
            { const f32x4 c = (cv - 1.f) * k0 + 1.f, sn = sv * k0; const f32x4 v0 = acc[ai][0][m][0], v1 = acc[ai][0][m][1];
              st_bf8(q0 + (size_t)row * 3072, (v0 * c - v1 * sn) * rs, (v0 * sn + v1 * c) * rs); }
            { const f32x4 c = (cv - 1.f) * k1 + 1.f, sn = sv * k1; const f32x4 v0 = acc[ai][1][m][0], v1 = acc[ai][1][m][1];
              st_bf8(q1 + (size_t)row * 3072, (v0 * c - v1 * sn) * rs, (v0 * sn + v1 * c) * rs); }
        }
    }
};
struct EpiKV {
    static constexpr bool PERM = true, AFTER_DRAIN = false, PAIRED = false;
    unsigned char* ws;
    __device__ __forceinline__ void operator()(const f32x4 (&acc)[2][2][4][2], const pg8::Unit& u, int wr, int wc, int fr, int fq) const {
        unsigned char* w_ = ws; asm volatile("" : "+s"(w_));
        const float* SS = (const float*)(w_ + ST_CKVSS); bf16* KF = (bf16*)(w_ + WS_KF); bf16* VB = (bf16*)(w_ + WS_VB);
        const int row0 = u.pm * 256 + wr * 64 + fr, cl = wc * 32 + 8 * fq;
        f32x4 t0[2][4], t1[2][4];
        EPI_ROWS(ai, m) { const int row = row0 + ai * 128 + m * 16; t0[ai][m] = *(const GAS f32x4*)(SS + (size_t)row * 8); t1[ai][m] = *(const GAS f32x4*)(SS + (size_t)row * 8 + 4); }
        EPI_ROWS(ai, m) {
            const int row = row0 + ai * 128 + m * 16;
            const float s = ((t0[ai][m][0] + t0[ai][m][1]) + (t0[ai][m][2] + t0[ai][m][3])) + ((t1[ai][m][0] + t1[ai][m][1]) + (t1[ai][m][2] + t1[ai][m][3]));
            const float rs = (1.f / F8_UKVSCALE) / sqrtf(s * (1.f / KVRANK) + EPS);
            st_bf8(KF + (size_t)row * 3072 + u.pn * 192 + cl, acc[ai][0][m][0] * rs, acc[ai][0][m][1] * rs);
            st_bf8(VB + (size_t)row * 2048 + u.pn * 128 + cl, acc[ai][1][m][0] * rs, acc[ai][1][m][1] * rs);
        }
    }
};
struct EpiGla {
    static constexpr bool PERM = true, AFTER_DRAIN = false, PAIRED = false;
    unsigned char* ws;
    __device__ __forceinline__ void operator()(const f32x4 (&acc)[2][2][4][2], const pg8::Unit& u, int wr, int wc, int fr, int fq) const {
        const bf16* GA = (const bf16*)(ws + WS_GA); bf16* MG = (bf16*)(ws + WS_MERGED);
        const int row0 = u.pm * 256 + wr * 64 + fr, col0 = u.pn * 256 + wc * 32 + 8 * fq;
        u32x4 gv[2][4][2];
        EPI_ROWS(ai, m) { const size_t ro = (size_t)(row0 + ai * 128 + m * 16) * DM + col0; gv[ai][m][0] = *(const GAS u32x4*)(GA + ro); gv[ai][m][1] = *(const GAS u32x4*)(GA + ro + 128); }
        EPI_ROWS(ai, m) {
            const size_t ro = (size_t)(row0 + ai * 128 + m * 16) * DM + col0;
#pragma unroll
            for (int bj = 0; bj < 2; ++bj) { const u32x4 w = gv[ai][m][bj];
                const f32x4 g0 = (f32x4){bflo(w.x), bfhi(w.x), bflo(w.y), bfhi(w.y)}, g1 = (f32x4){bflo(w.z), bfhi(w.z), bflo(w.w), bfhi(w.w)};
                st_bf8(MG + ro + bj * 128, acc[ai][bj][m][0] * g0, acc[ai][bj][m][1] * g1); }
        }
    }
};
struct EpiMla {
    static constexpr bool PERM = true, AFTER_DRAIN = false, PAIRED = false;
    unsigned char* ws;
    __device__ __forceinline__ void operator()(const f32x4 (&acc)[2][2][4][2], const pg8::Unit& u, int wr, int wc, int fr, int fq) const {
        const bf16* GB = (const bf16*)(ws + WS_GB); bf16* MG = (bf16*)(ws + WS_MERGED);
        const int row0 = u.pm * 256 + wr * 64 + fr, col0 = u.pn * 256 + wc * 32 + 8 * fq;
#pragma unroll
        for (int ai = 0; ai < 2; ++ai) {
            u32x4 gv[4][2], pv[4][2];
#pragma unroll
            for (int m = 0; m < 4; ++m) { const size_t ro = (size_t)(row0 + ai * 128 + m * 16) * DM + col0;
                gv[m][0] = *(const GAS u32x4*)(GB + ro); gv[m][1] = *(const GAS u32x4*)(GB + ro + 128); pv[m][0] = *(const GAS u32x4*)(MG + ro); pv[m][1] = *(const GAS u32x4*)(MG + ro + 128); }
#pragma unroll
            for (int m = 0; m < 4; ++m) { const size_t ro = (size_t)(row0 + ai * 128 + m * 16) * DM + col0;
#pragma unroll
                for (int bj = 0; bj < 2; ++bj) { const u32x4 w = gv[m][bj], q = pv[m][bj];
                    const f32x4 g0 = (f32x4){bflo(w.x), bfhi(w.x), bflo(w.y), bfhi(w.y)}, g1 = (f32x4){bflo(w.z), bfhi(w.z), bflo(w.w), bfhi(w.w)};
                    const f32x4 p0 = (f32x4){bflo(q.x), bfhi(q.x), bflo(q.y), bfhi(q.y)}, p1 = (f32x4){bflo(q.z), bfhi(q.z), bflo(q.w), bfhi(q.w)};
                    st_bf8(MG + ro + bj * 128, p0 + acc[ai][bj][m][0] * g0, p1 + acc[ai][bj][m][1] * g1); } }
        }
    }
};
struct EpiWo {
    static constexpr bool PERM = true, AFTER_DRAIN = false, PAIRED = false;
    unsigned char* ws; const float* x; float* out;
    __device__ __forceinline__ void operator()(const f32x4 (&acc)[2][2][4][2], const pg8::Unit& u, int wr, int wc, int fr, int fq) const {
        bf16* H1B = (bf16*)(ws + WS_H1B); float* SS = (float*)(ws + ST_H1SS); const bf16* XB = (const bf16*)(ws + WS_H0B);
        const int row0 = u.pm * 256 + wr * 64 + fr, col0 = u.pn * 256 + wc * 32 + 8 * fq;
        u32x4 xv[2][4][2];
        EPI_ROWS(ai, m) { const size_t ro = (size_t)(row0 + ai * 128 + m * 16) * DM + col0; xv[ai][m][0] = *(const GAS u32x4*)(XB + ro); xv[ai][m][1] = *(const GAS u32x4*)(XB + ro + 128); }
        EPI_ROWS(ai, m) { const int row = row0 + ai * 128 + m * 16; const size_t ro = (size_t)row * DM + col0; float ssum = 0.f;
#pragma unroll
            for (int bj = 0; bj < 2; ++bj) { const u32x4 w = xv[ai][m][bj];
                const f32x4 x0 = (f32x4){bflo(w.x), bfhi(w.x), bflo(w.y), bfhi(w.y)}, x1 = (f32x4){bflo(w.z), bfhi(w.z), bflo(w.w), bfhi(w.w)};
                const f32x4 v0 = x0 + acc[ai][bj][m][0], v1 = x1 + acc[ai][bj][m][1];
                st_bf8(H1B + ro + bj * 128, v0, v1); ssum += dot4(v0) + dot4(v1);
            }
            ssum += __shfl_xor(ssum, 16); ssum += __shfl_xor(ssum, 32); if (fq == 0) SS[(size_t)row * 64 + u.pn * 4 + wc] = ssum; }
    }
};
constexpr int LDS_RSTAB = 131072;
struct EpiFF1 {
    static constexpr bool PERM = true, AFTER_DRAIN = false, PAIRED = false;
    unsigned char* ws; LAS unsigned char* lds; int pm0;
    __device__ __forceinline__ void operator()(const f32x4 (&acc)[2][2][4][2], const pg8::Unit& u, int wr, int wc, int fr, int fq) const {
        const float* SS = (const float*)(ws + ST_H1SS); bf16* U = (bf16*)(ws + WS_U);
        const int row0 = u.pm * 256 + wr * 64 + fr, col0 = u.pn * 256 + wc * 32 + 8 * fq;
        float rsv[2][4];
        if (u.pm == pm0) { const LAS float* T = (const LAS float*)(lds + LDS_RSTAB) + wr * 64 + fr; EPI_ROWS(ai, m) rsv[ai][m] = T[ai * 128 + m * 16]; }
        else {
            EPI_ROWS(ai, m) { const float* p = SS + (size_t)(row0 + ai * 128 + m * 16) * 64 + 16 * fq;
                const f32x4 a = *(const GAS f32x4*)p, b = *(const GAS f32x4*)(p + 4), c = *(const GAS f32x4*)(p + 8), d = *(const GAS f32x4*)(p + 12);
                float s = (((a[0] + a[1]) + (a[2] + a[3])) + ((b[0] + b[1]) + (b[2] + b[3]))) + (((c[0] + c[1]) + (c[2] + c[3])) + ((d[0] + d[1]) + (d[2] + d[3])));
                s += __shfl_xor(s, 16); s += __shfl_xor(s, 32); rsv[ai][m] = 1.f / sqrtf(s * (1.f / DM) + EPS); }
        }
        EPI_ROWS(ai, m) {
            const int row = row0 + ai * 128 + m * 16; const float rs = rsv[ai][m];
#pragma unroll
            for (int bj = 0; bj < 2; ++bj) { f32x4 v0 = acc[ai][bj][m][0] * rs, v1 = acc[ai][bj][m][1] * rs;
#pragma unroll
                for (int j = 0; j < 4; ++j) { const float a = fmaxf(v0[j], 0.f), b = fmaxf(v1[j], 0.f); v0[j] = a * a; v1[j] = b * b; }
                st_bf8(U + (size_t)row * LDU + col0 + bj * 128, v0, v1); }
        }
    }
};
__device__ __forceinline__ void ff1_rs_table(const unsigned char* ws, LAS unsigned char* lds, int pm0, int tid) {
    const float* SS = (const float*)(ws + ST_H1SS) + (size_t)(pm0 * 256 + (tid >> 1)) * 64 + 32 * (tid & 1);
    float s = 0.f;
#pragma unroll
    for (int q = 0; q < 8; ++q) { const f32x4 a = *(const GAS f32x4*)(SS + 4 * q); s += (a[0] + a[1]) + (a[2] + a[3]); }
    s += __shfl_xor(s, 1);
    if ((tid & 1) == 0) ((LAS float*)(lds + LDS_RSTAB))[tid >> 1] = 1.f / sqrtf(s * (1.f / DM) + EPS);
    __syncthreads();
}
struct EpiFF2 {
    static constexpr bool PERM = true, AFTER_DRAIN = false, PAIRED = false;
    unsigned char* ws; float* out;
    __device__ __forceinline__ void operator()(const f32x4 (&acc)[2][2][4][2], const pg8::Unit& u, int wr, int wc, int fr, int fq) const {
        float* SS = (float*)(ws + ST_H2SS); const bf16* H1B = (const bf16*)(ws + WS_H1B);
        const int row0 = u.pm * 256 + wr * 64 + fr, col0 = u.pn * 256 + wc * 32 + 8 * fq;
        u32x4 hv[2][4][2];
        EPI_ROWS(ai, m) { const size_t ro = (size_t)(row0 + ai * 128 + m * 16) * DM + col0; hv[ai][m][0] = *(const GAS u32x4*)(H1B + ro); hv[ai][m][1] = *(const GAS u32x4*)(H1B + ro + 128); }
        EPI_ROWS(ai, m) {
            const int row = row0 + ai * 128 + m * 16; const size_t ro = (size_t)row * DM + col0; float ssum = 0.f;
#pragma unroll
            for (int bj = 0; bj < 2; ++bj) { const u32x4 w = hv[ai][m][bj];
                const f32x4 h0 = (f32x4){bflo(w.x), bfhi(w.x), bflo(w.y), bfhi(w.y)}, h1 = (f32x4){bflo(w.z), bfhi(w.z), bflo(w.w), bfhi(w.w)};
                const f32x4 v0 = h0 + acc[ai][bj][m][0], v1 = h1 + acc[ai][bj][m][1];
                st_bf8((bf16*)(ws + WS_H1B) + ro + bj * 128, v0, v1); ssum += dot4(v0) + dot4(v1);
            }
            ssum += __shfl_xor(ssum, 16); ssum += __shfl_xor(ssum, 32); if (fq == 0) SS[(size_t)row * 64 + u.pn * 4 + wc] = ssum;
        }
    }
};
struct EpiNull {
    static constexpr bool PERM = true, AFTER_DRAIN = false, PAIRED = false;
    unsigned char* ws;
    __device__ __forceinline__ void operator()(const f32x4 (&acc)[2][2][4][2], const pg8::Unit& u, int wr, int wc, int fr, int fq) const {
        float s = 0.f;
        EPI_ROWS(ai, m) {
#pragma unroll
            for (int bj = 0; bj < 2; ++bj) s += dot4(acc[ai][bj][m][0]) + dot4(acc[ai][bj][m][1]); }
        if (s == 1234567.125f) ((float*)(ws + ST_H2SS))[0] = s;
    }
};

struct PairOrder {
    pg8::StaticOrder so;
    __device__ void init(int M, int N, int G_, int c_) { so.init(M, N, G_, c_); }
    __device__ __forceinline__ bool next(int i, pg8::Unit& u) const { const bool ok = so.next(i >> 1, u); u.sel = i & 1; return ok; }
    __device__ __forceinline__ void a_ready(const pg8::Unit&) const {}
    __device__ __forceinline__ void done(const pg8::Unit&) const {}
};
struct EpiMerged {
    static constexpr bool PERM = true, AFTER_DRAIN = false, PAIRED = true;
    unsigned char* ws;
    static __device__ __forceinline__ void unpack(const u32x4 w, f32x4& a, f32x4& b) { a = (f32x4){bflo(w.x), bfhi(w.x), bflo(w.y), bfhi(w.y)}; b = (f32x4){bflo(w.z), bfhi(w.z), bflo(w.w), bfhi(w.w)}; }
    __device__ __forceinline__ void mid(f32x4 (&acc)[2][2][4][2], const pg8::Unit& u, int wr, int wc, int fr, int fq) const {
        const bf16* GA = (const bf16*)(ws + WS_GA); const bf16* GB = (const bf16*)(ws + WS_GB);
        const int row0 = u.pm * 256 + wr * 64 + fr, col0 = u.pn * 256 + wc * 32 + 8 * fq;
#pragma unroll
        for (int ai = 0; ai < 2; ++ai) {
            u32x4 av[4][2], bv[4][2];
#pragma unroll
            for (int m = 0; m < 4; ++m) { const size_t ro = (size_t)(row0 + ai * 128 + m * 16) * DM + col0;
                av[m][0] = *(const GAS u32x4*)(GA + ro); av[m][1] = *(const GAS u32x4*)(GA + ro + 128); bv[m][0] = *(const GAS u32x4*)(GB + ro); bv[m][1] = *(const GAS u32x4*)(GB + ro + 128); }
#pragma unroll
            for (int m = 0; m < 4; ++m)
#pragma unroll
                for (int bj = 0; bj < 2; ++bj) { f32x4 a0, a1, b0, b1; unpack(av[m][bj], a0, a1); unpack(bv[m][bj], b0, b1);
#pragma unroll
                    for (int j = 0; j < 4; ++j) { acc[ai][bj][m][0][j] *= a0[j] * __builtin_amdgcn_rcpf(fmaxf(b0[j], 1e-6f)); acc[ai][bj][m][1][j] *= a1[j] * __builtin_amdgcn_rcpf(fmaxf(b1[j], 1e-6f)); } }
        }
    }
    __device__ __forceinline__ void operator()(const f32x4 (&acc)[2][2][4][2], const pg8::Unit& u, int wr, int wc, int fr, int fq) const {
        const bf16* GB = (const bf16*)(ws + WS_GB); bf16* MG = (bf16*)(ws + WS_MERGED);
        const int row0 = u.pm * 256 + wr * 64 + fr, col0 = u.pn * 256 + wc * 32 + 8 * fq;
        u32x4 bv[2][4][2];
        EPI_ROWS(ai, m) { const size_t ro = (size_t)(row0 + ai * 128 + m * 16) * DM + col0; bv[ai][m][0] = *(const GAS u32x4*)(GB + ro); bv[ai][m][1] = *(const GAS u32x4*)(GB + ro + 128); }
        EPI_ROWS(ai, m) { const size_t ro = (size_t)(row0 + ai * 128 + m * 16) * DM + col0;
#pragma unroll
            for (int bj = 0; bj < 2; ++bj) { f32x4 b0, b1; unpack(bv[ai][m][bj], b0, b1);
#pragma unroll
                for (int j = 0; j < 4; ++j) { b0[j] = fmaxf(b0[j], 1e-6f); b1[j] = fmaxf(b1[j], 1e-6f); }
                st_bf8(MG + ro + bj * 128, acc[ai][bj][m][0] * b0, acc[ai][bj][m][1] * b1); } }
    }
};
__device__ __forceinline__ int gla_row(int c, int t) { return c == 0 ? (t < 48 ? -1 : SEQ + (t - 48)) : 64 * (c - 1) + t; }

struct GateW { float Wf[16], Wb[16], biasf, biasb; };
__device__ __forceinline__ void gate_lg(const GateW& w, const LAS float* GL, int t, bool valid, float& lgf, float& lgb) {
    float zf = w.biasf, zb = w.biasb;
#pragma unroll
    for (int q = 0; q < 4; ++q) { const f32x4 gf = *(const LAS f32x4*)(GL + t * 32 + 4 * q), gb = *(const LAS f32x4*)(GL + t * 32 + 16 + 4 * q);
#pragma unroll
        for (int j = 0; j < 4; ++j) { zf = fmaf(gf[j], w.Wf[4 * q + j], zf); zb = fmaf(gb[j], w.Wb[4 * q + j], zb); } }
    lgf = valid ? logsig16(zf) : 0.f; lgb = valid ? logsig16(zb) : 0.f;
}
struct GateTot { float offF, F63, sumB, offR, R0; };
__device__ __forceinline__ void gates_begin(GateW& w, GateTot& T, const unsigned char* ws, const float* wf, const float* bfv, const float* wb, const float* bbv, int c, int h, LAS unsigned char* lds, int tid) {
    const float* SMALL = (const float*)(ws + ST_SMALL);
    LAS float* GL = (LAS float*)lds; LAS float* TOT = (LAS float*)(lds + 8192);
    { const int t = tid >> 3, part = tid & 7, row = gla_row(c, t);
      f32x4 v = (f32x4){0.f, 0.f, 0.f, 0.f}; if (row >= 0) v = *(const GAS f32x4*)(SMALL + (size_t)row * 96 + 64 + 4 * part);
      *(LAS f32x4*)(GL + t * 32 + 4 * part) = v; }
    const int d = tid & 127, tq = tid >> 7, col = h * 128 + d;
#pragma unroll
    for (int r = 0; r < 16; ++r) { w.Wf[r] = wf[r * 1024 + col]; w.Wb[r] = wb[r * 1024 + col]; }
    w.biasf = bfv[col]; w.biasb = bbv[col];
    __syncthreads();
    float sF = 0.f, sB = 0.f;
#pragma unroll 2
    for (int i = 0; i < 16; ++i) { const int t = 16 * tq + i; float lf, lb; gate_lg(w, GL, t, gla_row(c, t) >= 0, lf, lb); sF += lf; sB += lb; }
    TOT[tq * 128 + d] = sF; TOT[512 + tq * 128 + d] = sB;
    __syncthreads();
    float offF = 0.f, offR = 0.f, totF = 0.f, totR = 0.f;
#pragma unroll
    for (int q = 0; q < 4; ++q) { const float a = TOT[q * 128 + d], b = TOT[512 + q * 128 + d]; totF += a; totR += b; if (q < tq) offF += a; if (q > tq) offR += b; }
    T.offF = offF; T.F63 = totF; T.sumB = sB; T.offR = offR; T.R0 = totR;
}
struct GlaW { const float *wf, *bf, *wb, *bb, *gnorm; };
__device__ __forceinline__ void stage_tile(LAS bf16* dst, const bf16* src, int ld, int col0, int c, int tid) {
#pragma unroll
    for (int k = 0; k < 2; ++k) { const int idx = tid + 512 * k, t = idx >> 4, ch = idx & 15, row = gla_row(c, t);
        u32x4 v = (u32x4){0u, 0u, 0u, 0u}; if (row >= 0) v = *(const GAS u32x4*)(src + (size_t)row * ld + col0 + 8 * ch);
        *(LAS u32x4*)(dst + t * 128 + 8 * ch) = v; }
}
constexpr int PA_K = 16384, PA_KTF = 32768, PA_KTB = PA_KTF + 128 * 132, PA_LG = PA_KTB + 128 * 132, PA_VS = PA_LG, PA_VSS = 264;
static_assert(PA_LG + 2 * 64 * 128 * 4 <= LDS_CTL && PA_VS + 64 * PA_VSS * 2 <= LDS_CTL, "pass A LDS");
__device__ __forceinline__ void gla_pass_a(unsigned char* ws, const GlaW& gw, LAS unsigned char* lds, int tid, int G, int bid, float* LG) {
    const bf16* GK = (const bf16*)(ws + WS_GK); const bf16* GV = (const bf16*)(ws + WS_GV); const float* SMALL = (const float*)(ws + ST_SMALL);
    bf16* KHTF = (bf16*)(ws + WS_KHTF); bf16* KHTB = (bf16*)(ws + WS_KHTB); bf16* VT = (bf16*)(ws + WS_VT);
    float* DLF = (float*)(ws + ST_DLF); float* DLB = (float*)(ws + ST_DLB);
    LAS float* GL = (LAS float*)lds; LAS float* TOT = (LAS float*)(lds + 8192); LAS bf16* KS = (LAS bf16*)(lds + PA_K); LAS bf16* KTF = (LAS bf16*)(lds + PA_KTF); LAS bf16* KTB = (LAS bf16*)(lds + PA_KTB);
    LAS float* LGC = (LAS float*)(lds + PA_LG); LAS bf16* VS = (LAS bf16*)(lds + PA_VS);
    const int nmine = (NXC * GH - bid + G - 1) / G + ((bid >= 16 && bid < 16 + GH) ? 1 : 0);
    for (int k = 0; k < nmine; ++k) {
        const int u = bid + k * G; const bool meta = u >= NXC * GH;
        const int c = meta ? 0 : 1 + (u >> 3), h = meta ? bid - 16 : (u & 7);
        const int d = tid & 127, tq = tid >> 7, col = h * 128 + d;
        __syncthreads();
        u32x4 vreg[4];
#pragma unroll
        for (int q = 0; q < 4; ++q) { const int idx = tid + 512 * q, t = idx >> 5, ch = idx & 31, row = gla_row(c, t);
            vreg[q] = (u32x4){0u, 0u, 0u, 0u}; if (row >= 0) vreg[q] = *(const GAS u32x4*)(GV + (size_t)row * 2048 + h * 256 + 8 * ch); }
        stage_tile(KS, GK, 1024, h * 128, c, tid);
        { const int t = tid >> 3, part = tid & 7, row = gla_row(c, t);
          f32x4 v = (f32x4){0.f, 0.f, 0.f, 0.f}; if (row >= 0) v = *(const GAS f32x4*)(SMALL + (size_t)row * 96 + 64 + 4 * part);
          *(LAS f32x4*)(GL + t * 32 + 4 * part) = v; }
        GateW w;
#pragma unroll
        for (int r = 0; r < 16; ++r) { w.Wf[r] = gw.wf[r * 1024 + col]; w.Wb[r] = gw.wb[r * 1024 + col]; }
        w.biasf = gw.bf[col]; w.biasb = gw.bb[col];
        __syncthreads();
        float sF = 0.f, sB = 0.f;
#pragma unroll 2
        for (int i = 0; i < 16; ++i) { const int t = 16 * tq + i, row = gla_row(c, t); float lf, lb; gate_lg(w, GL, t, row >= 0, lf, lb); sF += lf; sB += lb;
            LGC[t * 128 + d] = lf; LGC[8192 + t * 128 + d] = lb;
            if (c >= 1) { LG[(size_t)row * 1024 + col] = lf; LG[(size_t)SEQ * 1024 + (size_t)row * 1024 + col] = lb; } }
        TOT[tq * 128 + d] = sF; TOT[512 + tq * 128 + d] = sB;
        __syncthreads();
        float offF = 0.f, offR = 0.f, F63 = 0.f, R0 = 0.f;
#pragma unroll
        for (int q = 0; q < 4; ++q) { const float a = TOT[q * 128 + d], b2 = TOT[512 + q * 128 + d]; F63 += a; R0 += b2; if (q < tq) offF += a; if (q > tq) offR += b2; }
        { float runF = offF, runB = 0.f;
#pragma unroll 4
          for (int i = 0; i < 16; ++i) { const int t = 16 * tq + i; const float lf = LGC[t * 128 + d], lb = LGC[8192 + t * 128 + d];
              runF += lf; const float R = offR + (sB - runB); runB += lb;
              const float kv = bf2f(KS[t * 128 + d]);
              KTF[d * 66 + t] = f2bf(kv * __expf(F63 - runF)); KTB[d * 66 + t] = f2bf(kv * __expf(R0 - R)); } }
        if (tq == 0) { DLF[(size_t)(c * GH + h) * 128 + d] = __expf(F63); if (c >= 1) DLB[(size_t)((c - 1) * GH + h) * 128 + d] = __expf(R0); }
        __syncthreads();
#pragma unroll
        for (int q = 0; q < 4; ++q) { const int idx = tid + 512 * q, t = idx >> 5, ch = idx & 31; *(LAS u32x4*)(VS + t * PA_VSS + 8 * ch) = vreg[q]; }
        { GAS unsigned* of = (GAS unsigned*)(KHTF + (size_t)(c * GH + h) * 128 * 64); GAS unsigned* ob = (GAS unsigned*)(KHTB + (size_t)((c > 0 ? c - 1 : 0) * GH + h) * 128 * 64);
#pragma unroll
          for (int q = 0; q < 8; ++q) { const int idx = tid + 512 * q, dd = idx >> 5, dw = idx & 31;
              of[idx] = *(const LAS unsigned*)(KTF + dd * 66 + 2 * dw); if (c >= 1) ob[idx] = *(const LAS unsigned*)(KTB + dd * 66 + 2 * dw); } }
        __syncthreads();
        { const int e = tid & 255, th = tid >> 8; unsigned pv[16];
#pragma unroll
          for (int i = 0; i < 32; i += 2) { const unsigned a = VS[(32 * th + i) * PA_VSS + e], b2 = VS[(32 * th + i + 1) * PA_VSS + e]; pv[i >> 1] = a | (b2 << 16); }
          GAS u32x4* o = (GAS u32x4*)(VT + ((size_t)(c * GH + h) * 256 + e) * 64 + 32 * th);
#pragma unroll
          for (int q = 0; q < 4; ++q) o[q] = (u32x4){pv[4 * q], pv[4 * q + 1], pv[4 * q + 2], pv[4 * q + 3]}; }
    }
}
__device__ __forceinline__ void gla_chain(unsigned char* ws, int bid, int G, int wave, int lane) {
    const bf16* KHTF = (const bf16*)(ws + WS_KHTF); const bf16* KHTB = (const bf16*)(ws + WS_KHTB); const bf16* VT = (const bf16*)(ws + WS_VT);
    const float* DLF = (const float*)(ws + ST_DLF); const float* DLB = (const float*)(ws + ST_DLB); bf16* SNAP = (bf16*)(ws + WS_SNAP);
    const int r32 = lane & 31, hi = lane >> 5;
    for (int wc = bid * 2 + wave; wc < 512; wc += G * 2) {
        const int dir = wc >> 8, h = (wc >> 5) & 7, e0 = 32 * ((wc >> 2) & 7), d0 = 32 * (wc & 3);
        f32x16 S = {};
        bf16* snap = SNAP + (size_t)dir * 128 * GH * 256 * 128 + ((size_t)h * 256 + e0 + r32) * 128 + d0 + 4 * hi;
        const bf16* khb = (dir == 0 ? KHTF : KHTB) + ((size_t)h * 128 + d0 + r32) * 64 + 8 * hi;
        const bf16* vtb = VT + ((size_t)h * 256 + e0 + r32) * 64 + 8 * hi;
        const float* dlb = (dir == 0 ? DLF : DLB) + (size_t)h * 128 + d0 + 4 * hi;
        constexpr int PD = 3;
        bf16x8 A[PD][4], B[PD][4]; f32x4 DV[PD][4];
#define CH_LOAD(slot, s_) do { const int kc_ = dir == 0 ? (s_) : 127 - (s_), vc_ = dir == 0 ? (s_) : 128 - (s_); \
            const bf16* kh_ = khb + (size_t)kc_ * (GH * 128 * 64); const bf16* vt_ = vtb + (size_t)vc_ * (GH * 256 * 64); const float* dl_ = dlb + (size_t)kc_ * (GH * 128); \
            _Pragma("unroll") for (int q_ = 0; q_ < 4; ++q_) { A[slot][q_] = *(const GAS bf16x8*)(kh_ + 16 * q_); B[slot][q_] = *(const GAS bf16x8*)(vt_ + 16 * q_); DV[slot][q_] = *(const GAS f32x4*)(dl_ + 8 * q_); } } while (0)
#define CH_STORE(xc_) do { bf16* sp_ = snap + (size_t)(xc_) * (GH * 256 * 128); \
            _Pragma("unroll") for (int g_ = 0; g_ < 4; ++g_) *(GAS u32x2*)(sp_ + 8 * g_) = (u32x2){cvtpk(S[4 * g_], S[4 * g_ + 1]), cvtpk(S[4 * g_ + 2], S[4 * g_ + 3])}; } while (0)
#pragma unroll
        for (int p = 0; p < PD; ++p) CH_LOAD(p, p);
        if (dir == 1) CH_STORE(127);
        for (int sb = 0; sb < 129; sb += PD) {
#pragma unroll
            for (int p = 0; p < PD; ++p) {
                const int s = sb + p;
                if (s < 128) {
#pragma unroll
                    for (int g = 0; g < 4; ++g) { S[4 * g] *= DV[p][g][0]; S[4 * g + 1] *= DV[p][g][1]; S[4 * g + 2] *= DV[p][g][2]; S[4 * g + 3] *= DV[p][g][3]; }
#pragma unroll
                    for (int q = 0; q < 4; ++q) S = __builtin_amdgcn_mfma_f32_32x32x16_bf16(A[p][q], B[p][q], S, 0, 0, 0);
                    if (s + PD < 128) CH_LOAD(p, s + PD);
                    if (dir == 0) CH_STORE(s); else if (s < 127) CH_STORE(126 - s);
                }
            }
        }
#undef CH_LOAD
#undef CH_STORE
    }
}
__device__ __forceinline__ int crow(int r, int hi) { return (r & 3) + 8 * (r >> 2) + 4 * hi; }
constexpr int PC_OPS = 16384, PC_OPB = 64 * 272, PC_ATT = PC_OPS + 6 * PC_OPB, PC_ATTB = 64 * 144, PC_END = PC_ATT + 2 * PC_ATTB;
constexpr int PC_STK = PC_ATT, PC_STQ = PC_STK + 16384;
constexpr int PC_OT = PC_OPS, PC_OTS = 260;
static_assert(PC_END <= LDS_CTL && PC_STQ + 16384 <= LDS_CTL && PC_OT + 64 * PC_OTS * 4 <= PC_ATT, "pass C LDS");
template <int PV> __device__ __forceinline__ void gla_pass_c(unsigned char* ws, const GlaW& gw, LAS unsigned char* lds, int tid, int G, int bid, bf16* AGout, const float* LG) {
    const bf16* GQ = (const bf16*)(ws + WS_GQ); const bf16* GK = (const bf16*)(ws + WS_GK); const bf16* GOG = (const bf16*)(ws + WS_GOG);
    const bf16* VT = (const bf16*)(ws + WS_VT); const bf16* SNAP = (const bf16*)(ws + WS_SNAP); bf16* AG = AGout;
    const int wave = __builtin_amdgcn_readfirstlane(tid >> 6), lane = tid & 63, r32 = lane & 31, hi = lane >> 5;
#define PC_OP(i) ((LAS bf16*)(lds + PC_OPS + (i) * PC_OPB))
#define PC_AT(i) ((LAS bf16*)(lds + PC_ATT + (i) * PC_ATTB))
    for (int u = bid; u < NXC * GH; u += G) {
        const int xc = u >> 3, h = u & 7, c = xc + 1, e0 = 32 * wave;
        __syncthreads();
        const int d = tid & 127, tq = tid >> 7;
        float lgf[16], lgb[16];
        { const float* lp = LG + (size_t)(64 * xc + 16 * tq) * 1024 + h * 128 + d;
#pragma unroll
          for (int i = 0; i < 16; ++i) { lgf[i] = lp[(size_t)i * 1024]; lgb[i] = lp[(size_t)SEQ * 1024 + (size_t)i * 1024]; } }
        stage_tile((LAS bf16*)(lds + PC_STK), GK, 1024, h * 128, c, tid); stage_tile((LAS bf16*)(lds + PC_STQ), GQ, 1024, h * 128, c, tid);
        LAS float* TOT = (LAS float*)(lds + 8192);
#pragma unroll
        for (int i = 1; i < 16; ++i) lgf[i] += lgf[i - 1];
#pragma unroll
        for (int i = 14; i >= 0; --i) lgb[i] += lgb[i + 1];
        TOT[tq * 128 + d] = lgf[15]; TOT[512 + tq * 128 + d] = lgb[0];
        __syncthreads();
        { float offF = 0.f, offR = 0.f, F63 = 0.f, R0 = 0.f;
#pragma unroll
          for (int q = 0; q < 4; ++q) { const float a = TOT[q * 128 + d], b2 = TOT[512 + q * 128 + d]; F63 += a; R0 += b2; if (q < tq) offF += a; if (q > tq) offR += b2; }
          const LAS bf16* KS = (const LAS bf16*)(lds + PC_STK); const LAS bf16* QS = (const LAS bf16*)(lds + PC_STQ);
          const float dF = __expf(F63), dR = __expf(R0);
#pragma unroll
          for (int i = 0; i < 16; ++i) { const int t = 16 * tq + i; const float F = lgf[i] + offF, R = lgb[i] + offR;
              const float q = bf2f(QS[t * 128 + d]), kv = bf2f(KS[t * 128 + d]);
              const float ef = __expf(F - F63), er = __expf(R - R0), qf = q * ef, qr2 = q * er;
              PC_OP(0)[t * 136 + d] = f2bf(qf); PC_OP(1)[t * 136 + d] = f2bf(kv * __builtin_amdgcn_rcpf(ef)); PC_OP(4)[t * 136 + d] = f2bf(qf * dF);
              PC_OP(2)[t * 136 + d] = f2bf(qr2); PC_OP(3)[t * 136 + d] = f2bf(kv * __builtin_amdgcn_rcpf(er)); PC_OP(5)[t * 136 + d] = f2bf(qr2 * dR); } }
        __syncthreads();
        bf16x8 sfr[2][8], vfr[4];
#pragma unroll
        for (int dir = 0; dir < 2; ++dir) { const bf16* sp = SNAP + (size_t)dir * 128 * GH * 256 * 128 + ((size_t)(xc * GH + h) * 256 + e0 + r32) * 128 + 8 * hi;
#pragma unroll
            for (int ks = 0; ks < 8; ++ks) sfr[dir][ks] = *(const GAS bf16x8*)(sp + 16 * ks); }
        { const bf16* vp = VT + ((size_t)(c * GH + h) * 256 + e0 + r32) * 64 + 8 * hi;
#pragma unroll
          for (int ks = 0; ks < 4; ++ks) vfr[ks] = *(const GAS bf16x8*)(vp + 16 * ks); }
        { const int dirw = wave >> 2, ti = (wave >> 1) & 1, sj = wave & 1;
          f32x16 a = {};
          const bool live = dirw == 0 ? sj <= ti : sj >= ti;
          if (live) {
              const LAS bf16* QH = PC_OP(2 * dirw) + (32 * ti + r32) * 136 + 8 * hi; const LAS bf16* KH = PC_OP(2 * dirw + 1) + (32 * sj + r32) * 136 + 8 * hi;
#pragma unroll
              for (int ks = 0; ks < 8; ++ks) a = __builtin_amdgcn_mfma_f32_32x32x16_bf16(*(const LAS bf16x8*)(QH + 16 * ks), *(const LAS bf16x8*)(KH + 16 * ks), a, 0, 0, 0);
          }
          LAS bf16* AT = PC_AT(dirw);
#pragma unroll
          for (int r = 0; r < 16; ++r) { const int t = 32 * ti + crow(r, hi), s2 = 32 * sj + r32; const bool keep = dirw == 0 ? s2 <= t : s2 >= t; AT[t * 72 + s2] = f2bf(keep ? a[r] : 0.f); } }
        __syncthreads();
        f32x16 o0 = {}, o1 = {};
#pragma unroll
        for (int dir = 0; dir < 2; ++dir) {
            const LAS bf16* QT = PC_OP(4 + dir) + r32 * 136 + 8 * hi;
#pragma unroll
            for (int ks = 0; ks < 8; ++ks) {
                o0 = __builtin_amdgcn_mfma_f32_32x32x16_bf16(*(const LAS bf16x8*)(QT + 16 * ks), sfr[dir][ks], o0, 0, 0, 0);
                o1 = __builtin_amdgcn_mfma_f32_32x32x16_bf16(*(const LAS bf16x8*)(QT + 32 * 136 + 16 * ks), sfr[dir][ks], o1, 0, 0, 0); }
        }
#pragma unroll
        for (int dir = 0; dir < 2; ++dir) { const LAS bf16* AT = PC_AT(dir) + r32 * 72 + 8 * hi;
#pragma unroll
            for (int ks = 0; ks < 4; ++ks) {
                o0 = __builtin_amdgcn_mfma_f32_32x32x16_bf16(*(const LAS bf16x8*)(AT + 16 * ks), vfr[ks], o0, 0, 0, 0);
                o1 = __builtin_amdgcn_mfma_f32_32x32x16_bf16(*(const LAS bf16x8*)(AT + 32 * 72 + 16 * ks), vfr[ks], o1, 0, 0, 0); } }
        __syncthreads();
        { LAS float* OT = (LAS float*)(lds + PC_OT);
#pragma unroll
          for (int r = 0; r < 16; ++r) { OT[crow(r, hi) * PC_OTS + e0 + r32] = o0[r]; OT[(32 + crow(r, hi)) * PC_OTS + e0 + r32] = o1[r]; } }
        __syncthreads();
        { const int t = tid >> 3, j = tid & 7; const LAS float* OT = (const LAS float*)(lds + PC_OT) + t * PC_OTS + 8 * j;
          const size_t ro = (size_t)(64 * xc + t) * 2048 + h * 256 + 8 * j;
          f32x4 v[4][2]; u32x4 gg[4]; float ssq = 0.f;
#pragma unroll
          for (int i = 0; i < 4; ++i) { gg[i] = *(const GAS u32x4*)(GOG + ro + 64 * i); v[i][0] = *(const LAS f32x4*)(OT + 64 * i); v[i][1] = *(const LAS f32x4*)(OT + 64 * i + 4); ssq += dot4(v[i][0]) + dot4(v[i][1]); }
          ssq += __shfl_xor(ssq, 1); ssq += __shfl_xor(ssq, 2); ssq += __shfl_xor(ssq, 4);
          const float rn = 1.f / sqrtf(ssq * (1.f / GDV) + EPS);
#pragma unroll
          for (int i = 0; i < 4; ++i) { const f32x4 g0 = *(const GAS f32x4*)(gw.gnorm + 8 * j + 64 * i), g1 = *(const GAS f32x4*)(gw.gnorm + 8 * j + 64 * i + 4); const u32x4 q = gg[i];
              const f32x4 a0 = (f32x4){bflo(q.x), bfhi(q.x), bflo(q.y), bfhi(q.y)}, a1 = (f32x4){bflo(q.z), bfhi(q.z), bflo(q.w), bfhi(q.w)};
              st_bf8(AG + ro + 64 * i, v[i][0] * rn * g0 * a0, v[i][1] * rn * g1 * a1); } }
    }
#undef PC_OP
#undef PC_AT
}
namespace att {
constexpr int NW = 8, QBLK = 32, KVBLK = 64, NT = 129, LDQ = 3072, LDK = 3072, LDV = 2048, LDO = 2048;
constexpr float THR = 11.5f;
constexpr int SHM_V = KVBLK * 128 * 2, SHM_KN = KVBLK * 128 * 2, SHM_KR = KVBLK * 64 * 2;
constexpr int NBUF = 3, OFF_V = 0, OFF_KN = NBUF * SHM_V, OFF_KR = OFF_KN + NBUF * SHM_KN, OFF_WS = OFF_KR + NBUF * SHM_KR, SHM_ATTN = OFF_WS + NW * 64 * 4;
#define KSWZ(row, colB) ((row) * 256 + ((colB) ^ (((row) & 15) << 4)))
#define KRSWZ(row, chunk) ((row) * 128 + ((((chunk) ^ (((row) >> 1) & 7))) << 4))
constexpr float NEG = -1e30f;
__device__ __forceinline__ void partialSM(f32x16& p0, f32x16& p1, float& m_reg, float& mn, float& alpha) {
    float pmax = p0[0];
#pragma unroll
    for (int r = 1; r < 16; ++r) pmax = fmaxf(pmax, p0[r]);
#pragma unroll
    for (int r = 0; r < 16; ++r) pmax = fmaxf(pmax, p1[r]);
    { auto rr = __builtin_amdgcn_permlane32_swap(__float_as_uint(pmax), __float_as_uint(pmax), false, false);
      pmax = fmaxf(__uint_as_float(rr[0]), __uint_as_float(rr[1])); }
    { const bool keep = __all(pmax - m_reg <= THR);
      const float mx = fmaxf(m_reg, pmax); mn = keep ? m_reg : mx; alpha = keep ? 1.f : __builtin_amdgcn_exp2f(m_reg - mx); m_reg = mn; }
#pragma unroll
    for (int r = 0; r < 16; ++r) p0[r] = p0[r] - mn;
#pragma unroll
    for (int r = 0; r < 16; ++r) p1[r] = p1[r] - mn;
#pragma unroll
    for (int r = 0; r < 16; ++r) p0[r] = __builtin_amdgcn_exp2f(p0[r]);
}
__device__ __forceinline__ void finishSM(f32x16& p0, f32x16& p1, float alpha, float& l_reg, bf16x8& pa0, bf16x8& pa1, bf16x8& pa2, bf16x8& pa3) {
#pragma unroll
    for (int r = 0; r < 16; ++r) p1[r] = __builtin_amdgcn_exp2f(p1[r]);
    float ps = 0;
#pragma unroll
    for (int r = 0; r < 16; ++r) ps += p0[r];
#pragma unroll
    for (int r = 0; r < 16; ++r) ps += p1[r];
    { auto rr = __builtin_amdgcn_permlane32_swap(__float_as_uint(ps), __float_as_uint(ps), false, false);
      ps = __uint_as_float(rr[0]) + __uint_as_float(rr[1]); }
    l_reg = l_reg * alpha + ps;
#define PK4(P, BASE, OUT) do { u32x4 w = {cvtpk(P[BASE + 0], P[BASE + 1]), cvtpk(P[BASE + 2], P[BASE + 3]), cvtpk(P[BASE + 4], P[BASE + 5]), cvtpk(P[BASE + 6], P[BASE + 7])}; \
    OUT = *reinterpret_cast<bf16x8*>(&w); } while (0)
    PK4(p0, 0, pa0); PK4(p0, 8, pa1); PK4(p1, 0, pa2); PK4(p1, 8, pa3);
#undef PK4
}
__device__ __forceinline__ void qkt(f32x16& p0, f32x16& p1, const LAS char* Kn, const LAS char* Kr, const bf16x8* qr, int r32, int hi) {
    p0 = f32x16{}; p1 = f32x16{};
#pragma unroll
    for (int d0 = 0; d0 < 8; ++d0) { const int cb = (d0 * 16 + hi * 8) * 2;
        const bf16x8 b0 = *(const LAS bf16x8*)(Kn + KSWZ(r32, cb)), b1 = *(const LAS bf16x8*)(Kn + KSWZ(32 + r32, cb));
        p0 = __builtin_amdgcn_mfma_f32_32x32x16_bf16(b0, qr[d0], p0, 0, 0, 0);
        p1 = __builtin_amdgcn_mfma_f32_32x32x16_bf16(b1, qr[d0], p1, 0, 0, 0); }
#pragma unroll
    for (int d0 = 0; d0 < 4; ++d0) { const int ch = d0 * 2 + hi;
        const bf16x8 b0 = *(const LAS bf16x8*)(Kr + KRSWZ(r32, ch)), b1 = *(const LAS bf16x8*)(Kr + KRSWZ(32 + r32, ch));
        p0 = __builtin_amdgcn_mfma_f32_32x32x16_bf16(b0, qr[8 + d0], p0, 0, 0, 0);
        p1 = __builtin_amdgcn_mfma_f32_32x32x16_bf16(b1, qr[8 + d0], p1, 0, 0, 0); }
}
template <int MODE> __device__ __forceinline__ void maskp(f32x16& p0, f32x16& p1) {
    if (MODE == 1) {
#pragma unroll
        for (int r = 8; r < 16; ++r) p0[r] = NEG;
    } else {
#pragma unroll
        for (int r = 0; r < 16; ++r) p0[r] = NEG;
    }
#pragma unroll
    for (int r = 0; r < 16; ++r) p1[r] = NEG;
}
__device__ __forceinline__ int v_st(int k, int c) { const int kk = (k & ~0xC) | ((k & 4) << 1) | ((k & 8) >> 1); return ((kk >> 3) * 4 + (c >> 5)) * 512 + ((kk & 7) * 32 + (c & 31)) * 2; }
__device__ __forceinline__ int v_rd_base(int lane) { return ((lane & 3) << 3) | (((lane >> 2) & 3) << 6) | (((lane >> 4) & 1) << 5) | (((lane >> 5) & 1) << 8); }
constexpr int v_rd_off(int d0, int ks, int half) { return d0 * 512 + ks * 4096 + half * 2048; }
template <int OFF> __device__ __forceinline__ s16x4 tr_read(int vb) {
    return __builtin_amdgcn_ds_read_tr16_b64_v4i16((LAS s16x4*)(uintptr_t)(unsigned)(vb + OFF));
}
template <int D0> __device__ __forceinline__ void pv_one(f32x16& od, int vb, bf16x8 pa0, bf16x8 pa1, bf16x8 pa2, bf16x8 pa3) {
    const s16x4 l0 = tr_read<v_rd_off(D0, 0, 0)>(vb), h0 = tr_read<v_rd_off(D0, 0, 1)>(vb), l1 = tr_read<v_rd_off(D0, 1, 0)>(vb), h1 = tr_read<v_rd_off(D0, 1, 1)>(vb);
    const s16x4 l2 = tr_read<v_rd_off(D0, 2, 0)>(vb), h2 = tr_read<v_rd_off(D0, 2, 1)>(vb), l3 = tr_read<v_rd_off(D0, 3, 0)>(vb), h3 = tr_read<v_rd_off(D0, 3, 1)>(vb);
#define PK(L, H) (bf16x8){L[0], L[1], L[2], L[3], H[0], H[1], H[2], H[3]}
    od = __builtin_amdgcn_mfma_f32_32x32x16_bf16(pa0, PK(l0, h0), od, 0, 0, 0);
    od = __builtin_amdgcn_mfma_f32_32x32x16_bf16(pa1, PK(l1, h1), od, 0, 0, 0);
    od = __builtin_amdgcn_mfma_f32_32x32x16_bf16(pa2, PK(l2, h2), od, 0, 0, 0);
    od = __builtin_amdgcn_mfma_f32_32x32x16_bf16(pa3, PK(l3, h3), od, 0, 0, 0);
#undef PK
}
__device__ __forceinline__ void pv_d0(f32x16* o, int vb, bf16x8 pa0, bf16x8 pa1, bf16x8 pa2, bf16x8 pa3) {
    pv_one<0>(o[0], vb, pa0, pa1, pa2, pa3); pv_one<1>(o[1], vb, pa0, pa1, pa2, pa3); pv_one<2>(o[2], vb, pa0, pa1, pa2, pa3); pv_one<3>(o[3], vb, pa0, pa1, pa2, pa3);
}
#define PINV(x) asm volatile("" : "+v"(x))
struct KFrag { bf16x8 b0, b1; };
template <int P> __device__ __forceinline__ void kfrag(KFrag& f, const LAS char* Kn, const LAS char* Kr, int r32, int hi) {
    if (P < 8) { const int cb = (P * 16 + hi * 8) * 2; f.b0 = *(const LAS bf16x8*)(Kn + KSWZ(r32, cb)); f.b1 = *(const LAS bf16x8*)(Kn + KSWZ(32 + r32, cb)); }
    else { const int ch = (P - 8) * 2 + hi; f.b0 = *(const LAS bf16x8*)(Kr + KRSWZ(r32, ch)); f.b1 = *(const LAS bf16x8*)(Kr + KRSWZ(32 + r32, ch)); }
}
struct VFrag { s16x4 l0, h0, l1, h1, l2, h2, l3, h3; };
template <int D0> __device__ __forceinline__ void vfrag_lo(VFrag& f, int vb) { f.l0 = tr_read<v_rd_off(D0, 0, 0)>(vb); f.h0 = tr_read<v_rd_off(D0, 0, 1)>(vb); f.l1 = tr_read<v_rd_off(D0, 1, 0)>(vb); f.h1 = tr_read<v_rd_off(D0, 1, 1)>(vb); }
template <int D0> __device__ __forceinline__ void vfrag_hi(VFrag& f, int vb) { f.l2 = tr_read<v_rd_off(D0, 2, 0)>(vb); f.h2 = tr_read<v_rd_off(D0, 2, 1)>(vb); f.l3 = tr_read<v_rd_off(D0, 3, 0)>(vb); f.h3 = tr_read<v_rd_off(D0, 3, 1)>(vb); }
__device__ __forceinline__ void pv4(f32x16& od, const VFrag& f, bf16x8 pa0, bf16x8 pa1, bf16x8 pa2, bf16x8 pa3) {
#define PK(L, H) (bf16x8){L[0], L[1], L[2], L[3], H[0], H[1], H[2], H[3]}
    od = __builtin_amdgcn_mfma_f32_32x32x16_bf16(pa0, PK(f.l0, f.h0), od, 0, 0, 0);
    od = __builtin_amdgcn_mfma_f32_32x32x16_bf16(pa1, PK(f.l1, f.h1), od, 0, 0, 0);
    od = __builtin_amdgcn_mfma_f32_32x32x16_bf16(pa2, PK(f.l2, f.h2), od, 0, 0, 0);
    od = __builtin_amdgcn_mfma_f32_32x32x16_bf16(pa3, PK(f.l3, f.h3), od, 0, 0, 0);
#undef PK
}
__device__ __forceinline__ bf16x8 pk4(const f32x16& P, int base) {
    u32x4 w = {cvtpk(P[base + 0], P[base + 1]), cvtpk(P[base + 2], P[base + 3]), cvtpk(P[base + 4], P[base + 5]), cvtpk(P[base + 6], P[base + 7])};
    PINV(w); return *reinterpret_cast<bf16x8*>(&w);
}
template <int P> __device__ __forceinline__ void fill_a(f32x16& Y0, f32x16& Y1, float alY, float& ps, float& l_reg, bf16x8& pa0, bf16x8& pa1, bf16x8& pa2, bf16x8& pa3, VFrag& va, int vbY) {
    if constexpr (P == 0) { ps = Y0[0] + Y0[1];
#pragma unroll
        for (int r = 2; r < 8; ++r) ps += Y0[r];
        PINV(ps); pa0 = pk4(Y0, 0); }
    else if constexpr (P == 1) {
#pragma unroll
        for (int r = 8; r < 16; ++r) ps += Y0[r];
        PINV(ps); pa1 = pk4(Y0, 8); }
    else if constexpr (P < 10) { constexpr int i = 2 * (P - 2);
        float e0 = __builtin_amdgcn_exp2f(Y1[i]), e1 = __builtin_amdgcn_exp2f(Y1[i + 1]); PINV(e0); PINV(e1); Y1[i] = e0; Y1[i + 1] = e1;
        if constexpr (P > 2) { ps += Y1[i - 2]; ps += Y1[i - 1]; PINV(ps); }
        if constexpr (P == 6) pa2 = pk4(Y1, 0); }
    else if constexpr (P == 10) { ps += Y1[14]; ps += Y1[15]; pa3 = pk4(Y1, 8);
        auto rr = __builtin_amdgcn_permlane32_swap(__float_as_uint(ps), __float_as_uint(ps), false, false);
        l_reg = l_reg * alY + (__uint_as_float(rr[0]) + __uint_as_float(rr[1])); PINV(l_reg); vfrag_lo<0>(va, vbY); }
    else vfrag_hi<0>(va, vbY);
}
#ifndef DMA_IN_A
#define DMA_IN_A 0
#endif
__device__ __forceinline__ void dma16(const char* base, unsigned voff, LAS char* dst) {
    asm volatile("s_mov_b32 m0, %2\n\ts_nop 0\n\tglobal_load_lds_dwordx4 %0, %1" :: "v"(voff), "s"(base), "s"((unsigned)(uintptr_t)dst) : "memory", "m0");
}
struct DmaCtx { const char* kt; const char* vt; unsigned voKn0, voKn1, voKr, voV0, voV1; LAS char* lKn; LAS char* lKr; LAS char* lV; };
template <int I> __device__ __forceinline__ void dma_piece(const DmaCtx& c) {
    if (I == 0) dma16(c.kt, c.voKn0, c.lKn);
    if (I == 1) dma16(c.kt, c.voKn1, c.lKn + 1024);
    if (I == 2) dma16(c.kt, c.voKr, c.lKr);
    if (I == 3) dma16(c.vt, c.voV0, c.lV);
    if (I == 4) dma16(c.vt, c.voV1, c.lV + 1024);
}
template <int AV, bool DK, bool DV> __device__ __forceinline__ void phase_a(const DmaCtx& dc, const f32x16& negm, f32x16& X0, f32x16& X1, f32x16& Y0, f32x16& Y1, float alY, float& l_reg, bf16x8& pa0, bf16x8& pa1, bf16x8& pa2, bf16x8& pa3, VFrag& va,
                                        const LAS char* Kn, const LAS char* Kr, const bf16x8* qr, int vbY, int r32, int hi) {
    KFrag k; float ps = 0.f;
    kfrag<0>(k, Kn, Kr, r32, hi); if (AV != 2) fill_a<0>(Y0, Y1, alY, ps, l_reg, pa0, pa1, pa2, pa3, va, vbY); SBAR();
#define QKP(P) do { if (AV != 8) { X0 = __builtin_amdgcn_mfma_f32_32x32x16_bf16(k.b0, qr[P], P == 0 ? negm : X0, 0, 0, 0); X1 = __builtin_amdgcn_mfma_f32_32x32x16_bf16(k.b1, qr[P], P == 0 ? negm : X1, 0, 0, 0); } \
        else asm volatile("" :: "v"(k.b0), "v"(k.b1)); \
        if (AV != 5 && DMA_IN_A) { if (DK && P == 1) dma_piece<0>(dc); if (DK && P == 3) dma_piece<1>(dc); if (DK && P == 5) dma_piece<2>(dc); if (DV && P == 7) dma_piece<3>(dc); if (DV && P == 9) dma_piece<4>(dc); } \
        if (P < 11) { if (AV != 7) kfrag<(P < 11 ? P + 1 : 0)>(k, Kn, Kr, r32, hi); if (AV != 2 || P >= 9) fill_a<(P < 11 ? P + 1 : 1)>(Y0, Y1, alY, ps, l_reg, pa0, pa1, pa2, pa3, va, vbY); } SBAR(); } while (0)
    QKP(0); QKP(1); QKP(2); QKP(3); QKP(4); QKP(5); QKP(6); QKP(7); QKP(8); QKP(9); QKP(10); QKP(11);
#undef QKP
}
template <int S> __device__ __forceinline__ void fill_b(f32x16& X0) {
    constexpr int lo = S == 0 ? 0 : S == 1 ? 5 : 10, hi_ = S == 0 ? 5 : S == 1 ? 10 : 16;
#pragma unroll
    for (int r = lo; r < hi_; ++r) { float e = __builtin_amdgcn_exp2f(X0[r]); PINV(e); X0[r] = e; }
}
template <bool MASK, int AV> __device__ __forceinline__ void phase_b(f32x16* o, f32x16& negm, f32x16& X0, f32x16& X1, float& m_reg, float& alpha, bf16x8 pa0, bf16x8 pa1, bf16x8 pa2, bf16x8 pa3, VFrag& va, int vbY) {
#define PV4(D) do { if (AV != 8) pv4(o[D], va, pa0, pa1, pa2, pa3); else asm volatile("" :: "v"(va.l0), "v"(va.h0), "v"(va.l1), "v"(va.h1), "v"(va.l2), "v"(va.h2), "v"(va.l3), "v"(va.h3)); } while (0)
    PV4(0); if (AV != 7) { vfrag_lo<1>(va, vbY); vfrag_hi<1>(va, vbY); }
    bool keep = true;
    if (AV != 2) { if (MASK) maskp<1>(X0, X1);
      float m0 = X0[0], m1 = X1[0];
#pragma unroll
      for (int r = 1; r < 16; ++r) { m0 = fmaxf(m0, X0[r]); m1 = fmaxf(m1, X1[r]); }
      float pmax = fmaxf(m0, m1);
      { auto rr = __builtin_amdgcn_permlane32_swap(__float_as_uint(pmax), __float_as_uint(pmax), false, false); pmax = fmaxf(__uint_as_float(rr[0]), __uint_as_float(rr[1])); }
      PINV(pmax);
      keep = __all(pmax <= THR); alpha = 1.f;
      SBAR();
      if (__builtin_expect(!keep, 0)) {
          const float dlt = fmaxf(pmax, 0.f); alpha = __builtin_amdgcn_exp2f(-dlt); m_reg += dlt;
#pragma unroll
          for (int r = 0; r < 16; ++r) { X0[r] -= dlt; X1[r] -= dlt; negm[r] = -m_reg; } }
    }
    else { float t0 = X0[0], t1 = X1[0]; PINV(t0); PINV(t1); }
    SBAR();
    PV4(1); if (AV != 7) { vfrag_lo<2>(va, vbY); vfrag_hi<2>(va, vbY); } if (AV != 2) fill_b<0>(X0); SBAR();
    PV4(2); if (AV != 7) { vfrag_lo<3>(va, vbY); vfrag_hi<3>(va, vbY); } if (AV != 2) fill_b<1>(X0); SBAR();
    PV4(3); if (AV != 2) fill_b<2>(X0); SBAR();
#undef PV4
}
template <int AV> __device__ __forceinline__ void attn_body(const bf16* __restrict__ Qb, const bf16* __restrict__ Kh, const bf16* __restrict__ Vh, bf16* __restrict__ Ob, LAS char* lds) {
    int tid = threadIdx.x; asm volatile("" : "+v"(tid)); const int wid = __builtin_amdgcn_readfirstlane(tid >> 6), lane = tid & 63, r32 = lane & 31, hi = lane >> 5;
    LAS char* V_lds = lds + OFF_V; LAS char* Kn_lds = lds + OFF_KN; LAS char* Kr_lds = lds + OFF_KR;
    LAS float* wsf = (LAS float*)(lds + OFF_WS) + wid * 64; LAS float* li_l = wsf; LAS float* al_l = wsf + 32;
    float m_reg = -1e30f, l_reg = 0; f32x16 o[4] = {}; bf16x8 qr[12];
    const bf16* Qw = Qb + (long)(wid * QBLK + r32) * LDQ + hi * 8;
#pragma unroll
    for (int d0 = 0; d0 < 12; ++d0) qr[d0] = *(const GAS bf16x8*)(Qw + d0 * 16);
    unsigned voKn[2], voV[2], voKr;
#pragma unroll
    for (int i = 0; i < 2; ++i) { const int ch = 2 * wid + i;
        { const int row = 4 * ch + (lane >> 4), lc = (lane & 15) ^ (row & 15); voKn[i] = (unsigned)(row * LDK + lc * 8) * 2u; }
        { const int P = ch * 64 + lane, sub = P >> 5, k = (sub >> 2) * 8 + ((P >> 2) & 7), c = (sub & 3) * 32 + (P & 3) * 8; voV[i] = (unsigned)(k * LDV + c) * 2u; } }
    { const int row = 8 * wid + (lane >> 3), lc = (lane & 7) ^ ((row >> 1) & 7); voKr = (unsigned)(row * LDK + 128 + lc * 8) * 2u; }
    const int vb0 = (int)(uintptr_t)V_lds + v_rd_base(lane);
#define DMA_K(t, b) do { const char* kt_ = (const char*)Kh + (size_t)(t) * (KVBLK * LDK * 2); \
    dma16(kt_, voKn[0], Kn_lds + (b) * SHM_KN + (2 * wid) * 1024); dma16(kt_, voKn[1], Kn_lds + (b) * SHM_KN + (2 * wid + 1) * 1024); dma16(kt_, voKr, Kr_lds + (b) * SHM_KR + wid * 1024); } while (0)
#define DMA_V(t, b) do { const char* vt_ = (const char*)Vh + (size_t)(t) * (KVBLK * LDV * 2); \
    dma16(vt_, voV[0], V_lds + (b) * SHM_V + (2 * wid) * 1024); dma16(vt_, voV[1], V_lds + (b) * SHM_V + (2 * wid + 1) * 1024); } while (0)
#define RESC(a) do { if (__any((a) < 1.f)) { if (hi == 0) al_l[r32] = (a); asm volatile("s_waitcnt lgkmcnt(0)" ::: "memory"); \
    _Pragma("unroll") for (int d = 0; d < 4; ++d) _Pragma("unroll") for (int r = 0; r < 16; ++r) o[d][r] *= al_l[crow(r, hi)]; } } while (0)
#define WBAR(N) do { asm volatile("s_waitcnt vmcnt(" #N ") lgkmcnt(0)" ::: "memory"); __builtin_amdgcn_s_barrier(); asm volatile("" ::: "memory"); } while (0)
    f32x16 pA0, pA1, pB0, pB1; float mnA, mnB, alA, alB; bf16x8 pa0, pa1, pa2, pa3;
    DMA_K(0, 0); DMA_K(1, 1); DMA_V(0, 0);
    WBAR(0);
    DMA_K(2, 2); DMA_V(1, 1);
    qkt(pA0, pA1, Kn_lds, Kr_lds, qr, r32, hi); partialSM(pA0, pA1, m_reg, mnA, alA); RESC(alA);
    WBAR(5);
    f32x16 negm;
#pragma unroll
    for (int r = 0; r < 16; ++r) negm[r] = -m_reg;
    int bc = 1;
#define STEP(j, X0, X1, mnX, alX, Y0, Y1, alY, MASK, DK, DV) do { const int bp_ = bc == 0 ? 2 : bc - 1, bn_ = bc == 2 ? 0 : bc + 1; \
        const DmaCtx dc_{(const char*)Kh + (size_t)((j) + 2) * (KVBLK * LDK * 2), (const char*)Vh + (size_t)((j) + 1) * (KVBLK * LDV * 2), voKn[0], voKn[1], voKr, voV[0], voV[1], \
                         Kn_lds + bp_ * SHM_KN + (2 * wid) * 1024, Kr_lds + bp_ * SHM_KR + wid * 1024, V_lds + bn_ * SHM_V + (2 * wid) * 1024}; \
        phase_a<AV, DK, DV>(dc_, negm, X0, X1, Y0, Y1, alY, l_reg, pa0, pa1, pa2, pa3, vfa, Kn_lds + bc * SHM_KN, Kr_lds + bc * SHM_KR, qr, vb0 + bp_ * SHM_V, r32, hi); \
        phase_b<MASK, AV>(o, negm, X0, X1, m_reg, alX, pa0, pa1, pa2, pa3, vfa, vb0 + bp_ * SHM_V); \
        if (AV != 2) RESC(alX); \
        if (AV != 5 && !DMA_IN_A) { SBAR(); if (DK) { dma_piece<0>(dc_); dma_piece<1>(dc_); dma_piece<2>(dc_); } if (DV) { dma_piece<3>(dc_); dma_piece<4>(dc_); } } \
        if (DK && AV != 5) WBAR(5); else if (DV && AV != 5 && !DMA_IN_A) WBAR(2); else WBAR(0); \
        bc = bn_; } while (0)
    VFrag vfa;
    for (int j = 1; j + 3 < NT; j += 2) {
        STEP(j, pB0, pB1, mnB, alB, pA0, pA1, alA, false, true, true);
        STEP(j + 1, pA0, pA1, mnA, alA, pB0, pB1, alB, false, true, true);
    }
    STEP(NT - 2, pB0, pB1, mnB, alB, pA0, pA1, alA, false, false, true);
    STEP(NT - 1, pA0, pA1, mnA, alA, pB0, pB1, alB, true, false, false);
#undef STEP
    finishSM(pA0, pA1, alA, l_reg, pa0, pa1, pa2, pa3); SBAR();
    pv_d0(o, vb0 + ((NT - 1) % 3) * SHM_V, pa0, pa1, pa2, pa3);
    if (hi == 0) li_l[r32] = l_reg; LDS_WAIT();
    float rli[16];
#pragma unroll
    for (int r = 0; r < 16; ++r) rli[r] = __builtin_amdgcn_rcpf(li_l[crow(r, hi)]);
    bf16* Ow = Ob + (long)(wid * QBLK) * LDO;
    if (AV != 0) { float s = 0.f;
#pragma unroll
        for (int d0 = 0; d0 < 4; ++d0) _Pragma("unroll") for (int r = 0; r < 16; ++r) s += o[d0][r];
        if (s != 1234567.125f) return; }
#pragma unroll
    for (int r = 0; r < 16; ++r) { const int orow = crow(r, hi);
#pragma unroll
        for (int d0 = 0; d0 < 4; ++d0) Ow[(long)orow * LDO + d0 * 32 + r32] = f2bf(o[d0][r] * rli[r]); }
#undef DMA_K
#undef DMA_V
#undef WBAR
#undef RESC
}
__device__ __forceinline__ void attn_phase(unsigned char* ws, LAS unsigned char* lds, int G, int bid, bf16* exp_out, bf16* AO) {
    const bf16* QM = (const bf16*)(ws + WS_QM); const bf16* KF = (const bf16*)(ws + WS_KF); const bf16* VB = (const bf16*)(ws + WS_VB);
    for (int u = bid; u < MH * (SEQ / 256); u += G) {
        const int b = u & 255, r = u >> 8, h = 2 * (b & 7) + r, qb = b >> 3;
        __syncthreads();
        attn_body<0>(QM + (size_t)(256 * qb) * 3072 + h * 192, KF + h * 192, VB + h * 128, AO + (size_t)(256 * qb) * 2048 + h * 128, (LAS char*)lds);
    }
#if defined(EXP_ATT)
    for (int u = bid; u < MH * (SEQ / 256); u += G) {
        const int b = u & 255, r = u >> 8, h = 2 * (b & 7) + r, qb = b >> 3;
        __syncthreads();
        attn_body<EXP_ATT>(QM + (size_t)(256 * qb) * 3072 + h * 192, KF + h * 192, VB + h * 128, (EXP_ATT == 0 ? AO : exp_out) + (size_t)(256 * qb) * 2048 + h * 128, (LAS char*)lds);
    }
#endif
}
}
__device__ __forceinline__ void kpe_pass(unsigned char* ws, int gw, int NGW, int lane) {
    const float* SMALL = (const float*)(ws + ST_SMALL); const float* COS = (const float*)(ws + ST_COS); const float* SIN = (const float*)(ws + ST_SIN); bf16* KF = (bf16*)(ws + WS_KF);
    const int l = lane & 31, p = 2 * l, gp = p >> 5, fq = (p >> 3) & 3, nn = (p >> 2) & 1, j = p & 3, f = 16 * gp + 4 * fq + j;
    for (int row = 2 * gw + (lane >> 5); row < LP; row += 2 * NGW) {
        float v0 = 0.f, v1 = 0.f;
        if (row < LTOK) {
            const int pos = row < SEQ ? row + NMETA : row - SEQ;
            const float a0 = SMALL[(size_t)row * 96 + f], a1 = SMALL[(size_t)row * 96 + f + 1], b0 = SMALL[(size_t)row * 96 + 32 + f], b1 = SMALL[(size_t)row * 96 + 32 + f + 1];
            const float c0 = COS[pos * 32 + f], c1 = COS[pos * 32 + f + 1], s0 = SIN[pos * 32 + f], s1 = SIN[pos * 32 + f + 1];
            v0 = nn == 0 ? a0 * c0 - b0 * s0 : a0 * s0 + b0 * c0; v1 = nn == 0 ? a1 * c1 - b1 * s1 : a1 * s1 + b1 * c1;
        }
        const unsigned w = cvtpk(v0, v1);
#pragma unroll
        for (int h = 0; h < MH; ++h) *(GAS unsigned*)(KF + (size_t)row * 3072 + h * 192 + 128 + p) = w;
    }
}
__device__ __forceinline__ void final_norm(unsigned char* ws, float* out, const float* g, int gw, int NGW, int lane) {
    const float* SS = (const float*)(ws + ST_H2SS); const bf16* H2 = (const bf16*)(ws + WS_H1B);
    for (int row = gw; row < SEQ; row += NGW) {
        const float s = wave_sum(SS[(size_t)row * 64 + lane]);
        const float rs = 1.f / sqrtf(s * (1.f / DM) + EPS);
        const GAS u32x4* hp = (const GAS u32x4*)(H2 + (size_t)row * DM) + lane;
        GAS f32x4* o = (GAS f32x4*)(out + (size_t)row * DM) + 2 * lane; const GAS f32x4* gp = (const GAS f32x4*)g + 2 * lane;
        u32x4 w[8];
#pragma unroll
        for (int j = 0; j < 8; ++j) w[j] = hp[64 * j];
#pragma unroll
        for (int j = 0; j < 8; ++j) { const f32x4 a = (f32x4){bflo(w[j].x), bfhi(w[j].x), bflo(w[j].y), bfhi(w[j].y)}, b = (f32x4){bflo(w[j].z), bfhi(w[j].z), bflo(w[j].w), bfhi(w[j].w)};
            o[128 * j] = a * rs * gp[128 * j]; o[128 * j + 1] = b * rs * gp[128 * j + 1]; }
    }
}

#ifndef PG_SP2
#define PG_SP2 true
#endif
#ifndef PG_ALIGN
#define PG_ALIGN true
#endif
struct Args { const float* in[20]; float* out; unsigned char* ws; int ph_lo, ph_hi; };
constexpr int NPHASE = 10;
__global__ void __launch_bounds__(NTHR, 2) mega_fwd(Args args) {
    extern __shared__ __attribute__((aligned(16))) unsigned char lds_raw[];
    LAS unsigned char* lds = (LAS unsigned char*)lds_raw;
#define FRESH_IDS() int tid = threadIdx.x; asm volatile("" : "+v"(tid)); const int lane = tid & 63, wave = __builtin_amdgcn_readfirstlane(tid >> 6), gw = bid * NWAVES + wave; (void)lane; (void)gw
    const int G = gridDim.x, bid = blockIdx.x, NGW = G * NWAVES;
    unsigned char* ws = args.ws;
    volatile LAS unsigned* MISC = (volatile LAS unsigned*)(lds + LDS_CTL);
    if (threadIdx.x < 64) MISC[threadIdx.x] = 0u;
    __syncthreads();
    XcdBarrier bar = xcd_barrier_post((unsigned*)(ws + WS_CTL) + CW_BAR, MISC + 8);
    const int lo = args.ph_lo, hi = args.ph_hi;
#ifndef PH_MASK
#define PH_MASK 0x3ff
#endif
#define IN(k) ((((PH_MASK) >> (k)) & 1) && lo <= (k) && (k) < hi)
#define SEAM(k) do { if (IN(k) && IN((k) + 1)) xcd_barrier(bar); } while (0)
#ifndef DUP_PHASE
#define DUP_PHASE -1
#endif
#define REP(k) for (int rep_ = 0; rep_ < (DUP_PHASE == (k) ? 2 : 1); ++rep_, (DUP_PHASE == (k) && rep_ == 1 ? xcd_barrier(bar) : (void)0))
    GlaW glw{args.in[4], args.in[5], args.in[6], args.in[7], args.in[8]};
#if defined(DBG_TIME)
    volatile LAS unsigned long long* TS = (volatile LAS unsigned long long*)(lds + LDS_CTL + 64);
#define STAMP(k) do { if (bid == 0 && threadIdx.x == 0) TS[k] = __builtin_amdgcn_s_memrealtime(); } while (0)
#else
#define STAMP(k) do {} while (0)
#endif
    STAMP(0);

    REP(0) if (IN(0)) {
        P0Args a{args.in[0], args.in[1], args.in[2], args.in[3], args.in[9], args.in[10], args.in[11], args.in[12], args.in[13], args.in[14], args.in[15], args.in[16], args.in[17], args.in[18], ws};
        FRESH_IDS(); p0_prologue(a, lds, gw, NGW, wave, lane);
    }
    SEAM(0); STAMP(1);
    REP(1) if (IN(1)) {
        { pg8::Gemm g{(const bf16*)(ws + WS_H0B), (const bf16*)(ws + WS_WINT), LP, NPROJ, DM}; ProjOrder S; S.init(G, bid, 0); EpiProj E{ws, 1.f};
          pg8::gemm_phase<EpiProj, ProjOrder, PG_ALIGN, PG_SP2>(lds, g, S, E); }
        { pg8::Gemm g{(const bf16*)(ws + WS_H0F8), (const bf16*)(ws + WS_WF8 - (size_t)30 * 256 * DM), LP, NPROJ, DM}; ProjOrder S; S.init(G, bid, 1); EpiGate E{ws};
          pg8::gemm_phase<EpiGate, ProjOrder, PG_ALIGN, PG_SP2, true>(lds, g, S, E); }
    }
    SEAM(1); STAMP(2);
    REP(2) if (IN(2)) {
#ifndef NO_QUP
        { int kq_ = QRANK; asm volatile("" : "+s"(kq_)); pg8::Gemm g{(const bf16*)(ws + WS_CQ8), (const bf16*)(ws + WS_WUQ8), SEQ, 3072, kq_};
          pg8::StaticOrder S; S.init(SEQ, 3072, G, (bid + G / 2) % G); EpiQ E{ws};
          pg8::gemm_phase<EpiQ, pg8::StaticOrder, PG_ALIGN, PG_SP2, true>(lds, g, S, E); }
#endif
        STAMP(11);
#ifndef NO_KVUP
        { int kk_ = KVRANK; asm volatile("" : "+s"(kk_)); pg8::Gemm g{(const bf16*)(ws + WS_CKV8), (const bf16*)(ws + WS_WUKV8), LP, 4096, kk_};
          pg8::StaticOrder S; S.init(LP, 4096, G, bid); EpiKV E{ws};
          pg8::gemm_phase<EpiKV, pg8::StaticOrder, PG_ALIGN, PG_SP2, true>(lds, g, S, E); }
#endif
        STAMP(12);
        { FRESH_IDS(); kpe_pass(ws, gw, NGW, lane); }
        STAMP(13);
        { FRESH_IDS(); gla_pass_a(ws, glw, lds, tid, G, bid, args.out); }
#if defined(DUP_PA)
        { FRESH_IDS(); gla_pass_a(ws, glw, lds, tid, G, bid, args.out); }
#endif
#if defined(DUP_KPE)
        { FRESH_IDS(); kpe_pass(ws, gw, NGW, lane); }
#endif
    }
    SEAM(2); STAMP(3);
    REP(3) if (IN(3)) {
#ifndef NO_CHAIN
        { FRESH_IDS();
          if (wave < 2) gla_chain(ws, bid, G, wave, lane);
          else { P0Args a{args.in[0], args.in[1], args.in[2], args.in[3], args.in[9], args.in[10], args.in[11], args.in[12], args.in[13], args.in[14], args.in[15], args.in[16], args.in[17], args.in[18], ws};
                 p0_weights_late(a, lds, bid * 6 + (wave - 2), G * 6, wave, lane); } }
#if defined(DUP_CHAIN)
        { FRESH_IDS();
          if (wave < 2) { if (DUP_CHAIN != 3) gla_chain(ws, bid, G, wave, lane); }
          else if (DUP_CHAIN != 2) { P0Args a{args.in[0], args.in[1], args.in[2], args.in[3], args.in[9], args.in[10], args.in[11], args.in[12], args.in[13], args.in[14], args.in[15], args.in[16], args.in[17], args.in[18], ws};
                 p0_weights_late(a, lds, bid * 6 + (wave - 2), G * 6, wave, lane); } }
#endif
#endif
        STAMP(14);
#ifndef NO_ATT
        att::attn_phase(ws, lds, G, bid, (bf16*)args.out, (bf16*)args.out + (size_t)32 * 1024 * 1024);
#endif
    }
    SEAM(3); STAMP(4);
    REP(4) if (IN(4)) { FRESH_IDS(); gla_pass_c<0>(ws, glw, lds, tid, G, bid, (bf16*)args.out + (size_t)48 * 1024 * 1024, args.out);
    }
    SEAM(4); STAMP(5);
    REP(5) if (IN(5)) {
        pg8::Gemm g{(const bf16*)args.out + (size_t)48 * 1024 * 1024, (const bf16*)(ws + WS_WGT), SEQ, DM, 2048, (const bf16*)args.out + (size_t)32 * 1024 * 1024, (const bf16*)(ws + WS_WMT)}; PairOrder S; S.init(SEQ, DM, G, bid); EpiMerged E{ws};
        pg8::gemm_phase<EpiMerged, PairOrder, PG_ALIGN, PG_SP2>(lds, g, S, E);
    }
    SEAM(5); STAMP(6);
    REP(6) if (IN(6)) {
        pg8::Gemm g{(const bf16*)(ws + WS_MERGED), (const bf16*)(ws + WS_WOT), SEQ, DM, DM}; pg8::StaticOrder S; S.init(SEQ, DM, G, bid); EpiWo E{ws, args.in[0], args.out};
        pg8::gemm_phase<EpiWo, pg8::StaticOrder, PG_ALIGN, PG_SP2>(lds, g, S, E);
    }
    SEAM(6); STAMP(7);
#if defined(EXTRA_BAR)
    for (int eb_ = 0; eb_ < EXTRA_BAR; ++eb_) xcd_barrier(bar);
#endif
    REP(7) if (IN(7)) {
        pg8::Gemm g{(const bf16*)(ws + WS_H1B), (const bf16*)(ws + WS_W1T), SEQ, DFF, DM}; pg8::StaticOrder S; S.init(SEQ, DFF, G, bid); pg8::Unit u0; u0.pm = 0; u0.pn = 0; S.next(0, u0); { FRESH_IDS(); ff1_rs_table(ws, lds, u0.pm, tid); } EpiFF1 E{ws, lds, u0.pm};
#if defined(EXP_BURN)
        if (rep_ == 1) {
            f32x4 bacc[32]; bf16x8 ba, bb;
#pragma unroll
            for (int q = 0; q < 32; ++q) bacc[q] = (f32x4){0.f, 0.f, 0.f, 0.f};
#pragma unroll
            for (int q = 0; q < 8; ++q) { ba[q] = (short)(0x3f80 + (threadIdx.x & 7)); bb[q] = (short)(0x3c00 + (threadIdx.x & 3)); }
            for (int it = 0; it < 512; ++it) {
#pragma unroll
                for (int k2 = 0; k2 < 64; ++k2) bacc[k2 & 31] = __builtin_amdgcn_mfma_f32_16x16x32_bf16(ba, bb, bacc[k2 & 31], 0, 0, 0);
            }
            float sm = 0.f;
#pragma unroll
            for (int q = 0; q < 32; ++q) sm += bacc[q][0] + bacc[q][1] + bacc[q][2] + bacc[q][3];
            if (sm == 1234567.125f) ((float*)(ws + ST_H2SS))[0] = sm;
        } else
#endif
#if defined(EXP_NULLEPI)
        if (rep_ == 1) { EpiNull EN{ws};
#if EXP_NULLEPI == 2
            pg8::Gemm g2{(const bf16*)(ws + WS_H1B), (const bf16*)(ws + WS_W1T), 256, 256, DM}; pg8::StaticOrder S2; S2.init(256, 256, 1, 0); S2.nwg = 8; S2.nN = 1; S2.nM = 1;
            struct HotOrder { __device__ bool next(int i, pg8::Unit& u) const { u.pm = 0; u.pn = 0; return i < 8; } __device__ __forceinline__ void a_ready(const pg8::Unit&) const {} __device__ __forceinline__ void done(const pg8::Unit&) const {} } HS;
            pg8::gemm_phase<EpiNull, HotOrder, true, true>(lds, g2, HS, EN);
#else
            pg8::gemm_phase<EpiNull, pg8::StaticOrder, true, true>(lds, g, S, EN);
#endif
        } else
#endif
        pg8::gemm_phase<EpiFF1, pg8::StaticOrder, PG_ALIGN, PG_SP2>(lds, g, S, E);
    }
    SEAM(7); STAMP(8);
    REP(8) if (IN(8)) {
        pg8::Gemm g{(const bf16*)(ws + WS_U), (const bf16*)(ws + WS_W2T), SEQ, DM, DFF, nullptr, nullptr, LDU, 0}; pg8::StaticOrder S; S.init(SEQ, DM, G, bid); EpiFF2 E{ws, args.out};
        pg8::gemm_phase<EpiFF2, pg8::StaticOrder, PG_ALIGN, PG_SP2>(lds, g, S, E);
#if defined(EXP_NULLEPI8)
        xcd_barrier(bar); { EpiNull EN{ws}; pg8::gemm_phase<EpiNull, pg8::StaticOrder, PG_ALIGN, PG_SP2>(lds, g, S, EN); }
#endif
    }
    SEAM(8); STAMP(9);
    REP(9) if (IN(9)) { FRESH_IDS(); final_norm(ws, args.out, args.in[19], gw, NGW, lane); }
#undef IN
#undef SEAM
}

#if defined(DBG_BISECT)
__global__ void __launch_bounds__(256) dbg_cksum(const unsigned* p, size_t nwords, unsigned* slot) {
    unsigned s = 0;
    for (size_t i = (size_t)blockIdx.x * 256 + threadIdx.x; i < nwords; i += (size_t)gridDim.x * 256) { const unsigned w = p[i]; s += w * 2654435761u + (unsigned)(i & 0xffff) * (w >> 7); }
    for (int o = 1; o < 64; o <<= 1) s += __shfl_xor(s, o);
    if ((threadIdx.x & 63) == 0) atomicAdd(slot, s);
}
__global__ void dbg_report(const unsigned* tab, int nbuf, float* out, size_t nout) {
    int first = 0;
    for (int i = 0; i < nbuf; ++i) if (tab[i] != tab[64 + i]) { first = i + 1; break; }
    for (size_t i = (size_t)blockIdx.x * blockDim.x + threadIdx.x; i < nout; i += (size_t)gridDim.x * blockDim.x) out[i] = (float)first * 1000.f;
}
struct DbgBuf { size_t off, bytes; int phase; int where; };
static const DbgBuf DBG_BUFS[] = {
    {WS_WINT, (size_t)NPROJ * DM * 2, 0, 0}, {WS_W1T, (size_t)DFF * DM * 2, 0, 0}, {WS_W2T, (size_t)DFF * DM * 2, 0, 0}, {WS_WOT, (size_t)DM * DM * 2, 0, 0},
    {WS_WGT, (size_t)DM * 2048 * 2, 0, 0}, {WS_WMT, (size_t)DM * 2048 * 2, 0, 0}, {WS_WUQT, (size_t)3072 * 1024 * 2, 0, 0}, {WS_WUKVT, (size_t)4096 * 512 * 2, 0, 0},
    {WS_H0B, (size_t)LP * DM * 2, 0, 0}, {ST_RS1, (size_t)LP * 4, 0, 0}, {ST_COS, (size_t)LTOK * 32 * 4, 0, 0}, {ST_SIN, (size_t)LTOK * 32 * 4, 0, 0},
    {WS_GQ, (size_t)SEQ * 1024 * 2, 1, 0}, {WS_GK, (size_t)LP * 1024 * 2, 1, 0}, {WS_GV, (size_t)LP * 2048 * 2, 1, 0}, {WS_GOG, (size_t)SEQ * 2048 * 2, 1, 0},
    {WS_CQ, (size_t)SEQ * 1024 * 2, 1, 0}, {WS_CKV, (size_t)LP * 512 * 2, 1, 0}, {WS_GA, (size_t)SEQ * DM * 2, 1, 0}, {WS_GB, (size_t)SEQ * DM * 2, 1, 0},
    {ST_SMALL, (size_t)LP * 96 * 4, 1, 0}, {ST_CQSS, (size_t)SEQ * 16 * 4, 1, 0}, {ST_CKVSS, (size_t)LP * 8 * 4, 1, 0},
    {WS_QM, (size_t)SEQ * 3072 * 2, 2, 0}, {WS_KF, (size_t)LP * 3072 * 2, 2, 0}, {WS_VB, (size_t)LP * 2048 * 2, 2, 0},
    {WS_KHTF, (size_t)129 * 8 * 128 * 64 * 2, 2, 0}, {WS_KHTB, (size_t)128 * 8 * 128 * 64 * 2, 2, 0}, {WS_VT, (size_t)129 * 8 * 256 * 64 * 2, 2, 0},
    {ST_DLF, (size_t)129 * 8 * 128 * 4, 2, 0}, {ST_DLB, (size_t)128 * 8 * 128 * 4, 2, 0},
    {WS_SNAP, (size_t)2 * 128 * 8 * 256 * 128 * 2, 3, 0}, {WS_AO, (size_t)SEQ * 2048 * 2, 3, 0},
    {WS_AG, (size_t)SEQ * 2048 * 2, 4, 0},
    {WS_MERGED, (size_t)SEQ * DM * 2, 5, 0},
    {0, (size_t)SEQ * DM * 4, 6, 1}, {WS_H1B, (size_t)SEQ * DM * 2, 6, 0}, {ST_H1SS, (size_t)SEQ * 64 * 4, 6, 0},
    {WS_U, (size_t)SEQ * DFF * 2, 7, 0},
    {0, (size_t)SEQ * DM * 4, 8, 1}, {ST_H2SS, (size_t)SEQ * 64 * 4, 8, 0},
    {0, (size_t)SEQ * DM * 4, 9, 1},
};
static void dbg_launch(Args a, int grid, void* d_out, void* d_ws, hipStream_t stream) {
    const int nbuf = (int)(sizeof(DBG_BUFS) / sizeof(DBG_BUFS[0]));
    unsigned* tab = (unsigned*)((char*)d_ws + WS_CTL + 65536);
    for (int run = 0; run < 2; ++run)
        for (int p = 0; p < NPHASE; ++p) {
            a.ph_lo = p; a.ph_hi = p + 1; hipLaunchKernelGGL(mega_fwd, dim3(grid), dim3(NTHR), LDS_BYTES, stream, a);
            for (int i = 0; i < nbuf; ++i) if (DBG_BUFS[i].phase == p) {
                const char* base = DBG_BUFS[i].where ? (const char*)d_out : (const char*)d_ws + DBG_BUFS[i].off;
                hipLaunchKernelGGL(dbg_cksum, dim3(1024), dim3(256), 0, stream, (const unsigned*)base, DBG_BUFS[i].bytes / 4, tab + run * 64 + i);
            }
        }
    hipLaunchKernelGGL(dbg_report, dim3(1024), dim3(256), 0, stream, (const unsigned*)tab, nbuf, (float*)d_out, (size_t)SEQ * DM);
}

#endif
#ifndef MK_N_LAUNCHES
#define MK_N_LAUNCHES 1
#endif
extern "C" void kernel_launch(void* const* d_in, const int* in_sizes, int n_in, void* d_out, int out_size, void* d_ws, size_t ws_size, hipStream_t stream) {
    static int grid = 0;
    if (grid == 0) {
        if (n_in != 20 || out_size != SEQ * DM || ws_size < WS_END) { fprintf(stderr, "kernel_launch: unexpected shapes: n_in %d out %d ws %zu (need %zu)\n", n_in, out_size, ws_size, (size_t)WS_END); grid = -1; return; }
        int dev = 0, cus = 0, per_cu = 0;
        if (hipGetDevice(&dev) != hipSuccess || hipDeviceGetAttribute(&cus, hipDeviceAttributeMultiprocessorCount, dev) != hipSuccess) { grid = -1; return; }
        if (hipFuncSetAttribute((const void*)mega_fwd, hipFuncAttributeMaxDynamicSharedMemorySize, LDS_BYTES) != hipSuccess) { fprintf(stderr, "kernel_launch: hipFuncSetAttribute failed\n"); grid = -1; return; }
        if (hipOccupancyMaxActiveBlocksPerMultiprocessor(&per_cu, (const void*)mega_fwd, NTHR, LDS_BYTES) != hipSuccess || per_cu < 1) fprintf(stderr, "kernel_launch: occupancy query says %d\n", per_cu);
        (void)hipGetLastError();
        grid = cus;
    }
    if (grid < 0) return;
    if (hipMemsetAsync((char*)d_ws + WS_CTL, 0, CTL_BYTES, stream) != hipSuccess) return;
    Args a{};
    for (int i = 0; i < 20; ++i) a.in[i] = (const float*)d_in[i];
    a.out = (float*)d_out; a.ws = (unsigned char*)d_ws;
#if defined(DBG_BISECT)
    dbg_launch(a, grid, d_out, d_ws, stream);
#elif MK_N_LAUNCHES == 1
    a.ph_lo = 0; a.ph_hi = NPHASE;
    hipLaunchKernelGGL(mega_fwd, dim3(grid), dim3(NTHR), LDS_BYTES, stream, a);
#else
    for (int p = 0; p < NPHASE; ++p) { a.ph_lo = p; a.ph_hi = p + 1; hipLaunchKernelGGL(mega_fwd, dim3(grid), dim3(NTHR), LDS_BYTES, stream, a); }
#endif
    const hipError_t le = hipPeekAtLastError();
    if (le != hipSuccess) fprintf(stderr, "kernel_launch: launch failed: %s\n", hipGetErrorName(le));
}
```
